# Optimizing an MI355X kernel written in HIP

```python
import math
import jax, jax.numpy as jnp
from jax import lax
import numpy as np

D_MODEL = 4096
BATCH = 2
SEQ = 8192
DEPTH = 1

HEAD_DIM = 128
D_MIX = D_MODEL
H_A = D_MIX // (2 * HEAD_DIM)
H_B = D_MIX // (2 * HEAD_DIM)
D_A = H_A * HEAD_DIM
D_B = H_B * HEAD_DIM
D_FF = 4 * D_MODEL
PLE_DIM = 256
Q_BLOCK = 128
CHUNK = 64
N_IN = 3 * D_A + H_A + 4 * D_B
RMS_EPS = 1e-6

kernel_name = "fox_hgrn2_parallel_hybrid_layer"


def rms_norm(x, g, eps=RMS_EPS):
    xf = x.astype(jnp.float32)
    y = xf * lax.rsqrt(jnp.mean(xf * xf, axis=-1, keepdims=True) + eps)
    return (y * g.astype(jnp.float32)).astype(x.dtype)


def split_columns(proj):
    sizes = (D_A, D_A, D_A, H_A, D_B, D_B, D_B, D_B)
    outs, start = [], 0
    for s in sizes:
        outs.append(proj[..., start:start + s])
        start += s
    return outs


def fox_attention(q, k, v, f_logit):
    B, S, H, Dh = q.shape
    nb = S // Q_BLOCK
    scale = 1.0 / math.sqrt(Dh)
    F = jnp.cumsum(jax.nn.log_sigmoid(f_logit.astype(jnp.float32)), axis=1).transpose(0, 2, 1)
    qh = q.transpose(0, 2, 1, 3)
    kh = k.transpose(0, 2, 1, 3)
    vh = v.transpose(0, 2, 1, 3)
    q_blocks = qh.reshape(B, H, nb, Q_BLOCK, Dh).transpose(2, 0, 1, 3, 4)
    F_blocks = F.reshape(B, H, nb, Q_BLOCK).transpose(2, 0, 1, 3)
    pos_k = jnp.arange(S)

    def one_block(args):
        blk, qi, Fi = args
        pos_q = blk * Q_BLOCK + jnp.arange(Q_BLOCK)
        s = jnp.einsum('bhqd,bhkd->bhqk', qi, kh, preferred_element_type=jnp.float32) * scale
        s = s + Fi[..., :, None] - F[..., None, :]
        s = jnp.where(pos_k[None, :] <= pos_q[:, None], s, -jnp.inf)
        pr = jax.nn.softmax(s, axis=-1)
        return jnp.einsum('bhqk,bhkd->bhqd', pr.astype(vh.dtype), vh)

    out = lax.map(one_block, (jnp.arange(nb), q_blocks, F_blocks))
    return out.transpose(1, 0, 3, 2, 4).reshape(B, S, H, Dh)


def hgrn2_recurrence(q, k, v, logf):
    B, S, H, Dk = q.shape
    Dv = v.shape[-1]
    nc = S // CHUNK

    def to_chunks(t):
        return t.reshape(B, nc, CHUNK, H, t.shape[-1]).transpose(1, 0, 3, 2, 4)

    causal = jnp.tril(jnp.ones((CHUNK, CHUNK), dtype=bool))

    def step(state, inp):
        qi, ki, vi, gi = inp
        b = jnp.cumsum(gi, axis=-2)
        o_inter = jnp.einsum('bhtk,bhkv->bhtv', qi * jnp.exp(b), state)
        diff = b[:, :, :, None, :] - b[:, :, None, :, :]
        decay = jnp.exp(jnp.where(causal[:, :, None], diff, -jnp.inf))
        A = jnp.einsum('bhtk,bhsk,bhtsk->bhts', qi, ki, decay)
        o_intra = jnp.einsum('bhts,bhsv->bhtv', A, vi)
        b_last = b[:, :, -1:, :]
        new_state = jnp.exp(b_last[:, :, 0, :])[..., None] * state + \
            jnp.einsum('bhsk,bhsv->bhkv', ki * jnp.exp(b_last - b), vi)
        return new_state, o_inter + o_intra

    s0 = jnp.zeros((B, H, Dk, Dv), jnp.float32)
    _, o = lax.scan(step, s0, (to_chunks(q), to_chunks(k), to_chunks(v), to_chunks(logf)))
    return o.transpose(1, 0, 3, 2, 4).reshape(B, S, H, Dv)


def setup_inputs(seed: int = 0) -> dict:
    key = jax.random.key(seed)
    ks = jax.random.split(key, 17)
    f32 = jnp.float32

    def nrm(k, shape, scale):
        return jax.random.normal(k, shape, f32) * scale

    return {
        "x": nrm(ks[0], (BATCH, SEQ, D_MODEL), 1.0),
        "p": nrm(ks[1], (DEPTH, BATCH, SEQ, PLE_DIM), 1.0),
        "norm_mix_g": 1.0 + nrm(ks[2], (DEPTH, D_MODEL), 0.02),
        "w_in": nrm(ks[3], (DEPTH, D_MODEL, N_IN), D_MODEL ** -0.5),
        "fox_f_bias": 1.0 + nrm(ks[4], (DEPTH, H_A), 0.1),
        "fox_q_norm_g": 1.0 + nrm(ks[5], (DEPTH, HEAD_DIM), 0.02),
        "fox_k_norm_g": 1.0 + nrm(ks[6], (DEPTH, HEAD_DIM), 0.02),
        "hgrn_lb_logits": nrm(ks[7], (DEPTH + 1, D_B), 0.1),
        "hgrn_norm_g": 1.0 + nrm(ks[8], (DEPTH, HEAD_DIM), 0.02),
        "w_out": nrm(ks[9], (DEPTH, D_MIX, D_MODEL), D_MIX ** -0.5),
        "norm_mlp_g": 1.0 + nrm(ks[10], (DEPTH, D_MODEL), 0.02),
        "w_up": nrm(ks[11], (DEPTH, D_MODEL, D_FF), D_MODEL ** -0.5),
        "w_down": nrm(ks[12], (DEPTH, D_FF, D_MODEL), D_FF ** -0.5),
        "ple_norm_g": 1.0 + nrm(ks[13], (DEPTH, D_MODEL), 0.02),
        "w_ple_gate": nrm(ks[14], (DEPTH, D_MODEL, D_MODEL), D_MODEL ** -0.5),
        "w_ple_proj": nrm(ks[15], (DEPTH, PLE_DIM, D_MODEL), PLE_DIM ** -0.5),
        "ple_post_g": 1.0 + nrm(ks[16], (DEPTH, D_MODEL), 0.02),
    }


def reference(x, p, norm_mix_g, w_in, fox_f_bias, fox_q_norm_g, fox_k_norm_g, hgrn_lb_logits,
              hgrn_norm_g, w_out, norm_mlp_g, w_up, w_down, ple_norm_g, w_ple_gate,
              w_ple_proj, ple_post_g):
    B, S, _ = x.shape
    h = x
    lower_bounds = jnp.cumsum(jax.nn.softmax(hgrn_lb_logits.astype(jnp.float32), axis=0), axis=0)
    for i in range(DEPTH):
        u = rms_norm(h, norm_mix_g[i])
        proj = jnp.einsum('bsd,dn->bsn', u, w_in[i])
        q_a, k_a, v_a, f_a, q_b, f_b, i_b, g_b = split_columns(proj)

        qa = rms_norm(q_a.reshape(B, S, H_A, HEAD_DIM), fox_q_norm_g[i])
        ka = rms_norm(k_a.reshape(B, S, H_A, HEAD_DIM), fox_k_norm_g[i])
        va = v_a.reshape(B, S, H_A, HEAD_DIM)
        out_a = fox_attention(qa, ka, va, f_a + fox_f_bias[i]).reshape(B, S, D_A)

        lb = lower_bounds[i].reshape(H_B, HEAD_DIM)
        z = f_b.astype(jnp.float32).reshape(B, S, H_B, HEAD_DIM)
        logf = jnp.log(lb + (1.0 - lb) * jax.nn.sigmoid(z))
        kb = (1.0 - lb) * jax.nn.sigmoid(-z)
        qb = jax.nn.silu(q_b.astype(jnp.float32)).reshape(B, S, H_B, HEAD_DIM)
        vb = i_b.astype(jnp.float32).reshape(B, S, H_B, HEAD_DIM)
        ob = hgrn2_recurrence(qb, kb, vb, logf)
        ob = rms_norm(ob, hgrn_norm_g[i]).astype(h.dtype).reshape(B, S, D_B)
        out_b = ob * jax.nn.silu(g_b)

        mixed = jnp.concatenate([out_a.astype(h.dtype), out_b], axis=-1)
        h = h + jnp.einsum('bsm,md->bsd', mixed, w_out[i])

        um = rms_norm(h, norm_mlp_g[i])
        hid = jnp.square(jax.nn.relu(jnp.einsum('bsd,df->bsf', um, w_up[i])))
        h = h + jnp.einsum('bsf,fd->bsd', hid, w_down[i])

        gate = jax.nn.sigmoid(jnp.einsum('bsd,de->bse', rms_norm(h, ple_norm_g[i]), w_ple_gate[i]))
        e = rms_norm(jnp.einsum('bsq,qd->bsd', p[i].astype(h.dtype), w_ple_proj[i]), ple_post_g[i])
        h = h + gate * e
    return h
```

```cpp
#include <hip/hip_runtime.h>
#include <hip/hip_bf16.h>
#include <cstdio>
#include <cstdint>
namespace pg8 {
#define PG8_LAS __attribute__((address_space(3)))
typedef unsigned short bf16_t;
typedef short bf16x8 __attribute__((ext_vector_type(8)));
typedef float f32x4 __attribute__((ext_vector_type(4)));
typedef unsigned u32x4 __attribute__((ext_vector_type(4)));
constexpr int BM = 256, BK = 64, HALF = 128, HTB = HALF * BK * 2  , STAGE_BYTES = 8 * HTB, NXCD = 8, WGM = 8;

__host__ __device__ __forceinline__ int lds_byte(int r, int c) { const int st = (r >> 4) * 2 + (c >> 5), rr = r & 15, cc = c & 31, ob = rr * 64 + cc * 2; return st * 1024 + (ob ^ (((ob >> 9) & 1) << 5)); }
__host__ __device__ __forceinline__ void stage_rc(int b, int& R, int& C) { const int st = b / 1024, sb = b % 1024, swz = sb ^ (((sb >> 9) & 1) << 5); R = (st >> 1) * 16 + swz / 64; C = (st & 1) * 32 + (swz % 64) / 2; }
__host__ __device__ __forceinline__ int perm32(int rho) { const int n = rho >> 4, i = rho & 15; return 8 * (i >> 2) + 4 * n + (i & 3); }

struct Unit { int pm, pn; };
struct Gemm { const bf16_t* A; const bf16_t* Bt; int M, N, K; };

struct StaticOrder {
    int nM, nN, nwg, G, c;
    __host__ __device__ void init(int M, int N, int G_, int c_) { nM = M / BM; nN = N / BM; nwg = nM * nN; G = G_; c = c_; }
    __host__ __device__ bool next(int i, Unit& u) const {
        const long L = (long)i * G + c; if (L >= nwg) return false;
        int wgid = (int)L; { const int q = nwg / NXCD, r = nwg % NXCD, xcd = wgid % NXCD, off = wgid / NXCD; wgid = (xcd < r ? xcd * (q + 1) : r * (q + 1) + (xcd - r) * q) + off; }
        const int nig = WGM * nN, gid = wgid / nig, fm = gid * WGM, gsz = (nM - fm) < WGM ? (nM - fm) : WGM;
        u.pm = fm + ((wgid % nig) % gsz); u.pn = (wgid % nig) / gsz; return true;
    }
    __device__ __forceinline__ void a_ready(const Unit&) const {}
    __device__ __forceinline__ void done(const Unit&) const {}
};
typedef float f32x2c_t __attribute__((ext_vector_type(2))); typedef __bf16 bf16x2c_t __attribute__((ext_vector_type(2)));
__device__ __forceinline__ unsigned cvt_pk_bf16(float lo, float hi) { f32x2c_t v = {lo, hi}; bf16x2c_t b = __builtin_convertvector(v, bf16x2c_t); return __builtin_bit_cast(unsigned, b); }
typedef float f32x2 __attribute__((ext_vector_type(2)));
__device__ __forceinline__ u32x4 pack8v(const f32x4 v0, const f32x4 v1) { u32x4 w; w.x = cvt_pk_bf16(v0[0], v0[1]); w.y = cvt_pk_bf16(v0[2], v0[3]); w.z = cvt_pk_bf16(v1[0], v1[1]); w.w = cvt_pk_bf16(v1[2], v1[3]); return w; }
__device__ __forceinline__ float dot8(const f32x4 a, const f32x4 b) { return ((a[0] * a[0] + a[1] * a[1]) + (a[2] * a[2] + a[3] * a[3])) + ((b[0] * b[0] + b[1] * b[1]) + (b[2] * b[2] + b[3] * b[3])); }
__device__ __forceinline__ float red_fq(float s) { s += __shfl_xor(s, 16); s += __shfl_xor(s, 32); return s; }

struct EpiProj {
    static constexpr bool PERM = true, AFTER_DRAIN = false;
    bf16_t* proj; float* pqk;
    __device__ __forceinline__ void operator()(const f32x4 (&acc)[2][2][4][2], const Unit& u, int wr, int wc, int fr, int fq) const {
        const int C = u.pn * BM, which = C >> 11, hp = (C & 2047) >> 8, dcol = wc * 32 + 8 * fq;
#pragma unroll
        for (int ai = 0; ai < 2; ++ai)
#pragma unroll
            for (int m = 0; m < 4; ++m) { const int row = u.pm * BM + ai * HALF + wr * 64 + m * 16 + fr, b = row >> 13, t = row & 8191;
#pragma unroll
                for (int bj = 0; bj < 2; ++bj) { const int head = 2 * hp + bj;
                    const f32x4 v0 = acc[ai][bj][m][0], v1 = acc[ai][bj][m][1];
                    *(u32x4*)(proj + ((size_t)((which * 2 + b) * 16 + head) * 8192 + t) * 128 + dcol) = pack8v(v0, v1);
                    if (which < 2) { const float ss = red_fq(dot8(v0, v1)); if (fq == 0) pqk[((size_t)(which * 16384 + row) * 16 + head) * 4 + wc] = ss; } } }
    }
};
struct EpiOut {
    static constexpr bool PERM = true, AFTER_DRAIN = false;
    const float* x; float* out; bf16_t* hb; float* part;
    __device__ __forceinline__ void operator()(const f32x4 (&acc)[2][2][4][2], const Unit& u, int wr, int wc, int fr, int fq) const {
        const int col0 = u.pn * BM + wc * 32 + 8 * fq;
#pragma unroll
        for (int ai = 0; ai < 2; ++ai)
#pragma unroll
            for (int m = 0; m < 4; ++m) { const int row = u.pm * BM + ai * HALF + wr * 64 + m * 16 + fr; float ss = 0.f;
#pragma unroll
                for (int bj = 0; bj < 2; ++bj) { const size_t off = (size_t)row * 4096 + col0 + bj * HALF;
                    const f32x4 v0 = acc[ai][bj][m][0] + *(const f32x4*)(x + off), v1 = acc[ai][bj][m][1] + *(const f32x4*)(x + off + 4);
                    *(f32x4*)(out + off) = v0; *(f32x4*)(out + off + 4) = v1; *(u32x4*)(hb + off) = pack8v(v0, v1); ss += dot8(v0, v1); }
                ss = red_fq(ss); if (fq == 0) part[(size_t)row * 64 + u.pn * 4 + wc] = ss;
                asm volatile("" ::: "memory"); }
    }
};
struct EpiE {
    static constexpr bool PERM = true, AFTER_DRAIN = false;
    bf16_t* eb; float* part;
    __device__ __forceinline__ void operator()(const f32x4 (&acc)[2][2][4][2], const Unit& u, int wr, int wc, int fr, int fq) const {
        const int col0 = u.pn * BM + wc * 32 + 8 * fq;
#pragma unroll
        for (int ai = 0; ai < 2; ++ai)
#pragma unroll
            for (int m = 0; m < 4; ++m) { const int row = u.pm * BM + ai * HALF + wr * 64 + m * 16 + fr; float ss = 0.f;
#pragma unroll
                for (int bj = 0; bj < 2; ++bj) { const size_t off = (size_t)row * 4096 + col0 + bj * HALF;
                    const f32x4 v0 = acc[ai][bj][m][0], v1 = acc[ai][bj][m][1];
                    *(u32x4*)(eb + off) = pack8v(v0, v1); ss += dot8(v0, v1); }
                ss = red_fq(ss); if (fq == 0) part[(size_t)row * 64 + u.pn * 4 + wc] = ss; }
    }
};
struct EpiUp {
    static constexpr bool PERM = true, AFTER_DRAIN = false;
    bf16_t* hid; const PG8_LAS float* rs;
    __device__ __forceinline__ void operator()(const f32x4 (&acc)[2][2][4][2], const Unit& u, int wr, int wc, int fr, int fq) const {
        const int col0 = u.pn * BM + wc * 32 + 8 * fq;
#pragma unroll
        for (int ai = 0; ai < 2; ++ai)
#pragma unroll
            for (int m = 0; m < 4; ++m) { const int lr = ai * HALF + wr * 64 + m * 16 + fr, row = u.pm * BM + lr; const float r = rs[lr];
#pragma unroll
                for (int bj = 0; bj < 2; ++bj) { f32x4 v0 = acc[ai][bj][m][0] * r, v1 = acc[ai][bj][m][1] * r;
#pragma unroll
                    for (int i = 0; i < 4; ++i) { const float a = fmaxf(v0[i], 0.f), b = fmaxf(v1[i], 0.f); v0[i] = a * a; v1[i] = b * b; }
                    *(u32x4*)(hid + (size_t)row * 16384 + col0 + bj * HALF) = pack8v(v0, v1); } }
    }
};
struct EpiDown {
    static constexpr bool PERM = true, AFTER_DRAIN = false;
    float* out; bf16_t* hb; float* part; int row_off;
    __device__ __forceinline__ void operator()(const f32x4 (&acc)[2][2][4][2], const Unit& u, int wr, int wc, int fr, int fq) const {
        const int col0 = u.pn * BM + wc * 32 + 8 * fq;
#pragma unroll
        for (int ai = 0; ai < 2; ++ai)
#pragma unroll
            for (int m = 0; m < 4; ++m) { const int row = row_off + u.pm * BM + ai * HALF + wr * 64 + m * 16 + fr; float ss = 0.f;
#pragma unroll
                for (int bj = 0; bj < 2; ++bj) { const size_t off = (size_t)row * 4096 + col0 + bj * HALF;
                    const f32x4 v0 = acc[ai][bj][m][0] + *(const f32x4*)(out + off), v1 = acc[ai][bj][m][1] + *(const f32x4*)(out + off + 4);
                    *(f32x4*)(out + off) = v0; *(f32x4*)(out + off + 4) = v1; *(u32x4*)(hb + off) = pack8v(v0, v1); ss += dot8(v0, v1); }
                ss = red_fq(ss); if (fq == 0) part[(size_t)row * 64 + u.pn * 4 + wc] = ss;
                asm volatile("" ::: "memory"); }
    }
};
struct EpiGate {
    static constexpr bool PERM = true, AFTER_DRAIN = false;
    float* out; const bf16_t* eb; const float* gpost; const PG8_LAS float* rs2; const PG8_LAS float* rse;
    __device__ __forceinline__ void operator()(const f32x4 (&acc)[2][2][4][2], const Unit& u, int wr, int wc, int fr, int fq) const {
        const int col0 = u.pn * BM + wc * 32 + 8 * fq;
        f32x4 gp[2][2];
#pragma unroll
        for (int bj = 0; bj < 2; ++bj) { gp[bj][0] = *(const f32x4*)(gpost + col0 + bj * HALF); gp[bj][1] = *(const f32x4*)(gpost + col0 + bj * HALF + 4); }
#pragma unroll
        for (int ai = 0; ai < 2; ++ai)
#pragma unroll
            for (int m = 0; m < 4; ++m) { const int lr = ai * HALF + wr * 64 + m * 16 + fr, row = u.pm * BM + lr; const float r2 = rs2[lr] * -1.4426950408889634f, re = rse[lr];
#pragma unroll
                for (int bj = 0; bj < 2; ++bj) { const size_t off = (size_t)row * 4096 + col0 + bj * HALF;
                    const u32x4 ew = *(const u32x4*)(eb + off);
                    f32x4 e0, e1; e0[0] = __uint_as_float(ew.x << 16); e0[1] = __uint_as_float(ew.x & 0xffff0000u); e0[2] = __uint_as_float(ew.y << 16); e0[3] = __uint_as_float(ew.y & 0xffff0000u);
                    e1[0] = __uint_as_float(ew.z << 16); e1[1] = __uint_as_float(ew.z & 0xffff0000u); e1[2] = __uint_as_float(ew.w << 16); e1[3] = __uint_as_float(ew.w & 0xffff0000u);
                    f32x4 v0 = *(const f32x4*)(out + off), v1 = *(const f32x4*)(out + off + 4);
#pragma unroll
                    for (int i = 0; i < 4; ++i) { const float g0 = __builtin_amdgcn_rcpf(1.f + __builtin_amdgcn_exp2f(acc[ai][bj][m][0][i] * r2)), g1 = __builtin_amdgcn_rcpf(1.f + __builtin_amdgcn_exp2f(acc[ai][bj][m][1][i] * r2));
                        v0[i] += g0 * (e0[i] * re * gp[bj][0][i]); v1[i] += g1 * (e1[i] * re * gp[bj][1][i]); }
                    *(f32x4*)(out + off) = v0; *(f32x4*)(out + off + 4) = v1; }
                asm volatile("" ::: "memory"); }
    }
};
template <class Epi, class Sched, bool ALIGN_EPI = false, bool SP2 = false>
__device__ __forceinline__ void gemm_phase(PG8_LAS unsigned char* lds, const Gemm g, const Sched& S, const Epi& E) {
    int tid_ = threadIdx.x; asm volatile("" : "+v"(tid_));
    const int tid = tid_, wid = __builtin_amdgcn_readfirstlane(tid >> 6), lane = tid & 63, wr = wid >> 2, wc = wid & 3, fr = lane & 15, fq = lane >> 4;
    const int K = g.K, nt = K / BK;
    unsigned voffA[2], voffB[2];
#pragma unroll
    for (int i = 0; i < 2; ++i) { int R, C; stage_rc(tid * 16 + i * 8192, R, C); const int Rb = Epi::PERM ? ((R & ~31) + perm32(R & 31)) : R;
        voffA[i] = (unsigned)(R * K + C) * 2u; voffB[i] = (unsigned)(Rb * K + C) * 2u; }
    const size_t kstep = (size_t)(BK * 2);
    const size_t hstep = (size_t)HALF * K * 2;
    const size_t tstep = 2 * hstep;
    const unsigned ldsw = (unsigned)wid * 1024u;
    const int aoff = lds_byte(wr * 64 + fr, fq * 8), boff = lds_byte(wc * 32 + fr, fq * 8);
#define PG8_SA(b, h) (((b) * 2 + (h)) * HTB)
#define PG8_SB(b, h) ((4 + (b) * 2 + (h)) * HTB)
#define PG8_STAGE(bufoff, gbase, voff) do { _Pragma("unroll") for (int _i = 0; _i < 2; ++_i) \
        __builtin_amdgcn_global_load_lds((const unsigned*)((const char*)(gbase) + (voff)[_i]), (PG8_LAS unsigned*)(lds + (bufoff) + ldsw + _i * 8192), 16, 0, 0); } while (0)
#define PG8_LDA(dst, b, h) do { _Pragma("unroll") for (int m = 0; m < 4; ++m) _Pragma("unroll") for (int k = 0; k < 2; ++k) dst[m][k] = *(const PG8_LAS bf16x8*)(lds + PG8_SA(b, h) + aoff + m * 2048 + k * 1024); } while (0)
#define PG8_LDB(dst, b, h) do { _Pragma("unroll") for (int n = 0; n < 2; ++n) _Pragma("unroll") for (int k = 0; k < 2; ++k) dst[n][k] = *(const PG8_LAS bf16x8*)(lds + PG8_SB(b, h) + boff + n * 2048 + k * 1024); } while (0)
#define PG8_MMA(ai, bj, At, Bt) do { __builtin_amdgcn_s_setprio(1); _Pragma("unroll") for (int m = 0; m < 4; ++m) _Pragma("unroll") for (int n = 0; n < 2; ++n) _Pragma("unroll") for (int k = 0; k < 2; ++k) \
        acc[ai][bj][m][n] = __builtin_amdgcn_mfma_f32_16x16x32_bf16(Bt[n][k], At[m][k], acc[ai][bj][m][n], 0, 0, 0); __builtin_amdgcn_s_setprio(0); } while (0)
#define PG8_WAIT_V(n) asm volatile("s_waitcnt vmcnt(" #n ")" ::: "memory")
#define PG8_WAIT_L(n) asm volatile("s_waitcnt lgkmcnt(" #n ")" ::: "memory")
#define PG8_BAR __builtin_amdgcn_s_barrier()
#define PG8_SCHED __builtin_amdgcn_sched_barrier(0)
    Unit cur, nxt; int ui = 0;
    if (!S.next(0, cur)) return;
    f32x4 acc[2][2][4][2];
#pragma unroll
    for (int a = 0; a < 2; ++a)
#pragma unroll
        for (int b = 0; b < 2; ++b)
#pragma unroll
            for (int m = 0; m < 4; ++m)
#pragma unroll
                for (int n = 0; n < 2; ++n) acc[a][b][m][n] = (f32x4){0.f, 0.f, 0.f, 0.f};
    bf16x8 At[4][2], B0[2][2], B1[2][2];
    const char* cA = (const char*)g.A + (size_t)cur.pm * tstep; const char* cB = (const char*)g.Bt + (size_t)cur.pn * tstep;
    S.a_ready(cur);
    if constexpr (SP2) {
        PG8_STAGE(PG8_SB(0, 0), cB, voffB); PG8_STAGE(PG8_SB(0, 1), cB + hstep, voffB); PG8_STAGE(PG8_SA(0, 0), cA, voffA); PG8_STAGE(PG8_SA(0, 1), cA + hstep, voffA);
        if (wr == 1) PG8_BAR;
        PG8_WAIT_V(2); PG8_BAR;
        PG8_STAGE(PG8_SB(1, 0), cB + kstep, voffB); PG8_STAGE(PG8_SA(1, 0), cA + kstep, voffA); PG8_STAGE(PG8_SB(1, 1), cB + hstep + kstep, voffB);
        PG8_WAIT_V(6); PG8_BAR;
    } else {
        PG8_STAGE(PG8_SB(0, 0), cB, voffB); PG8_STAGE(PG8_SA(0, 0), cA, voffA); PG8_STAGE(PG8_SB(0, 1), cB + hstep, voffB); PG8_STAGE(PG8_SA(0, 1), cA + hstep, voffA);
        if (wr == 1) PG8_BAR;
        PG8_WAIT_V(4); PG8_BAR;
        PG8_STAGE(PG8_SB(1, 0), cB + kstep, voffB); PG8_STAGE(PG8_SA(1, 0), cA + kstep, voffA); PG8_STAGE(PG8_SB(1, 1), cB + hstep + kstep, voffB);
        PG8_WAIT_V(6); PG8_BAR;
    }
    for (;;) {
        const bool has_next = S.next(ui + 1, nxt);
        const char* nA = has_next ? (const char*)g.A + (size_t)nxt.pm * tstep : cA; const char* nB = has_next ? (const char*)g.Bt + (size_t)nxt.pn * tstep : cB;
        for (int t = 0; t < nt; t += 2) {
            const bool last = (t == nt - 2);
            const char* a1 = cA + (size_t)(t + 1) * kstep;
            const char* a2 = last ? nA : cA + (size_t)(t + 2) * kstep; const char* b2 = last ? nB : cB + (size_t)(t + 2) * kstep;
            const char* a3 = a2 + kstep; const char* b3 = b2 + kstep;
            if (last && has_next) S.a_ready(nxt);
            if constexpr (SP2) {
            PG8_LDB(B0, 0, 0); PG8_LDB(B1, 0, 1); PG8_SCHED; PG8_LDA(At, 0, 0); PG8_STAGE(PG8_SA(1, 1), a1 + hstep, voffA);
            PG8_WAIT_V(8); PG8_WAIT_L(0); PG8_BAR; PG8_MMA(0, 0, At, B0); PG8_MMA(0, 1, At, B1); PG8_BAR; PG8_SCHED;
            PG8_LDA(At, 0, 1); PG8_STAGE(PG8_SB(0, 0), b2, voffB); PG8_STAGE(PG8_SB(0, 1), b2 + hstep, voffB); PG8_STAGE(PG8_SA(0, 0), a2, voffA);
            PG8_WAIT_V(8); PG8_WAIT_L(0); PG8_BAR; PG8_MMA(1, 0, At, B0); PG8_MMA(1, 1, At, B1); PG8_BAR; PG8_SCHED;
            PG8_LDB(B0, 1, 0); PG8_LDB(B1, 1, 1); PG8_SCHED; PG8_LDA(At, 1, 0); PG8_STAGE(PG8_SA(0, 1), a2 + hstep, voffA);
            PG8_WAIT_V(8); PG8_WAIT_L(0); PG8_BAR; PG8_MMA(0, 0, At, B0); PG8_MMA(0, 1, At, B1); PG8_BAR; PG8_SCHED;
            PG8_LDA(At, 1, 1); PG8_STAGE(PG8_SB(1, 0), b3, voffB); PG8_STAGE(PG8_SB(1, 1), b3 + hstep, voffB); PG8_STAGE(PG8_SA(1, 0), a3, voffA);
            PG8_WAIT_V(8); PG8_WAIT_L(0); PG8_BAR; PG8_MMA(1, 0, At, B0); PG8_MMA(1, 1, At, B1); PG8_BAR; PG8_SCHED;
            } else {
            PG8_LDB(B0, 0, 0); PG8_SCHED; PG8_LDA(At, 0, 0); PG8_STAGE(PG8_SA(1, 1), a1 + hstep, voffA);
            PG8_WAIT_L(8); PG8_BAR; PG8_WAIT_L(0); PG8_MMA(0, 0, At, B0); PG8_BAR; PG8_SCHED;
            PG8_LDB(B1, 0, 1); PG8_STAGE(PG8_SB(0, 0), b2, voffB);
            PG8_BAR; PG8_WAIT_L(0); PG8_MMA(0, 1, At, B1); PG8_BAR;
            PG8_LDA(At, 0, 1); PG8_STAGE(PG8_SA(0, 0), a2, voffA);
            PG8_BAR; PG8_WAIT_L(0); PG8_MMA(1, 0, At, B0); PG8_BAR; PG8_SCHED;
            PG8_STAGE(PG8_SB(0, 1), b2 + hstep, voffB);
            PG8_WAIT_V(6); PG8_BAR; PG8_MMA(1, 1, At, B1); PG8_BAR;
            PG8_LDB(B0, 1, 0); PG8_SCHED; PG8_LDA(At, 1, 0); PG8_STAGE(PG8_SA(0, 1), a2 + hstep, voffA);
            PG8_WAIT_L(8); PG8_BAR; PG8_WAIT_L(0); PG8_MMA(0, 0, At, B0); PG8_BAR; PG8_SCHED;
            PG8_LDB(B1, 1, 1); PG8_STAGE(PG8_SB(1, 0), b3, voffB);
            PG8_BAR; PG8_WAIT_L(0); PG8_MMA(0, 1, At, B1); PG8_BAR;
            PG8_LDA(At, 1, 1); PG8_STAGE(PG8_SA(1, 0), a3, voffA);
            PG8_BAR; PG8_WAIT_L(0); PG8_MMA(1, 0, At, B0); PG8_BAR; PG8_SCHED;
            PG8_STAGE(PG8_SB(1, 1), b3 + hstep, voffB);
            PG8_WAIT_V(6); PG8_BAR; PG8_MMA(1, 1, At, B1); PG8_BAR;
            }
        }
        if constexpr (ALIGN_EPI) { if (wr == 0) PG8_BAR; }
        if constexpr (!Epi::AFTER_DRAIN) { E(acc, cur, wr, wc, fr, fq); S.done(cur); }
        if (!has_next) break;
#pragma unroll
        for (int a = 0; a < 2; ++a)
#pragma unroll
            for (int b = 0; b < 2; ++b)
#pragma unroll
                for (int m = 0; m < 4; ++m)
#pragma unroll
                    for (int n = 0; n < 2; ++n) acc[a][b][m][n] = (f32x4){0.f, 0.f, 0.f, 0.f};
        cur = nxt; cA = nA; cB = nB; ++ui;
        if constexpr (ALIGN_EPI) { if (wr == 1) PG8_BAR; }
    }
    PG8_WAIT_V(0);
    if constexpr (!ALIGN_EPI) { if (wr == 0) PG8_BAR; }
    PG8_BAR;
    if constexpr (Epi::AFTER_DRAIN) { E.fused(acc, cur, wr, wc, fr, fq, lds, wid, lane); S.done(cur); }
#undef PG8_SA
#undef PG8_SB
#undef PG8_STAGE
#undef PG8_LDA
#undef PG8_LDB
#undef PG8_MMA
#undef PG8_WAIT_V
#undef PG8_WAIT_L
#undef PG8_BAR
#undef PG8_SCHED
}
}
namespace fa {
constexpr int D = 128;
constexpr float SCALE = 0.08838834764831845f;
constexpr float LOG2E = 1.4426950408889634f;
constexpr float THR2 = 8.f * LOG2E;
constexpr bool WSKIP = false;
constexpr int OPITCH = 4096;
constexpr int NW = 8, QBLK = 32, KVBLK = 64, QB = NW * QBLK;
constexpr int SHM_V = KVBLK * D * 2, SHM_K = KVBLK * D * 2;
constexpr int LDS_BYTES = 2 * SHM_V + 2 * SHM_K + NW * 64 * 4;
constexpr int TAB_MAX = 8192 + QB;
constexpr int FL_OFF = LDS_BYTES, RK_OFF = FL_OFF + TAB_MAX * 4, GG_OFF = RK_OFF + TAB_MAX * 4, SCR_OFF = GG_OFF + 512, FA_LDS_END = SCR_OFF + 64;
constexpr int WBIG = 1 << 30;

using bf16 = __hip_bfloat16;
typedef short bf16x8 __attribute__((ext_vector_type(8)));
typedef short s16x4 __attribute__((ext_vector_type(4)));
typedef float f32x16 __attribute__((ext_vector_type(16)));
typedef float f32x4 __attribute__((ext_vector_type(4)));
typedef unsigned u32x4 __attribute__((ext_vector_type(4)));
template <class A, class Bt> struct same_t { static constexpr bool v = false; };
template <class A> struct same_t<A, A> { static constexpr bool v = true; };

#define KSWZ(row, colB) ((row) * 256 + ((colB) ^ (((row) & 7) << 4)))
#define SBAR() __builtin_amdgcn_sched_barrier(0)
__device__ __forceinline__ int v_st(int k, int c) { const int kk = (k & ~0xC) | ((k & 4) << 1) | ((k & 8) >> 1); return ((kk >> 3) * 4 + (c >> 5)) * 512 + ((kk & 7) * 32 + (c & 31)) * 2; }
__device__ __forceinline__ int v_rd_base(int lane) { return ((lane & 3) << 3) | (((lane >> 2) & 3) << 6) | (((lane >> 4) & 1) << 5) | (((lane >> 5) & 1) << 8); }
constexpr int v_rd_off(int d0, int ks, int half) { return d0 * 512 + ks * 4096 + half * 2048; }
__device__ __forceinline__ int crow(int r, int hi) { return (r & 3) + 8 * (r >> 2) + 4 * hi; }
__device__ __forceinline__ unsigned cvtpk(float lo, float hi) {
    unsigned r; asm volatile("v_cvt_pk_bf16_f32 %0, %1, %2" : "=v"(r) : "v"(lo), "v"(hi)); return r;
}
__device__ __forceinline__ bf16x8 pack8(f32x4 a, f32x4 b) {
    u32x4 w = {cvtpk(a[0], a[1]), cvtpk(a[2], a[3]), cvtpk(b[0], b[1]), cvtpk(b[2], b[3])};
    return *reinterpret_cast<bf16x8*>(&w);
}
template <class T> __device__ __forceinline__ bf16x8 load8(const T* p) {
    if constexpr (same_t<T, float>::v) { return pack8(*(const f32x4*)p, *(const f32x4*)(p + 4)); }
    else { return *reinterpret_cast<const bf16x8*>(p); }
}
__device__ __forceinline__ void mask_tile(f32x16& p0, f32x16& p1, int dq, unsigned W) {
    const float NEG = -__builtin_inff();
#pragma unroll
    for (int r = 0; r < 16; ++r) {
        const int c = (r & 3) + 8 * (r >> 2);
        if ((unsigned)(dq - c) >= W) p0[r] = NEG;
        if ((unsigned)(dq - c - 32) >= W) p1[r] = NEG;
    }
}
__device__ __forceinline__ void partialSM(f32x16& p0, f32x16& p1, const float* FlL, const float* RKL, float& m_reg, float& mn, float& alpha) {
#pragma unroll
    for (int g = 0; g < 4; ++g) { const f32x4 f0 = *(const f32x4*)(FlL + 8 * g), k0 = *(const f32x4*)(RKL + 8 * g), f1 = *(const f32x4*)(FlL + 32 + 8 * g), k1 = *(const f32x4*)(RKL + 32 + 8 * g);
#pragma unroll
        for (int i = 0; i < 4; ++i) { p0[4 * g + i] = fmaf(p0[4 * g + i], k0[i], f0[i]); p1[4 * g + i] = fmaf(p1[4 * g + i], k1[i], f1[i]); } }
    float pmax = p0[0]; for (int r = 1; r < 16; ++r) pmax = fmaxf(pmax, p0[r]); for (int r = 0; r < 16; ++r) pmax = fmaxf(pmax, p1[r]);
    { auto rr = __builtin_amdgcn_permlane32_swap(__float_as_uint(pmax), __float_as_uint(pmax), false, false);
      pmax = fmaxf(__uint_as_float(rr[0]), __uint_as_float(rr[1])); }
    if (__builtin_expect(__all((pmax - m_reg) <= THR2), 1)) { mn = m_reg; alpha = 1.f; }
    else { mn = fmaxf(m_reg, pmax); alpha = __builtin_amdgcn_exp2f(m_reg - mn); m_reg = mn; }
    for (int r = 0; r < 16; ++r) p0[r] = p0[r] - mn; for (int r = 0; r < 16; ++r) p1[r] = p1[r] - mn;
    for (int r = 0; r < 16; ++r) p0[r] = __builtin_amdgcn_exp2f(p0[r]);
}
__device__ __forceinline__ void finishSM(f32x16& p0, f32x16& p1, float alpha, float& l_reg, bf16x8& pa0, bf16x8& pa1, bf16x8& pa2, bf16x8& pa3) {
    for (int r = 0; r < 16; ++r) p1[r] = __builtin_amdgcn_exp2f(p1[r]);
    float ps = 0; for (int r = 0; r < 16; ++r) ps += p0[r]; for (int r = 0; r < 16; ++r) ps += p1[r];
    { auto rr = __builtin_amdgcn_permlane32_swap(__float_as_uint(ps), __float_as_uint(ps), false, false);
      ps = __uint_as_float(rr[0]) + __uint_as_float(rr[1]); }
    l_reg = l_reg * alpha + ps;
#define PK4(P, B_, OUT) do { unsigned a0 = cvtpk(P[B_+0], P[B_+1]), a1 = cvtpk(P[B_+2], P[B_+3]);                          \
        unsigned b0 = cvtpk(P[B_+4], P[B_+5]), b1 = cvtpk(P[B_+6], P[B_+7]);                                             \
        auto r0 = __builtin_amdgcn_permlane32_swap(a0, b0, false, false); auto r1 = __builtin_amdgcn_permlane32_swap(a1, b1, false, false); \
        u32x4 w = {r0[0], r1[0], r0[1], r1[1]}; OUT = *reinterpret_cast<bf16x8*>(&w); } while (0)
    PK4(p0, 0, pa0); PK4(p0, 8, pa1); PK4(p1, 0, pa2); PK4(p1, 8, pa3);
#undef PK4
}
template <int KB, bool SK>
__device__ __forceinline__ void qkt(f32x16& p0, f32x16& p1, const char* K_lds, int r32, int hi, const bf16x8* qr, bool act) {
    if (SK && !act) { const float NEG = -__builtin_inff();
#pragma unroll
        for (int r = 0; r < 16; ++r) { p0[r] = NEG; p1[r] = NEG; } return; }
    p0 = f32x16{}; p1 = f32x16{};
    const char* kb[4];
#pragma unroll
    for (int dd = 0; dd < 4; ++dd) kb[dd] = K_lds + KB * SHM_K + KSWZ(r32, (dd * 16 + hi * 8) * 2);
#pragma unroll
    for (int d0 = 0; d0 < 8; ++d0) { const char* a = kb[d0 & 3] + (d0 >> 2) * 128;
        bf16x8 b0 = *reinterpret_cast<const bf16x8*>(a);
        bf16x8 b1 = *reinterpret_cast<const bf16x8*>(a + 32 * 256);
        p0 = __builtin_amdgcn_mfma_f32_32x32x16_bf16(b0, qr[d0], p0, 0, 0, 0);
        p1 = __builtin_amdgcn_mfma_f32_32x32x16_bf16(b1, qr[d0], p1, 0, 0, 0); }
}
template <int VB, bool SK>
__device__ __forceinline__ void pv_tile(f32x16* o, int vb0, bf16x8 pa0, bf16x8 pa1, bf16x8 pa2, bf16x8 pa3, bool act) {
    if (SK && !act) return;
#define TRRD(dst, off) asm volatile("ds_read_b64_tr_b16 %0, %1 offset:%2" : "=&v"(dst) : "v"(vb0), "i"(off) : "memory")
#define PV_D0(d0) do { s16x4 l0, l1, l2, l3, h0, h1, h2, h3; constexpr int b_ = VB * SHM_V + v_rd_off(d0, 0, 0);     \
        TRRD(l0, b_); TRRD(h0, b_ + 2048); TRRD(l1, b_ + 4096); TRRD(h1, b_ + 6144); TRRD(l2, b_ + 8192); TRRD(h2, b_ + 10240); TRRD(l3, b_ + 12288); TRRD(h3, b_ + 14336); \
        asm volatile("s_waitcnt lgkmcnt(0)" ::: "memory"); SBAR();                 \
        o[d0] = __builtin_amdgcn_mfma_f32_32x32x16_bf16(pa0, (bf16x8){l0[0], l0[1], l0[2], l0[3], h0[0], h0[1], h0[2], h0[3]}, o[d0], 0, 0, 0);   \
        o[d0] = __builtin_amdgcn_mfma_f32_32x32x16_bf16(pa1, (bf16x8){l1[0], l1[1], l1[2], l1[3], h1[0], h1[1], h1[2], h1[3]}, o[d0], 0, 0, 0);   \
        o[d0] = __builtin_amdgcn_mfma_f32_32x32x16_bf16(pa2, (bf16x8){l2[0], l2[1], l2[2], l2[3], h2[0], h2[1], h2[2], h2[3]}, o[d0], 0, 0, 0);   \
        o[d0] = __builtin_amdgcn_mfma_f32_32x32x16_bf16(pa3, (bf16x8){l3[0], l3[1], l3[2], l3[3], h3[0], h3[1], h3[2], h3[3]}, o[d0], 0, 0, 0); } while (0)
    PV_D0(0); PV_D0(1); PV_D0(2); PV_D0(3);
#undef PV_D0
#undef TRRD
}

template <class TIn, class TOut> struct BlockRef { const TIn* Q; const TIn* K; const TIn* V; TOut* O; int P0; int jlo; const float* LS; const float* PK; const float* PQ; };
template <class TIn> struct Seam {
    bf16x8 qr[8];
    bf16x8 st_v0, st_v1, st_k0, st_k1; f32x4 sf0, sf1, sf2, sf3;
    f32x4 tq[16];
};
__device__ __forceinline__ int swa_jlo(int P0, int W) { const int lowk = P0 - W + 1; return lowk > 0 ? lowk / KVBLK : 0; }
#define ROW(p, k0, rr) ((p) + (size_t)((k0) + (rr)) * D + sc)
#define VMW() asm volatile("s_waitcnt vmcnt(0)" ::: "memory")
#define VMWN(n) asm volatile("s_waitcnt vmcnt(%0)" :: "i"(n) : "memory")
#define SLOAD_H(Kp, Vp, k0) do { S.st_v0 = load8<TIn>(ROW(Vp, k0, sr)); S.st_v1 = load8<TIn>(ROW(Vp, k0, 32 + sr));              \
                         S.st_k0 = load8<TIn>(ROW(Kp, k0, sr)); S.st_k1 = load8<TIn>(ROW(Kp, k0, 32 + sr)); } while (0)
#define SWRITE_HK(bf) do { *(bf16x8*)(K_lds + (bf) * SHM_K + kws) = S.st_k0; *(bf16x8*)(K_lds + (bf) * SHM_K + kws + 32 * 256) = S.st_k1; } while (0)
#define SWRITE_HV(bf) do { *(bf16x8*)(V_lds + (bf) * SHM_V + vst0) = S.st_v0; *(bf16x8*)(V_lds + (bf) * SHM_V + vst1) = S.st_v1; } while (0)
#define SWRITE_H(bf) do { SWRITE_HV(bf); SWRITE_HK(bf); } while (0)
#define SLOAD_F(p, k0) do { S.sf0 = *(const f32x4*)ROW(p, k0, sr); S.sf1 = *(const f32x4*)(ROW(p, k0, sr) + 4);                \
                            S.sf2 = *(const f32x4*)ROW(p, k0, 32 + sr); S.sf3 = *(const f32x4*)(ROW(p, k0, 32 + sr) + 4); } while (0)
#define SWRITE_KF(bf) do { *(bf16x8*)(K_lds + (bf) * SHM_K + kws) = pack8(S.sf0, S.sf1); *(bf16x8*)(K_lds + (bf) * SHM_K + kws + 32 * 256) = pack8(S.sf2, S.sf3); } while (0)
#define SWRITE_VF(bf) do { *(bf16x8*)(V_lds + (bf) * SHM_V + vst0) = pack8(S.sf0, S.sf1); *(bf16x8*)(V_lds + (bf) * SHM_V + vst1) = pack8(S.sf2, S.sf3); } while (0)
template <class TIn, class TOut>
__device__ __forceinline__ void causal_swa_prime(const BlockRef<TIn, TOut>& cur, int W, char* lds, Seam<TIn>& S) {
    constexpr bool F32 = same_t<TIn, float>::v;
    const int tid = threadIdx.x, wid = __builtin_amdgcn_readfirstlane(tid >> 6), lane = tid & 63, r32 = lane & 31, hi = lane >> 5;
    const int sr = tid >> 4, sc = (tid & 15) * 8, kws = KSWZ(sr, sc * 2); char* K_lds = lds + 2 * SHM_V;
    const int kb0 = cur.jlo * KVBLK;
    for (int d0 = 0; d0 < 8; ++d0) S.qr[d0] = load8<TIn>(cur.Q + (size_t)(wid * QBLK + r32) * D + d0 * 16 + hi * 8);
    if constexpr (F32) { SLOAD_F((const float*)cur.K, kb0); VMW(); SWRITE_KF(0); SBAR(); SLOAD_F((const float*)cur.V, kb0); }
    else { SLOAD_H(cur.K, cur.V, kb0); VMW(); SWRITE_HK(0); }
    __syncthreads();
}
template <class TIn, class TOut>
__device__ __forceinline__ void causal_swa_block(const BlockRef<TIn, TOut>& cur, const BlockRef<TIn, TOut>& nxt, int skv, int W, char* lds, Seam<TIn>& S) {
    constexpr bool F32 = same_t<TIn, float>::v;
    const int tid = threadIdx.x, wid = __builtin_amdgcn_readfirstlane(tid >> 6), lane = tid & 63, r32 = lane & 31, hi = lane >> 5;
    const int j_lo = cur.jlo;
    int j_hi = (cur.P0 + QB - 1) / KVBLK + 1; if (j_hi > skv / KVBLK) j_hi = skv / KVBLK;
    const int NT = j_hi - j_lo;
    const int kbn = nxt.jlo * KVBLK;
    const int qlo = cur.P0 + wid * QBLK, qm = qlo + r32 - 4 * hi;
    char* V_lds = lds; char* K_lds = lds + 2 * SHM_V;
    float* ws = (float*)(lds + 2 * SHM_V + 2 * SHM_K) + wid * 64; float* li_l = ws, * al_l = ws + 32;
    float m_reg = -1e30f, l_reg = 0; f32x16 o[4] = {};
    const int sr = tid >> 4, sc = (tid & 15) * 8, vst0 = v_st(sr, sc), vst1 = v_st(32 + sr, sc), kws = KSWZ(sr, sc * 2);
    const int vb0 = (int)(uintptr_t)V_lds + v_rd_base(lane);
    const TIn* Kh = cur.K; const TIn* Vh = cur.V;
    float* Flt = (float*)(lds + FL_OFF); float* RKt = (float*)(lds + RK_OFF); const float* GGt = (const float*)(lds + GG_OFF); float* wsum = (float*)(lds + SCR_OFF);
    { const int s0 = j_lo * KVBLK, len = cur.P0 + QB - s0;
      float carry = 0.f;
      for (int base = 0; base < len; base += NW * 64) { const int i = base + tid;
          float x = (i < len) ? cur.LS[s0 + i] : 0.f;
#pragma unroll
          for (int o = 1; o < 64; o <<= 1) { const float y = __shfl_up(x, o); if (lane >= o) x += y; }
          if (lane == 63) wsum[wid] = x;
          __syncthreads();
          float off = carry, tot = 0.f;
#pragma unroll
          for (int w = 0; w < NW; ++w) { const float ws_ = wsum[w]; tot += ws_; if (w < wid) off += ws_; }
          if (i < len) { Flt[i] = -(x + off) * LOG2E;
              const f32x4 pk = *(const f32x4*)(cur.PK + (size_t)(s0 + i) * 64);
              RKt[i] = (SCALE * LOG2E) / sqrtf(((pk[0] + pk[1]) + (pk[2] + pk[3])) * (1.f / 128.f) + 1e-6f); }
          carry += tot;
          __syncthreads(); }
      const f32x4 pq = *(const f32x4*)(cur.PQ + (size_t)(cur.P0 + wid * QBLK + r32) * 64);
      const float rq = 1.f / sqrtf(((pq[0] + pq[1]) + (pq[2] + pq[3])) * (1.f / 128.f) + 1e-6f);
#pragma unroll
      for (int d0 = 0; d0 < 8; ++d0) { const f32x4 g0 = *(const f32x4*)(GGt + d0 * 16 + hi * 8), g1 = *(const f32x4*)(GGt + d0 * 16 + hi * 8 + 4);
          f32x4 a, b;
#pragma unroll
          for (int j = 0; j < 4; ++j) { a[j] = __uint_as_float(((unsigned)(unsigned short)S.qr[d0][j]) << 16) * (rq * g0[j]); b[j] = __uint_as_float(((unsigned)(unsigned short)S.qr[d0][4 + j]) << 16) * (rq * g1[j]); }
          S.qr[d0] = pack8(a, b); }
    }
    const float* Flb = Flt + 4 * hi; const float* RKb = RKt + 4 * hi;
#define RESC(a) do { if (__any((a) < 1.f)) { if (hi == 0) al_l[r32] = (a); asm volatile("s_waitcnt lgkmcnt(0)" ::: "memory");              \
                     for (int d_ = 0; d_ < 4; ++d_) for (int r = 0; r < 16; ++r) o[d_][r] *= al_l[crow(r, hi)]; } } while (0)
#define KBASE(t) ((j_lo + (t)) * KVBLK)
#define ACT(t) (KBASE(t) <= qlo + QBLK - 1 && KBASE(t) + KVBLK - 1 >= qlo - W + 1)
#define MASKT(P0_, P1_, t) do { const int kb_ = KBASE(t); if ((!SK || ACT(t)) && (kb_ + KVBLK - 1 > qlo || kb_ <= qlo + QBLK - 1 - W)) mask_tile(P0_, P1_, qm - kb_, (unsigned)W); } while (0)
    constexpr int NQL = F32 ? 16 : 8;
    constexpr bool SK = WSKIP && !F32;
#define SEAM_K0() do { VMWN(NQL); if constexpr (F32) { SWRITE_KF(0); SBAR(); SLOAD_F((const float*)nxt.V, kbn); } else { SWRITE_HK(0); } SBAR(); } while (0)
    f32x16 pA0, pA1, pB0, pB1; float mnA, mnB, alA, alB; bf16x8 pa0, pa1, pa2, pa3;
    if constexpr (F32) { VMW(); SWRITE_VF(0); SBAR(); } else { SWRITE_HV(0); SBAR(); }
    if (NT > 1) { if constexpr (F32) SLOAD_F((const float*)Kh, KBASE(1)); else SLOAD_H(Kh, Vh, KBASE(1)); }
    SBAR(); qkt<0, SK>(pA0, pA1, K_lds, r32, hi, S.qr, ACT(0));
    if constexpr (F32) { if (NT > 1) { VMW(); SWRITE_KF(1); SBAR(); SLOAD_F((const float*)Vh, KBASE(1)); } }
    MASKT(pA0, pA1, 0); partialSM(pA0, pA1, Flb, RKb, m_reg, mnA, alA);
    if (NT > 1) { VMW(); if constexpr (F32) { SWRITE_VF(1); SBAR(); if (NT > 2) SLOAD_F((const float*)Kh, KBASE(2)); } else SWRITE_H(1); }
    __syncthreads();
#define HALF_STEP(PX0, PX1, mnX, alX, PY0, PY1, alY, t, KB, VB, SB) do {                                                      \
        SBAR(); qkt<KB, SK>(PX0, PX1, K_lds, r32, hi, S.qr, ACT(t));                                             \
        finishSM(PY0, PY1, alY, l_reg, pa0, pa1, pa2, pa3); SBAR();                                                           \
        if ((t) + 1 < NT) { if constexpr (F32) { VMW(); SWRITE_KF(SB); SBAR(); SLOAD_F((const float*)Vh, KBASE((t) + 1)); }  \
                            else { SLOAD_H(Kh, Vh, KBASE((t) + 1)); } SBAR(); }                                               \
        pv_tile<VB, SK>(o, vb0, pa0, pa1, pa2, pa3, ACT((t) - 1)); MASKT(PX0, PX1, (t)); partialSM(PX0, PX1, Flb + (t) * KVBLK, RKb + (t) * KVBLK, m_reg, mnX, alX);                                        \
        __syncthreads();                                                                                                      \
        if ((t) + 1 < NT) { VMW(); if constexpr (F32) { SWRITE_VF(SB); SBAR(); if ((t) + 2 < NT) SLOAD_F((const float*)Kh, KBASE((t) + 2)); } \
                            else { SWRITE_H(SB); } }                                                                          \
        RESC(alX); __syncthreads(); } while (0)
    for (int t = 1; t + 1 < NT; t += 2) {
        HALF_STEP(pB0, pB1, mnB, alB, pA0, pA1, alA, t, 1, 0, 0);
        HALF_STEP(pA0, pA1, mnA, alA, pB0, pB1, alB, t + 1, 0, 1, 1);
    }
    const bool even = (NT & 1) == 0;
    if (even) { SBAR(); qkt<1, SK>(pB0, pB1, K_lds, r32, hi, S.qr, ACT(NT - 1)); SBAR(); }
#define QROW(e) (nxt.Q + (size_t)(wid * QBLK + r32) * D + ((e) >> 1) * 16 + hi * 8 + ((e) & 1) * 4)
    if constexpr (F32) { SLOAD_F((const float*)nxt.K, kbn); SBAR();
#pragma unroll
        for (int e = 0; e < 8; ++e) S.tq[e] = *(const f32x4*)QROW(e); }
    else { SLOAD_H(nxt.K, nxt.V, kbn); SBAR();
#pragma unroll
        for (int d0 = 0; d0 < 8; ++d0) S.qr[d0] = load8<TIn>(nxt.Q + (size_t)(wid * QBLK + r32) * D + d0 * 16 + hi * 8); }
    SBAR();
    finishSM(pA0, pA1, alA, l_reg, pa0, pa1, pa2, pa3); SBAR();
    if constexpr (F32) {
#pragma unroll
        for (int e = 8; e < 16; ++e) S.tq[e] = *(const f32x4*)QROW(e); SBAR(); }
#undef QROW
    pv_tile<0, SK>(o, vb0, pa0, pa1, pa2, pa3, ACT(even ? NT - 2 : NT - 1));
    if (even) { MASKT(pB0, pB1, NT - 1); partialSM(pB0, pB1, Flb + (NT - 1) * KVBLK, RKb + (NT - 1) * KVBLK, m_reg, mnB, alB); __syncthreads(); RESC(alB);
        finishSM(pB0, pB1, alB, l_reg, pa0, pa1, pa2, pa3); SBAR(); pv_tile<1, SK>(o, vb0, pa0, pa1, pa2, pa3, ACT(NT - 1)); }
    SBAR(); SEAM_K0();
    if (hi == 0) li_l[r32] = l_reg; asm volatile("s_waitcnt lgkmcnt(0)" ::: "memory");
    float rli[16];
#pragma unroll
    for (int r = 0; r < 16; ++r) rli[r] = __builtin_amdgcn_rcpf(li_l[crow(r, hi)]);
    TOut* Ow = cur.O + (size_t)(wid * QBLK) * OPITCH;
#pragma unroll
    for (int r = 0; r < 16; ++r) { const int orow = crow(r, hi);
#pragma unroll
        for (int d0 = 0; d0 < 4; ++d0) { const float v = o[d0][r] * rli[r];
            if constexpr (same_t<TOut, float>::v) { Ow[(size_t)orow * OPITCH + d0 * 32 + r32] = v; }
            else { const float vn = __shfl_xor(v, 1);
                   if ((r32 & 1) == 0) *(unsigned*)(Ow + (size_t)orow * OPITCH + d0 * 32 + r32) = cvtpk(v, vn); } } }
    if constexpr (F32) {
#pragma unroll
        for (int d0 = 0; d0 < 8; ++d0) S.qr[d0] = pack8(S.tq[2 * d0], S.tq[2 * d0 + 1]); }
    __syncthreads();
#undef RESC
#undef KBASE
#undef ACT
#undef MASKT
#undef SEAM_K0
#undef HALF_STEP
}
#undef ROW
#undef VMW
#undef VMWN
#undef SLOAD_H
#undef SWRITE_HK
#undef SWRITE_HV
#undef SWRITE_H
#undef SLOAD_F
#undef SWRITE_KF
#undef SWRITE_VF

template <class TIn, class TOut>
__device__ __forceinline__ void fox_block(const BlockRef<TIn, TOut>& cur, char* lds) {
    int tid_ = threadIdx.x; asm volatile("" : "+v"(tid_));
    const int tid = tid_, wid = __builtin_amdgcn_readfirstlane(tid >> 6), lane = tid & 63, r32 = lane & 31, hi = lane >> 5;
    const int j_lo = cur.jlo, NT = (cur.P0 + QB) / KVBLK - j_lo;
    const int qlo = cur.P0 + wid * QBLK, qm = qlo + r32 - 4 * hi;
    char* V_lds = lds; char* K_lds = lds + 2 * SHM_V;
    float* ws = (float*)(lds + 2 * SHM_V + 2 * SHM_K) + wid * 64; float* li_l = ws, * al_l = ws + 32;
    const int sr = tid >> 4, sc = (tid & 15) * 8, vst0 = v_st(sr, sc), vst1 = v_st(32 + sr, sc), kws = KSWZ(sr, sc * 2);
    const int vb0 = (int)(uintptr_t)V_lds + v_rd_base(lane);
    float* Flt = (float*)(lds + FL_OFF); float* RKt = (float*)(lds + RK_OFF); const float* GGt = (const float*)(lds + GG_OFF); float* wsum = (float*)(lds + SCR_OFF);
    bf16x8 st_v0, st_v1, st_k0, st_k1;
#define FB_LOAD(j) do { const size_t o_ = (size_t)((j) * KVBLK + sr) * D + sc; st_v0 = load8<TIn>(cur.V + o_); st_v1 = load8<TIn>(cur.V + o_ + 32 * D); st_k0 = load8<TIn>(cur.K + o_); st_k1 = load8<TIn>(cur.K + o_ + 32 * D); } while (0)
#define FB_WRITE(bf) do { *(bf16x8*)(K_lds + (bf) * SHM_K + kws) = st_k0; *(bf16x8*)(K_lds + (bf) * SHM_K + kws + 32 * 256) = st_k1; *(bf16x8*)(V_lds + (bf) * SHM_V + vst0) = st_v0; *(bf16x8*)(V_lds + (bf) * SHM_V + vst1) = st_v1; } while (0)
    FB_LOAD(j_lo);
    bf16x8 qr[8];
#pragma unroll
    for (int d0 = 0; d0 < 8; ++d0) qr[d0] = load8<TIn>(cur.Q + (size_t)(wid * QBLK + r32) * D + d0 * 16 + hi * 8);
    { const int s0 = j_lo * KVBLK, len = cur.P0 + QB - s0;
      float carry = 0.f;
      for (int base = 0; base < len; base += NW * 64) { const int i = base + tid;
          float x = (i < len) ? cur.LS[s0 + i] : 0.f;
#pragma unroll
          for (int o = 1; o < 64; o <<= 1) { const float y = __shfl_up(x, o); if (lane >= o) x += y; }
          if (lane == 63) wsum[wid] = x;
          __syncthreads();
          float off = carry, tot = 0.f;
#pragma unroll
          for (int w = 0; w < NW; ++w) { const float ws_ = wsum[w]; tot += ws_; if (w < wid) off += ws_; }
          if (i < len) { Flt[i] = -(x + off) * LOG2E;
              const f32x4 pk = *(const f32x4*)(cur.PK + (size_t)(s0 + i) * 64);
              RKt[i] = (SCALE * LOG2E) / sqrtf(((pk[0] + pk[1]) + (pk[2] + pk[3])) * (1.f / 128.f) + 1e-6f); }
          carry += tot;
          __syncthreads(); }
      const f32x4 pq = *(const f32x4*)(cur.PQ + (size_t)(cur.P0 + wid * QBLK + r32) * 64);
      const float rq = 1.f / sqrtf(((pq[0] + pq[1]) + (pq[2] + pq[3])) * (1.f / 128.f) + 1e-6f);
#pragma unroll
      for (int d0 = 0; d0 < 8; ++d0) { const f32x4 g0 = *(const f32x4*)(GGt + d0 * 16 + hi * 8), g1 = *(const f32x4*)(GGt + d0 * 16 + hi * 8 + 4);
          f32x4 a, b;
#pragma unroll
          for (int j = 0; j < 4; ++j) { a[j] = __uint_as_float(((unsigned)(unsigned short)qr[d0][j]) << 16) * (rq * g0[j]); b[j] = __uint_as_float(((unsigned)(unsigned short)qr[d0][4 + j]) << 16) * (rq * g1[j]); }
          qr[d0] = pack8(a, b); }
    }
    const float* Flb = Flt + 4 * hi; const float* RKb = RKt + 4 * hi;
    asm volatile("s_waitcnt vmcnt(0)" ::: "memory"); FB_WRITE(0);
    __syncthreads();
    float m_reg = -1e30f, l_reg = 0; f32x16 o[4] = {};
    for (int t = 0; t < NT; ++t) {
        const int buf = t & 1, kb = (j_lo + t) * KVBLK;
        if (t + 1 < NT) FB_LOAD(j_lo + t + 1);
        if (kb <= qlo + QBLK - 1) {
            f32x16 p0, p1; float mn, al; bf16x8 pa0, pa1, pa2, pa3;
            qkt<0, false>(p0, p1, K_lds + buf * SHM_K, r32, hi, qr, true);
            if (kb + KVBLK - 1 > qlo) mask_tile(p0, p1, qm - kb, (unsigned)WBIG);
            partialSM(p0, p1, Flb + t * KVBLK, RKb + t * KVBLK, m_reg, mn, al);
            if (__any(al < 1.f)) { if (hi == 0) al_l[r32] = al; asm volatile("s_waitcnt lgkmcnt(0)" ::: "memory");
                for (int d_ = 0; d_ < 4; ++d_) for (int r = 0; r < 16; ++r) o[d_][r] *= al_l[crow(r, hi)]; }
            finishSM(p0, p1, al, l_reg, pa0, pa1, pa2, pa3); SBAR();
            pv_tile<0, false>(o, vb0 + buf * SHM_V, pa0, pa1, pa2, pa3, true);
        }
        if (t + 1 < NT) { asm volatile("s_waitcnt vmcnt(0)" ::: "memory"); FB_WRITE(buf ^ 1); }
        __syncthreads();
    }
    if (hi == 0) li_l[r32] = l_reg; asm volatile("s_waitcnt lgkmcnt(0)" ::: "memory");
    float rli[16];
#pragma unroll
    for (int r = 0; r < 16; ++r) rli[r] = __builtin_amdgcn_rcpf(li_l[crow(r, hi)]);
    TOut* Ow = cur.O + (size_t)(wid * QBLK) * OPITCH;
#pragma unroll
    for (int r = 0; r < 16; ++r) { const int orow = crow(r, hi);
#pragma unroll
        for (int d0 = 0; d0 < 4; ++d0) { const float v = o[d0][r] * rli[r]; const float vn = __shfl_xor(v, 1);
            if ((r32 & 1) == 0) *(unsigned*)(Ow + (size_t)orow * OPITCH + d0 * 32 + r32) = cvtpk(v, vn); } }
    __syncthreads();
#undef FB_LOAD
#undef FB_WRITE
}
}
namespace hg {
#define HG_LAS __attribute__((address_space(3)))
typedef short bf16x8 __attribute__((ext_vector_type(8)));
typedef short s16x4 __attribute__((ext_vector_type(4)));
typedef float f32x4 __attribute__((ext_vector_type(4)));
typedef unsigned u32x4 __attribute__((ext_vector_type(4)));
constexpr int RB = 272;
constexpr int PL = 0, KT = 64 * RB, KH = 2 * 64 * RB, VL = 3 * 64 * RB, A1 = 4 * 64 * RB, A1RB = 144, SK = A1 + 64 * A1RB, SC = SK + 128 * RB, B63 = SC + 8 * 128 * 4, DK = B63 + 512, HG_END = DK + 512;
constexpr int OL = 0, ORB = 132 * 4;
static_assert(64 * ORB <= 2 * 64 * RB && HG_END <= 131072, "hgrn LDS map");
typedef float f32x2_t __attribute__((ext_vector_type(2))); typedef __bf16 bf16x2_t __attribute__((ext_vector_type(2)));
__device__ __forceinline__ unsigned cvtpk(float lo, float hi) { f32x2_t v = {lo, hi}; bf16x2_t b = __builtin_convertvector(v, bf16x2_t); return __builtin_bit_cast(unsigned, b); }
__device__ __forceinline__ float bf_lo(unsigned w) { return __uint_as_float(w << 16); }
__device__ __forceinline__ float bf_hi(unsigned w) { return __uint_as_float(w & 0xffff0000u); }
__device__ __forceinline__ s16x4 vtr(const HG_LAS char* p) { typedef short v4i16_t __attribute__((ext_vector_type(4))); return __builtin_bit_cast(s16x4, __builtin_amdgcn_ds_read_tr16_b64_v4i16((HG_LAS v4i16_t*)p)); }
__device__ __forceinline__ bf16x8 tr2(const HG_LAS char* base, int row0, int col0, int lane) {
    const int i = lane & 15, kq = lane >> 4; const HG_LAS char* p = base + (row0 + 8 * kq + (i >> 2)) * RB + (col0 + 4 * (i & 3)) * 2;
    const s16x4 lo = vtr(p), hi = vtr(p + 4 * RB); return (bf16x8){lo[0], lo[1], lo[2], lo[3], hi[0], hi[1], hi[2], hi[3]};
}
__device__ __forceinline__ bf16x8 rd8(const HG_LAS char* base, int pitch, int row0, int col0, int lane) { return *(const HG_LAS bf16x8*)(base + (row0 + (lane & 15)) * pitch + (col0 + 8 * (lane >> 4)) * 2); }
#define HG_MFMA(a, b, c) __builtin_amdgcn_mfma_f32_16x16x32_bf16(a, b, c, 0, 0, 0)

struct SeqArgs { unsigned short* out2; const unsigned short* qb; const unsigned short* fb; const unsigned short* ib; const unsigned short* gb; unsigned short* out; const HG_LAS float* lb; const float* ghn; int nchunk; };
__device__ __forceinline__ void hgrn_sequence(HG_LAS char* lds, const SeqArgs a) {
    int tid_ = threadIdx.x; asm volatile("" : "+v"(tid_));
    const int tid = tid_, wid = __builtin_amdgcn_readfirstlane(tid >> 6), lane = tid & 63;
    const int kc = tid & 15, tg = tid >> 4;
    constexpr float LOG2E = 1.4426950408889634f, LN2 = 0.6931471805599453f;
    float lbv[8];
#pragma unroll
    for (int e = 0; e < 8; ++e) lbv[e] = a.lb[8 * kc + e];
    f32x4 sT[8];
#pragma unroll
    for (int kb = 0; kb < 8; ++kb) sT[kb] = (f32x4){0.f, 0.f, 0.f, 0.f};
    for (int i = tid; i < 128 * RB / 16; i += 512) *(HG_LAS u32x4*)(lds + SK + i * 16) = (u32x4){0u, 0u, 0u, 0u};
    const size_t eoff = (size_t)(2 * tg) * 128 + 8 * kc;
    u32x4 zr[2], qr[2], vr[2];
#pragma unroll
    for (int r = 0; r < 2; ++r) { zr[r] = *(const u32x4*)(a.fb + eoff + r * 128); qr[r] = *(const u32x4*)(a.qb + eoff + r * 128); vr[r] = *(const u32x4*)(a.ib + eoff + r * 128); }
    __syncthreads();
#if defined(HG_CHECK)
    for (int c2 = 0; c2 < 2 * a.nchunk; ++c2) { const int c = c2 % a.nchunk; unsigned short* const outp = (c2 < a.nchunk) ? a.out : a.out2;
        if (c2 == a.nchunk) {
#pragma unroll
            for (int kb = 0; kb < 8; ++kb) sT[kb] = (f32x4){0.f, 0.f, 0.f, 0.f};
            for (int i = tid; i < 128 * RB / 16; i += 512) *(HG_LAS u32x4*)(lds + SK + i * 16) = (u32x4){0u, 0u, 0u, 0u};
            __syncthreads(); }
#else
    for (int c = 0; c < a.nchunk; ++c) { unsigned short* const outp = a.out;
#endif
        float g0[8], tot[8], inc[8];
#pragma unroll
        for (int e = 0; e < 8; ++e) { const float omlb = 1.f - lbv[e];
            const unsigned w0 = zr[0][e >> 1], w1 = zr[1][e >> 1]; const float z0 = (e & 1) ? bf_hi(w0) : bf_lo(w0), z1 = (e & 1) ? bf_hi(w1) : bf_lo(w1);
            const float s0 = __builtin_amdgcn_rcpf(1.f + __builtin_amdgcn_exp2f(-z0 * LOG2E)), s1 = __builtin_amdgcn_rcpf(1.f + __builtin_amdgcn_exp2f(-z1 * LOG2E));
            g0[e] = __builtin_amdgcn_logf(lbv[e] + omlb * s0) * LN2; tot[e] = g0[e] + __builtin_amdgcn_logf(lbv[e] + omlb * s1) * LN2; inc[e] = tot[e]; }
#pragma unroll
        for (int e = 0; e < 8; ++e) { float y = __shfl_up(inc[e], 16); if (lane >= 16) inc[e] += y; y = __shfl_up(inc[e], 32); if (lane >= 32) inc[e] += y; }
        if (lane >= 48) {
#pragma unroll
            for (int e = 0; e < 8; ++e) ((HG_LAS float*)(lds + SC))[wid * 128 + 8 * kc + e] = inc[e]; }
        __syncthreads();
        float b63[8];
#pragma unroll
        for (int e = 0; e < 8; ++e) { float off = 0.f, all = 0.f;
#pragma unroll
            for (int w = 0; w < 8; ++w) { const float s = ((const HG_LAS float*)(lds + SC))[w * 128 + 8 * kc + e]; all += s; if (w < wid) off += s; }
            inc[e] = off + inc[e] - tot[e]; b63[e] = all * LOG2E; }
        if (tg == 0) {
#pragma unroll
            for (int e = 0; e < 8; ++e) ((HG_LAS float*)(lds + DK))[8 * kc + e] = __builtin_amdgcn_exp2f(b63[e]); }
#pragma unroll
        for (int r = 0; r < 2; ++r) { float pv[8], kt[8], kh[8];
#pragma unroll
            for (int e = 0; e < 8; ++e) { const unsigned wz = zr[r][e >> 1]; const float z = (e & 1) ? bf_hi(wz) : bf_lo(wz);
                const float km = (1.f - lbv[e]) * (1.f - __builtin_amdgcn_rcpf(1.f + __builtin_amdgcn_exp2f(-z * LOG2E)));
                const unsigned w = qr[r][e >> 1]; const float q = (e & 1) ? bf_hi(w) : bf_lo(w);
                const float sq = q * __builtin_amdgcn_rcpf(1.f + __builtin_amdgcn_exp2f(-q * LOG2E)); const float bl = (inc[e] + (r ? tot[e] : g0[e])) * LOG2E;
                pv[e] = sq * __builtin_amdgcn_exp2f(bl); kt[e] = km * __builtin_amdgcn_exp2f(-bl); kh[e] = km * __builtin_amdgcn_exp2f(b63[e] - bl); }
            const int ro = (2 * tg + r) * RB + 16 * kc;
            *(HG_LAS u32x4*)(lds + PL + ro) = (u32x4){cvtpk(pv[0], pv[1]), cvtpk(pv[2], pv[3]), cvtpk(pv[4], pv[5]), cvtpk(pv[6], pv[7])};
            *(HG_LAS u32x4*)(lds + KT + ro) = (u32x4){cvtpk(kt[0], kt[1]), cvtpk(kt[2], kt[3]), cvtpk(kt[4], kt[5]), cvtpk(kt[6], kt[7])};
            *(HG_LAS u32x4*)(lds + KH + ro) = (u32x4){cvtpk(kh[0], kh[1]), cvtpk(kh[2], kh[3]), cvtpk(kh[4], kh[5]), cvtpk(kh[6], kh[7])};
            *(HG_LAS u32x4*)(lds + VL + ro) = vr[r]; }
#if defined(HG_CHECK)
        if (c2 + 1 < 2 * a.nchunk) { const size_t no = eoff + (size_t)((c + 1) % a.nchunk) * 64 * 128;
#else
        if (c + 1 < a.nchunk) { const size_t no = eoff + (size_t)(c + 1) * 64 * 128;
#endif
#pragma unroll
            for (int r = 0; r < 2; ++r) { zr[r] = *(const u32x4*)(a.fb + no + r * 128); qr[r] = *(const u32x4*)(a.qb + no + r * 128); vr[r] = *(const u32x4*)(a.ib + no + r * 128); } }
        __syncthreads();
        const int tb = wid >> 1, q4 = lane >> 4, n16 = lane & 15;
        { const int sb0 = 2 * (wid & 1); f32x4 c0 = {0.f, 0.f, 0.f, 0.f}, c1 = {0.f, 0.f, 0.f, 0.f};
          if (sb0 <= tb) {
#pragma unroll
            for (int ks = 0; ks < 4; ++ks) { const bf16x8 af = rd8(lds + PL, RB, 16 * tb, 32 * ks, lane);
                c0 = HG_MFMA(af, rd8(lds + KT, RB, 16 * sb0, 32 * ks, lane), c0); c1 = HG_MFMA(af, rd8(lds + KT, RB, 16 * sb0 + 16, 32 * ks, lane), c1); } }
#pragma unroll
          for (int r = 0; r < 4; ++r) { const int t = 16 * tb + 4 * q4 + r, s0 = 16 * sb0 + n16, s1 = s0 + 16;
              const float x0 = (s0 <= t) ? c0[r] : 0.f, x1 = (s1 <= t) ? c1[r] : 0.f;
              *(HG_LAS unsigned short*)(lds + A1 + t * A1RB + s0 * 2) = (unsigned short)(cvtpk(x0, 0.f) & 0xffffu);
              *(HG_LAS unsigned short*)(lds + A1 + t * A1RB + s1 * 2) = (unsigned short)(cvtpk(x1, 0.f) & 0xffffu); } }
        __syncthreads();
        f32x4 oc[4];
#pragma unroll
        for (int j = 0; j < 4; ++j) oc[j] = (f32x4){0.f, 0.f, 0.f, 0.f};
        { const int vb0 = 4 * (wid & 1);
#pragma unroll
          for (int ks = 0; ks < 4; ++ks) { const bf16x8 af = rd8(lds + PL, RB, 16 * tb, 32 * ks, lane);
#pragma unroll
              for (int j = 0; j < 4; ++j) oc[j] = HG_MFMA(af, tr2(lds + SK, 32 * ks, 16 * (vb0 + j), lane), oc[j]); }
#pragma unroll
          for (int ks = 0; ks < 2; ++ks) { const bf16x8 af = rd8(lds + A1, A1RB, 16 * tb, 32 * ks, lane);
#pragma unroll
              for (int j = 0; j < 4; ++j) oc[j] = HG_MFMA(af, tr2(lds + VL, 32 * ks, 16 * (vb0 + j), lane), oc[j]); } }
        __syncthreads();
        u32x4 gcur[2];
#pragma unroll
        for (int r = 0; r < 2; ++r) gcur[r] = *(const u32x4*)(a.gb + eoff + (size_t)c * 64 * 128 + r * 128);
        { const int vb0 = 4 * (wid & 1);
#pragma unroll
          for (int j = 0; j < 4; ++j)
#pragma unroll
              for (int r = 0; r < 4; ++r) *(HG_LAS float*)(lds + OL + (16 * tb + 4 * q4 + r) * ORB + (16 * (vb0 + j) + n16) * 4) = oc[j][r]; }
#pragma unroll
        for (int kb = 0; kb < 8; ++kb) { const float d = ((const HG_LAS float*)(lds + DK))[16 * kb + n16]; sT[kb] = sT[kb] * d; }
#pragma unroll
        for (int ks = 0; ks < 2; ++ks) { const bf16x8 af = tr2(lds + VL, 32 * ks, 16 * wid, lane);
#pragma unroll
            for (int kb = 0; kb < 8; ++kb) sT[kb] = HG_MFMA(af, tr2(lds + KH, 32 * ks, 16 * kb, lane), sT[kb]); }
#pragma unroll
        for (int kb = 0; kb < 8; ++kb) { typedef unsigned u32x2 __attribute__((ext_vector_type(2)));
            *(HG_LAS u32x2*)(lds + SK + (16 * kb + n16) * RB + (16 * wid + 4 * q4) * 2) = (u32x2){cvtpk(sT[kb][0], sT[kb][1]), cvtpk(sT[kb][2], sT[kb][3])}; }
        __syncthreads();
#pragma unroll
        for (int r = 0; r < 2; ++r) { const int t = 2 * tg + r;
            const f32x4 o0 = *(const HG_LAS f32x4*)(lds + OL + t * ORB + 32 * kc), o1 = *(const HG_LAS f32x4*)(lds + OL + t * ORB + 32 * kc + 16);
            float ss = ((o0[0] * o0[0] + o0[1] * o0[1]) + (o0[2] * o0[2] + o0[3] * o0[3])) + ((o1[0] * o1[0] + o1[1] * o1[1]) + (o1[2] * o1[2] + o1[3] * o1[3]));
            ss += __shfl_xor(ss, 1); ss += __shfl_xor(ss, 2); ss += __shfl_xor(ss, 4); ss += __shfl_xor(ss, 8);
            const float rstd = 1.f / sqrtf(ss * (1.f / 128.f) + 1e-6f);
            float y[8];
#pragma unroll
            for (int e = 0; e < 8; ++e) { const unsigned w = gcur[r][e >> 1]; const float gt = (e & 1) ? bf_hi(w) : bf_lo(w);
                const float sgt = gt * __builtin_amdgcn_rcpf(1.f + __builtin_amdgcn_exp2f(-gt * LOG2E)); const float o = (e < 4) ? o0[e & 3] : o1[e & 3];
                y[e] = (o * rstd * a.ghn[8 * kc + e]) * sgt; }
            *(u32x4*)(outp + ((size_t)c * 64 + t) * 4096 + 8 * kc) = (u32x4){cvtpk(y[0], y[1]), cvtpk(y[2], y[3]), cvtpk(y[4], y[5]), cvtpk(y[6], y[7])}; }
        __syncthreads();
    }
}
#undef HG_MFMA
}
#define GAS __attribute__((address_space(1)))
#define LAS __attribute__((address_space(3)))
typedef unsigned short bf16;
typedef unsigned v4u __attribute__((ext_vector_type(4)));
typedef float f32x4 __attribute__((ext_vector_type(4)));
typedef short bf16x8 __attribute__((ext_vector_type(8)));
typedef GAS unsigned gu32;
typedef GAS unsigned long long gu64;
#define RLX_AGENT __ATOMIC_RELAXED, __HIP_MEMORY_SCOPE_AGENT
#define LDS_WAIT() asm volatile("s_waitcnt lgkmcnt(0)" ::: "memory")
#define VM_WAIT() asm volatile("s_waitcnt vmcnt(0)" ::: "memory")
__device__ __forceinline__ unsigned long long rt() { return __builtin_amdgcn_s_memrealtime(); }
__device__ __forceinline__ unsigned f2bf(float f) { unsigned u = __builtin_bit_cast(unsigned, f); return (u + 0x7fffu + ((u >> 16) & 1u)) >> 16; }
__device__ __forceinline__ unsigned pk2(float lo, float hi) { return f2bf(lo) | (f2bf(hi) << 16); }

#define XB_TMO      128
#define XB_XCNT(j)  (256  + 64 * (j))
#define XB_XSUB(j)  (1280 + 64 * (j))
#define XB_XGEN(j)  (2304 + 64 * (j))
#define XB_TOP      3328
#define XB_TOPGEN   3392
#define XCD_BAR_WORDS 3456
#define XB_SPIN_CAP (1u << 18)

__device__ __forceinline__ unsigned xb_ld(unsigned* p)              { return __hip_atomic_load(p, __ATOMIC_RELAXED, __HIP_MEMORY_SCOPE_AGENT); }
__device__ __forceinline__ unsigned xb_add(unsigned* p, unsigned v) { return __hip_atomic_fetch_add(p, v, __ATOMIC_RELAXED, __HIP_MEMORY_SCOPE_AGENT); }
__device__ __forceinline__ unsigned xb_xcc_id() { return (unsigned)__builtin_amdgcn_s_getreg((3 << 11) | 20) & 0xFu; }
#define XB_SPIN(cond, bar) do { unsigned _sp = 0; while (cond) { __builtin_amdgcn_s_sleep(1); \
    if ((++_sp & 255u) == 0u) { if (xb_ld(&(bar)[XB_TMO])) break; if (_sp > XB_SPIN_CAP) { atomicAdd(&(bar)[XB_TMO], 1u); break; } } } } while (0)

struct XcdBarrier {
    unsigned* bar; unsigned x;
    volatile LAS unsigned* st;
};

__device__ __forceinline__ XcdBarrier xcd_barrier_post(unsigned* bar, volatile LAS unsigned* st) {
    XcdBarrier b; b.bar = bar; b.x = xb_xcc_id(); b.st = st;
    if (threadIdx.x == 0) (void)xb_add(&bar[XB_XCNT(b.x)], 1u);
    return b;
}
__device__ __forceinline__ void xcd_barrier_complete(unsigned* bar, unsigned x, unsigned& nloc, unsigned& nx) {
    const unsigned G = gridDim.x * gridDim.y * gridDim.z;
    unsigned sum, cnt, mine, sp = 0u;
    for (;;) {
        sum = 0u; cnt = 0u; mine = 0u;
#pragma unroll
        for (unsigned j = 0; j < 16; ++j) { const unsigned c = xb_ld(&bar[XB_XCNT(j)]); sum += c; cnt += (c > 0u) ? 1u : 0u; mine = (j == x) ? c : mine; }
        if (sum == G) break;
        __builtin_amdgcn_s_sleep(1);
        if ((++sp & 255u) == 0u) { if (xb_ld(&bar[XB_TMO])) break; if (sp > XB_SPIN_CAP) { atomicAdd(&bar[XB_TMO], 1u); break; } }
    }
    nloc = mine > 0u ? mine : 1u; nx = cnt > 0u ? cnt : 1u;
}

__device__ __forceinline__ void xcd_barrier(const XcdBarrier& b) {
    asm volatile("s_waitcnt vmcnt(0)" ::: "memory");
    __syncthreads();
    if (threadIdx.x == 0) {
        unsigned* bar = b.bar;
        __builtin_amdgcn_s_waitcnt(0);
        unsigned nloc = b.st[0], nx = b.st[1];
        if (nloc == 0u) { xcd_barrier_complete(bar, b.x, nloc, nx); b.st[0] = nloc; b.st[1] = nx; }
        const unsigned old = xb_add(&bar[XB_XSUB(b.x)], 1u);
        const unsigned gen = old / nloc;
        if (old + 1u == (gen + 1u) * nloc) {
            __builtin_amdgcn_fence(__ATOMIC_RELEASE, "agent");
            asm volatile("s_waitcnt vmcnt(0)" ::: "memory");
            const unsigned og = xb_add(&bar[XB_TOP], 1u);
            const unsigned tg = og / nx;
            if (og + 1u == (tg + 1u) * nx) xb_add(&bar[XB_TOPGEN], 1u);
            else XB_SPIN(xb_ld(&bar[XB_TOPGEN]) == tg, bar);
            __builtin_amdgcn_fence(__ATOMIC_ACQUIRE, "agent");
            xb_add(&bar[XB_XGEN(b.x)], 1u);
            asm volatile("s_waitcnt vmcnt(0)" ::: "memory");
        } else {
            XB_SPIN(xb_ld(&bar[XB_XGEN(b.x)]) == gen, bar);
            __builtin_amdgcn_fence(__ATOMIC_ACQUIRE, "agent");
            asm volatile("s_waitcnt vmcnt(0)" ::: "memory");
        }
    }
    __syncthreads();
}
typedef unsigned short u16;
constexpr int NWAVES = 8;
constexpr int BATCH = 2, SEQ = 8192, DM = 4096, NH = 16, HD = 128, DFF = 16384, PLE = 256;
constexpr int M = BATCH * SEQ;
constexpr int NIN = 14352, NPROJ = 14336, FA_COL = 6144;
constexpr float RMS_EPS = 1e-6f;
constexpr size_t MiB = 1u << 20;
constexpr size_t WS_CTL = 0, CTL_ZERO_BYTES = 65536;
constexpr size_t WS_WFA = 1 * MiB;
constexpr size_t WS_LS = 2 * MiB;
constexpr size_t WS_BS = 3 * MiB;
constexpr size_t WS_PQK = 4 * MiB;
constexpr size_t WS_P1 = 12 * MiB, WS_P2 = 16 * MiB, WS_PE = 20 * MiB;
constexpr size_t WS_WOUT = 24 * MiB, WS_WUP = 56 * MiB, WS_WDOWN = 184 * MiB, WS_WGATE = 312 * MiB, WS_WPLE = 344 * MiB;
constexpr size_t WS_PB = 346 * MiB;
constexpr size_t WS_ACTA = 354 * MiB;
constexpr size_t WS_WIN = 482 * MiB;
constexpr size_t WS_PROJ = 594 * MiB;
constexpr size_t WS_H1B = 482 * MiB;
constexpr size_t WS_HID = 610 * MiB;
constexpr size_t WS_ERAW = 866 * MiB;
constexpr size_t WS_END = 1042 * MiB;
constexpr size_t PROJ_T = (size_t)2 * 16 * 8192 * 128;
constexpr int CW_TMO = 0, CW_BAR = 4096;
constexpr int LDS_BYTES = 163840;
constexpr int RING_OFF = 0;
constexpr int TAB_OFF = 160768, TAB_RS = TAB_OFF, TAB_RSE = TAB_OFF + 1024;
constexpr int MISC_OFF = 162816;
static_assert(fa::FA_LDS_END <= TAB_OFF && hg::HG_END <= TAB_OFF, "LDS map");

struct Frame {
    LAS unsigned char* lds; volatile LAS unsigned* MISC; gu32* ctl;
    int tid, lane, wave, vcu, G;
};
__device__ __forceinline__ float wave_sum(float v) {
#pragma unroll
    for (int o = 1; o < 64; o <<= 1) v += __shfl_xor(v, o);
    return v;
}
__device__ __forceinline__ void p0_transpose_item(const float* W, int ldw, int K, const float* g, u16* WT, int k0, int src0, int dst0, LAS float* scr, int lane) {
#pragma unroll 8
    for (int i = 0; i < 32; ++i) { const int kk = 2 * i + (lane >> 5); float w = W[(size_t)(k0 + kk) * ldw + src0 + (lane & 31)]; if (g) w *= g[k0 + kk]; scr[kk * 33 + (lane & 31)] = w; }
    LDS_WAIT(); asm volatile("" ::: "memory");
    const int c = lane & 7;
#pragma unroll
    for (int j = 0; j < 4; ++j) { const int n = (lane >> 3) + 8 * j; const LAS float* s = scr + (8 * c) * 33 + n;
        v4u o; o.x = pk2(s[0 * 33], s[1 * 33]); o.y = pk2(s[2 * 33], s[3 * 33]); o.z = pk2(s[4 * 33], s[5 * 33]); o.w = pk2(s[6 * 33], s[7 * 33]);
        *(GAS v4u*)(WT + (size_t)(dst0 + n) * K + k0 + 8 * c) = o; }
    LDS_WAIT(); asm volatile("" ::: "memory");
}
struct Args { const float* in[17]; float* out; unsigned char* ws; };
typedef const __attribute__((address_space(4))) Args KArgs;
__device__ __forceinline__ KArgs* karg_ptr() { KArgs* kp = (KArgs*)__builtin_amdgcn_kernarg_segment_ptr(); asm volatile("" : "+s"(kp)); return kp; }

__device__ __forceinline__ void p0_prologue(Frame& F) {
    KArgs& A = *karg_ptr(); unsigned char* ws = A.ws;
    LAS float* scr = (LAS float*)(F.lds + RING_OFF + F.wave * 16384);
    const int gw = F.vcu * NWAVES + F.wave, NGW = F.G * NWAVES;
    constexpr int I_IN = (DM / 64) * (NPROJ / 32), I_OUT = (DM / 64) * (DM / 32), I_UP = (DM / 64) * (DFF / 32), I_DN = (DFF / 64) * (DM / 32), I_GT = I_OUT, I_PL = (PLE / 64) * (DM / 32);
    constexpr int NITEMS = I_IN + I_OUT + I_UP + I_DN + I_GT + I_PL;
    for (int it = gw; it < NITEMS; it += NGW) {
        int r = it;
        if (r < I_IN) { const int nblk = NPROJ / 32, kb = r / nblk, nb = r % nblk, n0 = 32 * nb;
            p0_transpose_item(A.in[3], NIN, DM, nullptr, (u16*)(ws + WS_WIN), 64 * kb, n0 + (n0 >= FA_COL ? 16 : 0), n0, scr, F.lane); continue; } r -= I_IN;
        if (r < I_OUT) { const int nblk = DM / 32; p0_transpose_item(A.in[9], DM, DM, nullptr, (u16*)(ws + WS_WOUT), 64 * (r / nblk), 32 * (r % nblk), 32 * (r % nblk), scr, F.lane); continue; } r -= I_OUT;
        if (r < I_UP) { const int nblk = DFF / 32; p0_transpose_item(A.in[11], DFF, DM, A.in[10], (u16*)(ws + WS_WUP), 64 * (r / nblk), 32 * (r % nblk), 32 * (r % nblk), scr, F.lane); continue; } r -= I_UP;
        if (r < I_DN) { const int nblk = DM / 32; p0_transpose_item(A.in[12], DM, DFF, nullptr, (u16*)(ws + WS_WDOWN), 64 * (r / nblk), 32 * (r % nblk), 32 * (r % nblk), scr, F.lane); continue; } r -= I_DN;
        if (r < I_GT) { const int nblk = DM / 32; p0_transpose_item(A.in[14], DM, DM, A.in[13], (u16*)(ws + WS_WGATE), 64 * (r / nblk), 32 * (r % nblk), 32 * (r % nblk), scr, F.lane); continue; } r -= I_GT;
        { const int nblk = DM / 32; p0_transpose_item(A.in[15], DM, PLE, nullptr, (u16*)(ws + WS_WPLE), 64 * (r / nblk), 32 * (r % nblk), 32 * (r % nblk), scr, F.lane); }
    }
    { const int gt = F.vcu * 512 + F.tid, NT = F.G * 512;
      for (int i = gt; i < 16 * DM; i += NT) { const int n = i >> 12, k = i & 4095; ((u16*)(ws + WS_WFA))[i] = (u16)f2bf(A.in[3][(size_t)k * NIN + FA_COL + n]); }
      const f32x4* p4 = (const f32x4*)A.in[1]; unsigned long long* pb = (unsigned long long*)(ws + WS_PB);
      for (int i = gt; i < M * PLE / 4; i += NT) { const f32x4 v = p4[i]; pb[i] = (unsigned long long)pk2(v.x, v.y) | ((unsigned long long)pk2(v.z, v.w) << 32); } }
    { const f32x4* g4 = (const f32x4*)A.in[2]; u16* U = (u16*)(ws + WS_ACTA);
      for (int m = gw; m < M; m += NGW) { const f32x4* xr = (const f32x4*)(A.in[0] + (size_t)m * DM);
          f32x4 v[16]; float s = 0.f;
#pragma unroll
          for (int j = 0; j < 8; ++j) { v[2 * j] = xr[128 * j + 2 * F.lane]; v[2 * j + 1] = xr[128 * j + 2 * F.lane + 1]; }
#pragma unroll
          for (int j = 0; j < 16; ++j) s += (v[j].x * v[j].x + v[j].y * v[j].y) + (v[j].z * v[j].z + v[j].w * v[j].w);
          const float rstd = 1.f / sqrtf(wave_sum(s) * (1.f / DM) + RMS_EPS);
          v4u* o = (v4u*)(U + (size_t)m * DM);
#pragma unroll
          for (int j = 0; j < 8; ++j) { const f32x4 ga = g4[128 * j + 2 * F.lane], gb = g4[128 * j + 2 * F.lane + 1]; const f32x4 a = v[2 * j] * rstd * ga, b = v[2 * j + 1] * rstd * gb;
              v4u w; w.x = pk2(a.x, a.y); w.y = pk2(a.z, a.w); w.z = pk2(b.x, b.y); w.w = pk2(b.z, b.w); o[64 * j + F.lane] = w; } } }
}
__device__ __forceinline__ void fa_tile(Frame& F, int tile) {
    KArgs& A = *karg_ptr(); unsigned char* ws = A.ws; const u16* U = (const u16*)(ws + WS_ACTA); const u16* WF = (const u16*)(ws + WS_WFA);
    const int R0 = tile * 64, b = R0 >> 13, t0 = R0 & 8191, rb = F.wave & 3, kh = F.wave >> 2, n16 = F.lane & 15, q4 = F.lane >> 4;
    f32x4 acc = {0.f, 0.f, 0.f, 0.f};
    const u16* ap = U + (size_t)(R0 + 16 * rb + n16) * DM + kh * 2048 + 8 * q4; const u16* bp = WF + (size_t)n16 * DM + kh * 2048 + 8 * q4;
#pragma unroll 8
    for (int s = 0; s < 64; ++s) acc = __builtin_amdgcn_mfma_f32_16x16x32_bf16(*(const bf16x8*)(ap + 32 * s), *(const bf16x8*)(bp + 32 * s), acc, 0, 0, 0);
    LAS float* red = (LAS float*)(F.lds + RING_OFF);
    LAS float* bsum = (LAS float*)(F.lds + RING_OFF + 4096);
    if (kh == 1) *(LAS f32x4*)(red + (rb * 64 + F.lane) * 4) = acc;
    __syncthreads();
    if (kh == 0) { const f32x4 o = *(const LAS f32x4*)(red + (rb * 64 + F.lane) * 4); const float bias = A.in[4][n16]; float ts = 0.f;
        float* LS = (float*)(ws + WS_LS) + (size_t)(b * 16 + n16) * 8192 + t0 + 16 * rb + 4 * q4;
        f32x4 l;
#pragma unroll
        for (int r = 0; r < 4; ++r) { const float v = acc[r] + o[r] + bias; l[r] = fminf(v, 0.f) - __builtin_amdgcn_logf(1.f + __builtin_amdgcn_exp2f(-fabsf(v) * 1.4426950408889634f)) * 0.6931471805599453f; ts += l[r]; }
        *(f32x4*)LS = l;
        ts += __shfl_xor(ts, 16); ts += __shfl_xor(ts, 32);
        if (q4 == 0) bsum[rb * 16 + n16] = ts; }
    __syncthreads();
    if (F.tid < 16) { const float s = (bsum[F.tid] + bsum[16 + F.tid]) + (bsum[32 + F.tid] + bsum[48 + F.tid]); ((float*)(ws + WS_BS))[(b * 16 + F.tid) * 128 + (t0 >> 6)] = s; }
    __syncthreads();
}
__device__ __forceinline__ void row_table(Frame& F, const float* part, int row0, LAS float* tab) {
    if (F.tid < 256) { const f32x4* p = (const f32x4*)(part + (size_t)(row0 + F.tid) * 64); float s = 0.f;
#pragma unroll
        for (int j = 0; j < 16; ++j) { const f32x4 v = p[j]; s += (v.x + v.y) + (v.z + v.w); }
        tab[F.tid] = 1.f / sqrtf(s * (1.f / DM) + RMS_EPS); }
    __syncthreads();
}

typedef __hip_bfloat16 hbf; typedef fa::BlockRef<hbf, hbf> FoxRef;
__device__ __forceinline__ FoxRef fox_ref(int L, const u16* PJ, u16* MIX, const float* BS, const float* LS, const float* PQK, float bqk2) {
    const int bh = L >> 5, qb = L & 31, b = bh >> 4, h = bh & 15; FoxRef r;
    r.Q = (const hbf*)(PJ + 0 * PROJ_T + ((size_t)bh * 8192 + qb * 256) * 128); r.K = (const hbf*)(PJ + 1 * PROJ_T + (size_t)bh * 8192 * 128); r.V = (const hbf*)(PJ + 2 * PROJ_T + (size_t)bh * 8192 * 128);
    r.O = (hbf*)(MIX + ((size_t)b * 8192 + qb * 256) * 4096 + 128 * h); r.P0 = qb * 256;
    int jlo = qb * 4; float sacc = 0.f; while (jlo > 0 && bqk2 + sacc >= -110.f) { --jlo; sacc += BS[bh * 128 + jlo]; }
    r.jlo = jlo; r.LS = LS + (size_t)bh * 8192; r.PK = PQK + ((size_t)(16384 + b * 8192) * 16 + h) * 4; r.PQ = PQK + ((size_t)(b * 8192) * 16 + h) * 4; return r;
}

__global__ void __launch_bounds__(NWAVES * 64, 2) fwd_kernel(Args args) {
    extern __shared__ __attribute__((aligned(16))) unsigned char lds[];
    Frame F;
    F.lds = (LAS unsigned char*)lds;
    F.MISC = (volatile LAS unsigned*)(F.lds + MISC_OFF);
#define REFRESH_TID() do { int t_ = threadIdx.x; asm volatile("" : "+v"(t_)); F.tid = t_; F.lane = t_ & 63; F.wave = __builtin_amdgcn_readfirstlane(t_ >> 6); } while (0)
    REFRESH_TID();
    F.G = gridDim.x; { const int bx = blockIdx.x; F.vcu = (F.G % 8 == 0) ? (bx % 8) * (F.G / 8) + bx / 8 : bx; }
    F.ctl = (gu32*)(karg_ptr()->ws + WS_CTL);
    for (int u = F.tid; u < (LDS_BYTES - MISC_OFF) / 4; u += NWAVES * 64) ((LAS unsigned*)(F.lds + MISC_OFF))[u] = 0u;
    __syncthreads();
    XcdBarrier bar = xcd_barrier_post((unsigned*)(F.ctl + CW_BAR), F.MISC + 8);
    const int G = F.G, cb = (int)blockIdx.x;

#ifndef PHM
#define PHM 0xff
#endif
#if PHM & 1
    REFRESH_TID(); p0_prologue(F);
#endif
    xcd_barrier(bar);

#if PHM & 2
    REFRESH_TID();
    for (int tile = F.vcu; tile < M / 64; tile += G) fa_tile(F, tile);
    { unsigned char* ws = karg_ptr()->ws;
      pg8::Gemm g{(const pg8::bf16_t*)(ws + WS_ACTA), (const pg8::bf16_t*)(ws + WS_WIN), M, NPROJ, DM}; pg8::StaticOrder S; S.init(M, NPROJ, G, cb);
      pg8::EpiProj E{(pg8::bf16_t*)(ws + WS_PROJ), (float*)(ws + WS_PQK)};
      pg8::gemm_phase<pg8::EpiProj, pg8::StaticOrder, true, true>(F.lds + RING_OFF, g, S, E); }
#endif
    xcd_barrier(bar);

#if PHM & 4
    REFRESH_TID();
    {
        KArgs& args = *karg_ptr(); unsigned char* ws = args.ws;
        const u16* PJ = (const u16*)(ws + WS_PROJ); u16* MIX = (u16*)(ws + WS_ACTA);
        const int nh_wg = (G >= 64) ? 32 : 0;
#ifndef P2M
#define P2M 3
#endif
        if (F.vcu < 32 && nh_wg) {
#if P2M & 1
            LAS float* lbt = (LAS float*)(F.lds + hg::HG_END);
            const int bh = F.vcu, b = bh >> 4, h = bh & 15;
            if (F.tid < 128) { const float l0 = args.in[7][h * 128 + F.tid], l1 = args.in[7][2048 + h * 128 + F.tid]; const float mx = fmaxf(l0, l1), e0 = __expf(l0 - mx), e1 = __expf(l1 - mx); lbt[F.tid] = e0 / (e0 + e1); }
            __syncthreads();
            hg::SeqArgs a{(u16*)args.out + (size_t)b * 8192 * 4096 + 2048 + 128 * h, PJ + 3 * PROJ_T + (size_t)bh * 8192 * 128, PJ + 4 * PROJ_T + (size_t)bh * 8192 * 128, PJ + 5 * PROJ_T + (size_t)bh * 8192 * 128, PJ + 6 * PROJ_T + (size_t)bh * 8192 * 128,
                          MIX + (size_t)b * 8192 * 4096 + 2048 + 128 * h, (const HG_LAS float*)lbt, args.in[8], SEQ / 64};
            hg::hgrn_sequence((HG_LAS char*)F.lds, a);
#if defined(HG_CHECK)
            {
                asm volatile("s_waitcnt vmcnt(0)" ::: "memory"); __syncthreads();
                unsigned bad = 0;
                for (int i = F.tid; i < 8192 * 16; i += 512) { const int t = i >> 4, c8 = i & 15;
                    const v4u x = *(const v4u*)(a.out + (size_t)t * 4096 + 8 * c8), y = *(const v4u*)(a.out2 + (size_t)t * 4096 + 8 * c8);
                    bad |= (x.x ^ y.x) | (x.y ^ y.y) | (x.z ^ y.z) | (x.w ^ y.w); }
                if (bad) __hip_atomic_store((gu32*)((unsigned*)(F.ctl + CW_BAR) + XB_TMO), 1u, RLX_AGENT);
            }
#endif
#endif
        } else {
#if P2M & 2
            typedef hbf hb; typedef FoxRef Ref;
            LAS float* GGt = (LAS float*)(F.lds + fa::GG_OFF);
            if (F.tid < 128) GGt[F.tid] = args.in[5][F.tid] * args.in[6][F.tid];
            float gq = 0.f, gk = 0.f;
            for (int i = 0; i < 128; ++i) { gq = fmaxf(gq, fabsf(args.in[5][i])); gk = fmaxf(gk, fabsf(args.in[6][i])); }
            const float bqk2 = 2.f * 11.313708499f * gq * gk * 1.03f;
            __syncthreads();
            const int na = G - nh_wg, a0 = F.vcu - nh_wg; const int NITEM = 32 * 32;
            const float* BS = (const float*)(ws + WS_BS); const float* LS = (const float*)(ws + WS_LS); const float* PQK = (const float*)(ws + WS_PQK);
            if (a0 >= 0 && a0 < NITEM) {
                for (int L = a0; L < NITEM; L += na) { const Ref cur = fox_ref(L, PJ, MIX, BS, LS, PQK, bqk2); fa::fox_block<hb, hb>(cur, (char*)lds); }
            }
#endif
        }
    }
#endif
    xcd_barrier(bar);

#if PHM & 8
    REFRESH_TID();
    { KArgs& args = *karg_ptr(); unsigned char* ws = args.ws;
      pg8::Gemm g{(const pg8::bf16_t*)(ws + WS_ACTA), (const pg8::bf16_t*)(ws + WS_WOUT), M, DM, DM}; pg8::StaticOrder S; S.init(M, DM, G, cb);
      pg8::EpiOut E{args.in[0], args.out, (pg8::bf16_t*)(ws + WS_H1B), (float*)(ws + WS_P1)};
      pg8::gemm_phase<pg8::EpiOut, pg8::StaticOrder, true, true>(F.lds + RING_OFF, g, S, E); }
    { unsigned char* ws = karg_ptr()->ws;
      pg8::Gemm g{(const pg8::bf16_t*)(ws + WS_PB), (const pg8::bf16_t*)(ws + WS_WPLE), M, DM, PLE}; pg8::StaticOrder S; S.init(M, DM, G, cb);
      pg8::EpiE E{(pg8::bf16_t*)(ws + WS_ERAW), (float*)(ws + WS_PE)};
      pg8::gemm_phase<pg8::EpiE, pg8::StaticOrder, true, true>(F.lds + RING_OFF, g, S, E); }
#endif
    xcd_barrier(bar);

#if PHM & 16
    REFRESH_TID();
#pragma unroll
    for (int half = 0; half < 2; ++half) {
        const int row_off = half * (M / 2);
        { unsigned char* ws = karg_ptr()->ws;
          pg8::Gemm g{(const pg8::bf16_t*)(ws + WS_H1B) + (size_t)row_off * DM, (const pg8::bf16_t*)(ws + WS_WUP), M / 2, DFF, DM}; pg8::StaticOrder S; S.init(M / 2, DFF, G, cb);
          pg8::Unit u0; if (S.next(0, u0)) row_table(F, (const float*)(ws + WS_P1), row_off + u0.pm * 256, (LAS float*)(F.lds + TAB_RS)); else __syncthreads();
          pg8::EpiUp E{(pg8::bf16_t*)(ws + WS_HID), (const LAS float*)(F.lds + TAB_RS)};
          pg8::gemm_phase<pg8::EpiUp, pg8::StaticOrder, true, true>(F.lds + RING_OFF, g, S, E); }
        xcd_barrier(bar);
        { KArgs& args = *karg_ptr(); unsigned char* ws = args.ws;
          pg8::Gemm g{(const pg8::bf16_t*)(ws + WS_HID), (const pg8::bf16_t*)(ws + WS_WDOWN), M / 2, DM, DFF}; pg8::StaticOrder S; S.init(M / 2, DM, G, cb);
          pg8::EpiDown E{args.out, (pg8::bf16_t*)(ws + WS_ACTA), (float*)(ws + WS_P2), row_off};
          pg8::gemm_phase<pg8::EpiDown, pg8::StaticOrder, true, true>(F.lds + RING_OFF, g, S, E); }
        xcd_barrier(bar);
    }

#endif
#if PHM & 32
    REFRESH_TID();
    { KArgs& args = *karg_ptr(); unsigned char* ws = args.ws;
      pg8::Gemm g{(const pg8::bf16_t*)(ws + WS_ACTA), (const pg8::bf16_t*)(ws + WS_WGATE), M, DM, DM}; pg8::StaticOrder S; S.init(M, DM, G, cb);
      pg8::Unit u0; if (S.next(0, u0)) { row_table(F, (const float*)(ws + WS_P2), u0.pm * 256, (LAS float*)(F.lds + TAB_RS)); row_table(F, (const float*)(ws + WS_PE), u0.pm * 256, (LAS float*)(F.lds + TAB_RSE)); }
      pg8::EpiGate E{args.out, (const pg8::bf16_t*)(ws + WS_ERAW), args.in[16], (const LAS float*)(F.lds + TAB_RS), (const LAS float*)(F.lds + TAB_RSE)};
      pg8::gemm_phase<pg8::EpiGate, pg8::StaticOrder, true, true>(F.lds + RING_OFF, g, S, E); }
#endif
    if (__hip_atomic_load((gu32*)((unsigned*)(F.ctl + CW_BAR) + XB_TMO), RLX_AGENT) != 0u) { asm volatile("s_waitcnt vmcnt(0)" ::: "memory"); __syncthreads();
        float* o = karg_ptr()->out; const float qn = __builtin_nanf(""); for (int i = threadIdx.x; i < DM; i += NWAVES * 64) o[(size_t)blockIdx.x * 64 * DM + i] = qn; }
}

extern "C" void kernel_launch(void* const* d_in, const int* in_sizes, int n_in, void* d_out, int out_size, void* d_ws, size_t ws_size, hipStream_t stream) {
    static int grid = 0;
    if (grid == 0) {
        if (n_in != 17 || in_sizes[0] != M * DM || out_size != M * DM || ws_size < WS_END) { fprintf(stderr, "kernel_launch: shape / workspace mismatch (n_in %d, ws %zu, need %zu); nothing launched\n", n_in, ws_size, (size_t)WS_END); grid = -1; return; }
        int dev = 0, cus = 0, per_cu = 0;
        if (hipGetDevice(&dev) != hipSuccess || hipDeviceGetAttribute(&cus, hipDeviceAttributeMultiprocessorCount, dev) != hipSuccess) { grid = -1; return; }
        if (hipFuncSetAttribute((const void*)fwd_kernel, hipFuncAttributeMaxDynamicSharedMemorySize, LDS_BYTES) != hipSuccess) { fprintf(stderr, "kernel_launch: hipFuncSetAttribute failed\n"); grid = -1; return; }
        if (hipOccupancyMaxActiveBlocksPerMultiprocessor(&per_cu, (const void*)fwd_kernel, NWAVES * 64, LDS_BYTES) != hipSuccess || per_cu < 1) fprintf(stderr, "kernel_launch: note: occupancy query reports %d workgroups per CU\n", per_cu);
        (void)hipGetLastError();
        grid = cus;
    }
    if (grid < 0) return;
    if (hipMemsetAsync((char*)d_ws + WS_CTL, 0, CTL_ZERO_BYTES, stream) != hipSuccess) return;
    Args a{};
    for (int i = 0; i < 17; ++i) a.in[i] = (const float*)d_in[i];
    a.out = (float*)d_out; a.ws = (unsigned char*)d_ws;
    hipLaunchKernelGGL(fwd_kernel, dim3(grid), dim3(NWAVES * 64), LDS_BYTES, stream, a);
}
```

```cpp
#include <hip/hip_runtime.h>
#include <hip/hip_bf16.h>
#include <cstdio>
#include <cstdint>
namespace pg8 {
#define PG8_LAS __attribute__((address_space(3)))
typedef unsigned short bf16_t;
typedef short bf16x8 __attribute__((ext_vector_type(8)));
typedef float f32x4 __attribute__((ext_vector_type(4)));
typedef unsigned u32x4 __attribute__((ext_vector_type(4)));
constexpr int BM = 256, BK = 64, HALF = 128, HTB = HALF * BK * 2  , STAGE_BYTES = 8 * HTB, NXCD = 8, WGM = 8;

__host__ __device__ __forceinline__ int lds_byte(int r, int c) { const int st = (r >> 4) * 2 + (c >> 5), rr = r & 15, cc = c & 31, ob = rr * 64 + cc * 2; return st * 1024 + (ob ^ (((ob >> 9) & 1) << 5)); }
__host__ __device__ __forceinline__ void stage_rc(int b, int& R, int& C) { const int st = b / 1024, sb = b % 1024, swz = sb ^ (((sb >> 9) & 1) << 5); R = (st >> 1) * 16 + swz / 64; C = (st & 1) * 32 + (swz % 64) / 2; }
__host__ __device__ __forceinline__ int perm32(int rho) { const int n = rho >> 4, i = rho & 15; return 8 * (i >> 2) + 4 * n + (i & 3); }

struct Unit { int pm, pn; };
struct Gemm { const bf16_t* A; const bf16_t* Bt; int M, N, K; const bf16_t* A2; const bf16_t* B2; };

struct StaticOrder {
    int nM, nN, nwg, G, c;
    __host__ __device__ void init(int M, int N, int G_, int c_) { nM = M / BM; nN = N / BM; nwg = nM * nN; G = G_; c = c_; }
    __host__ __device__ bool next(int i, Unit& u) const {
        const long L = (long)i * G + c; if (L >= nwg) return false;
        int wgid = (int)L; { const int q = nwg / NXCD, r = nwg % NXCD, xcd = wgid % NXCD, off = wgid / NXCD; wgid = (xcd < r ? xcd * (q + 1) : r * (q + 1) + (xcd - r) * q) + off; }
        const int nig = WGM * nN, gid = wgid / nig, fm = gid * WGM, gsz = (nM - fm) < WGM ? (nM - fm) : WGM;
        u.pm = fm + ((wgid % nig) % gsz); u.pn = (wgid % nig) / gsz; return true;
    }
    __device__ __forceinline__ void a_ready(const Unit&) const {}
    __device__ __forceinline__ void done(const Unit&) const {}
};
typedef float f32x2c_t __attribute__((ext_vector_type(2))); typedef __bf16 bf16x2c_t __attribute__((ext_vector_type(2)));
__device__ __forceinline__ unsigned cvt_pk_bf16(float lo, float hi) { f32x2c_t v = {lo, hi}; bf16x2c_t b = __builtin_convertvector(v, bf16x2c_t); return __builtin_bit_cast(unsigned, b); }
typedef float f32x2 __attribute__((ext_vector_type(2)));
__device__ __forceinline__ u32x4 pack8v(const f32x4 v0, const f32x4 v1) { u32x4 w; w.x = cvt_pk_bf16(v0[0], v0[1]); w.y = cvt_pk_bf16(v0[2], v0[3]); w.z = cvt_pk_bf16(v1[0], v1[1]); w.w = cvt_pk_bf16(v1[2], v1[3]); return w; }
__device__ __forceinline__ float dot8(const f32x4 a, const f32x4 b) { return ((a[0] * a[0] + a[1] * a[1]) + (a[2] * a[2] + a[3] * a[3])) + ((b[0] * b[0] + b[1] * b[1]) + (b[2] * b[2] + b[3] * b[3])); }
__device__ __forceinline__ float red_fq(float s) { s += __shfl_xor(s, 16); s += __shfl_xor(s, 32); return s; }

struct EpiProj {
    static constexpr bool PERM = true, AFTER_DRAIN = false;
    bf16_t* proj; float* pqk; const PG8_LAS float* rs;
    __device__ __forceinline__ void operator()(const f32x4 (&acc)[2][2][4][2], const Unit& u, int wr, int wc, int fr, int fq) const {
        const int C = u.pn * BM, which = C >> 11, hp = (C & 2047) >> 8, dcol = wc * 32 + 8 * fq;
#pragma unroll
        for (int ai = 0; ai < 2; ++ai)
#pragma unroll
            for (int m = 0; m < 4; ++m) { const int lr = ai * HALF + wr * 64 + m * 16 + fr, row = u.pm * BM + lr, b = row >> 13, t = row & 8191; const float r = rs[lr];
#pragma unroll
                for (int bj = 0; bj < 2; ++bj) { const int head = 2 * hp + bj;
                    const f32x4 v0 = acc[ai][bj][m][0] * r, v1 = acc[ai][bj][m][1] * r;
                    *(u32x4*)(proj + ((size_t)((which * 2 + b) * 16 + head) * 8192 + t) * 128 + dcol) = pack8v(v0, v1);
                    if (which < 2) { const float ss = red_fq(dot8(v0, v1)); if (fq == 0) pqk[((size_t)(which * 16384 + row) * 16 + head) * 4 + wc] = ss; } } }
    }
};
struct EpiOut {
    static constexpr bool PERM = true, AFTER_DRAIN = false;
    bf16_t* hb; float* part;
    __device__ __forceinline__ void operator()(const f32x4 (&acc)[2][2][4][2], const Unit& u, int wr, int wc, int fr, int fq) const {
        const int col0 = u.pn * BM + wc * 32 + 8 * fq, row0 = u.pm * BM + wr * 64 + fr;
#pragma unroll
        for (int g = 0; g < 8; ++g) { const int ai = g >> 2, m = g & 3, row = row0 + ai * HALF + m * 16; float ss = 0.f;
#pragma unroll
            for (int bj = 0; bj < 2; ++bj) { const size_t off = (size_t)row * 4096 + col0 + bj * HALF;
                const f32x4 v0 = acc[ai][bj][m][0], v1 = acc[ai][bj][m][1];
                *(u32x4*)(hb + off) = pack8v(v0, v1); ss += dot8(v0, v1); }
            ss = red_fq(ss); if (fq == 0) part[(size_t)row * 64 + u.pn * 4 + wc] = ss; }
    }
};
struct EpiE {
    static constexpr bool PERM = true, AFTER_DRAIN = false;
    bf16_t* eb; float* part; const float* gpost;
    __device__ __forceinline__ void operator()(const f32x4 (&acc)[2][2][4][2], const Unit& u, int wr, int wc, int fr, int fq) const {
        int fr_ = fr, fq_ = fq; asm volatile("" : "+v"(fr_), "+v"(fq_));
        const int col0 = u.pn * BM + wc * 32 + 8 * fq_;
        f32x4 gp[2][2];
#pragma unroll
        for (int bj = 0; bj < 2; ++bj) { gp[bj][0] = *(const f32x4*)(gpost + col0 + bj * HALF); gp[bj][1] = *(const f32x4*)(gpost + col0 + bj * HALF + 4); }
#pragma unroll
        for (int ai = 0; ai < 2; ++ai)
#pragma unroll
            for (int m = 0; m < 4; ++m) { const int row = u.pm * BM + ai * HALF + wr * 64 + m * 16 + fr_; float ss = 0.f;
#pragma unroll
                for (int bj = 0; bj < 2; ++bj) { const size_t off = (size_t)row * 4096 + col0 + bj * HALF;
                    const f32x4 v0 = acc[ai][bj][m][0], v1 = acc[ai][bj][m][1];
                    *(u32x4*)(eb + off) = pack8v(v0 * gp[bj][0], v1 * gp[bj][1]); ss += dot8(v0, v1); }
                ss = red_fq(ss); if (fq_ == 0) part[(size_t)row * 64 + u.pn * 4 + wc] = ss; }
    }
};
struct EpiUp {
    static constexpr bool PERM = true, AFTER_DRAIN = false;
    bf16_t* hid; const PG8_LAS float* rs;
    __device__ __forceinline__ void operator()(const f32x4 (&acc)[2][2][4][2], const Unit& u, int wr, int wc, int fr, int fq) const {
        const int col0 = u.pn * BM + wc * 32 + 8 * fq;
#pragma unroll
        for (int ai = 0; ai < 2; ++ai)
#pragma unroll
            for (int m = 0; m < 4; ++m) { const int lr = ai * HALF + wr * 64 + m * 16 + fr, row = u.pm * BM + lr; const float r = rs[lr];
#pragma unroll
                for (int bj = 0; bj < 2; ++bj) { f32x4 v0 = acc[ai][bj][m][0] * r, v1 = acc[ai][bj][m][1] * r;
#pragma unroll
                    for (int i = 0; i < 4; ++i) { const float a = fmaxf(v0[i], 0.f), b = fmaxf(v1[i], 0.f); v0[i] = a * a; v1[i] = b * b; }
                    *(u32x4*)(hid + (size_t)row * 16384 + col0 + bj * HALF) = pack8v(v0, v1); } }
    }
};
struct EpiDown {
    static constexpr bool PERM = true, AFTER_DRAIN = false;
    const bf16_t* h1b; bf16_t* hb; unsigned char* h8; float* part; int row_off;
    __device__ __forceinline__ void operator()(const f32x4 (&acc)[2][2][4][2], const Unit& u, int wr, int wc, int fr, int fq) const {
        const int col0 = u.pn * BM + wc * 32 + 8 * fq, row0 = row_off + u.pm * BM + wr * 64 + fr;
        u32x4 nx[2];
#pragma unroll
        for (int bj = 0; bj < 2; ++bj) nx[bj] = *(const u32x4*)(h1b + (size_t)row0 * 4096 + col0 + bj * HALF);
#pragma unroll
        for (int g = 0; g < 8; ++g) { const int ai = g >> 2, m = g & 3, row = row0 + ai * HALF + m * 16; float ss = 0.f;
            u32x4 cx[2];
#pragma unroll
            for (int bj = 0; bj < 2; ++bj) cx[bj] = nx[bj];
            if (g < 7) { const int rown = row0 + ((g + 1) >> 2) * HALF + ((g + 1) & 3) * 16;
#pragma unroll
                for (int bj = 0; bj < 2; ++bj) nx[bj] = *(const u32x4*)(h1b + (size_t)rown * 4096 + col0 + bj * HALF); }
#pragma unroll
            for (int bj = 0; bj < 2; ++bj) { const size_t off = (size_t)row * 4096 + col0 + bj * HALF; const u32x4 w = cx[bj];
                f32x4 v0 = acc[ai][bj][m][0], v1 = acc[ai][bj][m][1];
                v0[0] += __uint_as_float(w.x << 16); v0[1] += __uint_as_float(w.x & 0xffff0000u); v0[2] += __uint_as_float(w.y << 16); v0[3] += __uint_as_float(w.y & 0xffff0000u);
                v1[0] += __uint_as_float(w.z << 16); v1[1] += __uint_as_float(w.z & 0xffff0000u); v1[2] += __uint_as_float(w.w << 16); v1[3] += __uint_as_float(w.w & 0xffff0000u);
                *(u32x4*)(hb + off) = pack8v(v0, v1); ss += dot8(v0, v1);
                { typedef unsigned u32x2_ __attribute__((ext_vector_type(2))); u32x2_ q;
                  int p0 = __builtin_amdgcn_cvt_pk_fp8_f32(v0[0], v0[1], 0, false); p0 = __builtin_amdgcn_cvt_pk_fp8_f32(v0[2], v0[3], p0, true);
                  int p1 = __builtin_amdgcn_cvt_pk_fp8_f32(v1[0], v1[1], 0, false); p1 = __builtin_amdgcn_cvt_pk_fp8_f32(v1[2], v1[3], p1, true);
                  q.x = (unsigned)p0; q.y = (unsigned)p1; *(u32x2_*)(h8 + off) = q; } }
            ss = red_fq(ss); if (fq == 0) part[(size_t)row * 64 + u.pn * 4 + wc] = ss;
            asm volatile("" ::: "memory"); }
    }
};
struct EpiGate {
    static constexpr bool PERM = true, AFTER_DRAIN = false;
    float* out; const bf16_t* h2b; const bf16_t* eb; float wscale_inv; const PG8_LAS float* rs2; const PG8_LAS float* rse;
    __device__ __forceinline__ void operator()(const f32x4 (&acc)[2][2][4][2], const Unit& u, int wr, int wc, int fr, int fq) const {
        int fr_ = fr, fq_ = fq; asm volatile("" : "+v"(fr_), "+v"(fq_));
        const int col0 = u.pn * BM + wc * 32 + 8 * fq_, lr0 = wr * 64 + fr_, row0 = u.pm * BM + lr0;
        u32x4 nx[2], ne[2];
#pragma unroll
        for (int bj = 0; bj < 2; ++bj) { const size_t off = (size_t)row0 * 4096 + col0 + bj * HALF; nx[bj] = *(const u32x4*)(h2b + off); ne[bj] = *(const u32x4*)(eb + off); }
#pragma unroll
        for (int g = 0; g < 8; ++g) { const int ai = g >> 2, m = g & 3, lr = lr0 + ai * HALF + m * 16, row = row0 + ai * HALF + m * 16;
            const float r2 = rs2[lr] * wscale_inv * -1.4426950408889634f, re = rse[lr];
            u32x4 cx[2], ce[2];
#pragma unroll
            for (int bj = 0; bj < 2; ++bj) { cx[bj] = nx[bj]; ce[bj] = ne[bj]; }
            if (g < 7) { const int rown = row0 + ((g + 1) >> 2) * HALF + ((g + 1) & 3) * 16;
#pragma unroll
                for (int bj = 0; bj < 2; ++bj) { const size_t off = (size_t)rown * 4096 + col0 + bj * HALF; nx[bj] = *(const u32x4*)(h2b + off); ne[bj] = *(const u32x4*)(eb + off); } }
#pragma unroll
            for (int bj = 0; bj < 2; ++bj) { const size_t off = (size_t)row * 4096 + col0 + bj * HALF;
                const u32x4 ew = ce[bj], hw = cx[bj];
                f32x4 e0, e1, v0, v1;
                e0[0] = __uint_as_float(ew.x << 16); e0[1] = __uint_as_float(ew.x & 0xffff0000u); e0[2] = __uint_as_float(ew.y << 16); e0[3] = __uint_as_float(ew.y & 0xffff0000u);
                e1[0] = __uint_as_float(ew.z << 16); e1[1] = __uint_as_float(ew.z & 0xffff0000u); e1[2] = __uint_as_float(ew.w << 16); e1[3] = __uint_as_float(ew.w & 0xffff0000u);
                v0[0] = __uint_as_float(hw.x << 16); v0[1] = __uint_as_float(hw.x & 0xffff0000u); v0[2] = __uint_as_float(hw.y << 16); v0[3] = __uint_as_float(hw.y & 0xffff0000u);
                v1[0] = __uint_as_float(hw.z << 16); v1[1] = __uint_as_float(hw.z & 0xffff0000u); v1[2] = __uint_as_float(hw.w << 16); v1[3] = __uint_as_float(hw.w & 0xffff0000u);
#pragma unroll
                for (int i = 0; i < 4; ++i) { const float g0 = __builtin_amdgcn_rcpf(1.f + __builtin_amdgcn_exp2f(acc[ai][bj][m][0][i] * r2)), g1 = __builtin_amdgcn_rcpf(1.f + __builtin_amdgcn_exp2f(acc[ai][bj][m][1][i] * r2));
                    v0[i] += g0 * (e0[i] * re); v1[i] += g1 * (e1[i] * re); }
                *(f32x4*)(out + off) = v0; *(f32x4*)(out + off + 4) = v1; }
            asm volatile("" ::: "memory"); }
    }
};
template <class Epi, class Sched, bool ALIGN_EPI = false, bool SP2 = false, bool FP8 = false, int EXT = 0>
__device__ __forceinline__ void gemm_phase(PG8_LAS unsigned char* lds, const Gemm g, const Sched& S, const Epi& E, const int wave_s  ) {
    int lane_; asm volatile("v_mbcnt_lo_u32_b32 %0, -1, 0\n\tv_mbcnt_hi_u32_b32 %0, -1, %0" : "=v"(lane_)); const int tid_ = wave_s * 64 + lane_;
    const int tid = tid_, wid = wave_s, lane = lane_, wr = wid >> 2, wc = wid & 3, fr = lane & 15, fq = lane >> 4;
    const int K = g.K, nt = K / BK;
    unsigned voffA[2], voffB[2];
#pragma unroll
    for (int i = 0; i < 2; ++i) { int R, C; stage_rc(tid * 16 + i * 8192, R, C); const int Rb = Epi::PERM ? ((R & ~31) + perm32(R & 31)) : R;
        voffA[i] = (unsigned)(R * K + C) * 2u; voffB[i] = (unsigned)(Rb * K + C) * 2u; }
    const size_t kstep = (size_t)(BK * 2);
    const size_t hstep = (size_t)HALF * K * 2;
    const size_t tstep = 2 * hstep;
    const unsigned ldsw = (unsigned)wid * 1024u;
    const int aoff = lds_byte(wr * 64 + fr, fq * 8), boff = lds_byte(wc * 32 + fr, fq * 8);
    const int aoff8 = lds_byte(wr * 64 + fr, fq * 16), boff8 = lds_byte(wc * 32 + fr, fq * 16);
#define PG8_SA(b, h) (((b) * 2 + (h)) * HTB)
#define PG8_SB(b, h) ((4 + (b) * 2 + (h)) * HTB)
#define PG8_STAGE(bufoff, gbase, voff) do { _Pragma("unroll") for (int _i = 0; _i < 2; ++_i) \
        __builtin_amdgcn_global_load_lds((const unsigned*)((const char*)(gbase) + (voff)[_i]), (PG8_LAS unsigned*)(lds + (bufoff) + ldsw + _i * 8192), 16, 0, 0); } while (0)
#define PG8_LDA(dst, b, h) do { _Pragma("unroll") for (int m = 0; m < 4; ++m) _Pragma("unroll") for (int k = 0; k < 2; ++k) dst[m][k] = *(const PG8_LAS bf16x8*)(lds + PG8_SA(b, h) + (FP8 ? aoff8 + m * 2048 + k * 16 : aoff + m * 2048 + k * 1024)); } while (0)
#define PG8_LDB(dst, b, h) do { _Pragma("unroll") for (int n = 0; n < 2; ++n) _Pragma("unroll") for (int k = 0; k < 2; ++k) dst[n][k] = *(const PG8_LAS bf16x8*)(lds + PG8_SB(b, h) + (FP8 ? boff8 + n * 2048 + k * 16 : boff + n * 2048 + k * 1024)); } while (0)
#define PG8_MMA(ai, bj, At, Bt) do { __builtin_amdgcn_s_setprio(1); if constexpr (FP8) { typedef int v8i_ __attribute__((ext_vector_type(8))); \
        _Pragma("unroll") for (int m = 0; m < 4; ++m) _Pragma("unroll") for (int n = 0; n < 2; ++n) \
            { const v8i_ b8_ = __builtin_bit_cast(v8i_, __builtin_shufflevector(Bt[n][0], Bt[n][1], 0, 1, 2, 3, 4, 5, 6, 7, 8, 9, 10, 11, 12, 13, 14, 15)), a8_ = __builtin_bit_cast(v8i_, __builtin_shufflevector(At[m][0], At[m][1], 0, 1, 2, 3, 4, 5, 6, 7, 8, 9, 10, 11, 12, 13, 14, 15)); \
              asm volatile("v_mfma_f32_16x16x128_f8f6f4 %0, %1, %2, %0" : "+v"(acc[ai][bj][m][n]) : "v"(b8_), "v"(a8_)); }     \
            } else { \
        _Pragma("unroll") for (int m = 0; m < 4; ++m) _Pragma("unroll") for (int n = 0; n < 2; ++n) _Pragma("unroll") for (int k = 0; k < 2; ++k) \
        acc[ai][bj][m][n] = __builtin_amdgcn_mfma_f32_16x16x32_bf16(Bt[n][k], At[m][k], acc[ai][bj][m][n], 0, 0, 0); } __builtin_amdgcn_s_setprio(0); } while (0)
#define PG8_WAIT_V(n) asm volatile("s_waitcnt vmcnt(" #n ")" ::: "memory")
#define PG8_WAIT_L(n) asm volatile("s_waitcnt lgkmcnt(" #n ")" ::: "memory")
#define PG8_BAR __builtin_amdgcn_s_barrier()
#define PG8_SCHED __builtin_amdgcn_sched_barrier(0)
    Unit cur, nxt; int ui = 0;
    if (!S.next(0, cur)) return;
    f32x4 acc[2][2][4][2];
#pragma unroll
    for (int a = 0; a < 2; ++a)
#pragma unroll
        for (int b = 0; b < 2; ++b)
#pragma unroll
            for (int m = 0; m < 4; ++m)
#pragma unroll
                for (int n = 0; n < 2; ++n) acc[a][b][m][n] = (f32x4){0.f, 0.f, 0.f, 0.f};
    bf16x8 At[4][2], B0[2][2], B1[2][2];
    const char* cA = (const char*)g.A + (size_t)cur.pm * tstep; const char* cB = (const char*)g.Bt + (size_t)cur.pn * tstep;
    S.a_ready(cur);
    if constexpr (SP2) {
        PG8_STAGE(PG8_SB(0, 0), cB, voffB); PG8_STAGE(PG8_SB(0, 1), cB + hstep, voffB); PG8_STAGE(PG8_SA(0, 0), cA, voffA); PG8_STAGE(PG8_SA(0, 1), cA + hstep, voffA);
        if (wr == 1) PG8_BAR;
        PG8_WAIT_V(2); PG8_BAR;
        PG8_STAGE(PG8_SB(1, 0), cB + kstep, voffB); PG8_STAGE(PG8_SA(1, 0), cA + kstep, voffA); PG8_STAGE(PG8_SB(1, 1), cB + hstep + kstep, voffB);
        PG8_WAIT_V(6); PG8_BAR;
    } else {
        PG8_STAGE(PG8_SB(0, 0), cB, voffB); PG8_STAGE(PG8_SA(0, 0), cA, voffA); PG8_STAGE(PG8_SB(0, 1), cB + hstep, voffB); PG8_STAGE(PG8_SA(0, 1), cA + hstep, voffA);
        if (wr == 1) PG8_BAR;
        PG8_WAIT_V(4); PG8_BAR;
        PG8_STAGE(PG8_SB(1, 0), cB + kstep, voffB); PG8_STAGE(PG8_SA(1, 0), cA + kstep, voffA); PG8_STAGE(PG8_SB(1, 1), cB + hstep + kstep, voffB);
        PG8_WAIT_V(6); PG8_BAR;
    }
    for (;;) {
        const bool has_next = S.next(ui + 1, nxt);
        const char* nA = has_next ? (const char*)g.A + (size_t)nxt.pm * tstep : cA; const char* nB = has_next ? (const char*)g.Bt + (size_t)nxt.pn * tstep : cB;
        static_assert(EXT % 2 == 0, "EXT");
        const char* xA = EXT ? (const char*)g.A2 + (size_t)cur.pm * tstep + (size_t)cur.pn * (BM * 2) : cA; const char* xB = EXT ? (const char*)g.B2 : cB;
        const int NT = nt + EXT;
        for (int t = 0; t < NT; t += 2) {
            const bool last = (t == NT - 2);
            const char* a1 = (!EXT || t < nt) ? cA + (size_t)(t + 1) * kstep : xA + (size_t)(t + 1 - nt) * kstep;
            const char* a2; const char* b2;
            if (last) { a2 = nA; b2 = nB; } else if (!EXT || t + 2 < nt) { a2 = cA + (size_t)(t + 2) * kstep; b2 = cB + (size_t)(t + 2) * kstep; } else { a2 = xA + (size_t)(t + 2 - nt) * kstep; b2 = xB + (size_t)(t + 2 - nt) * kstep; }
            const char* a3 = a2 + kstep; const char* b3 = b2 + kstep;
            if (last && has_next) S.a_ready(nxt);
            if constexpr (SP2) {
            PG8_LDB(B0, 0, 0); PG8_LDB(B1, 0, 1); PG8_SCHED; PG8_LDA(At, 0, 0); PG8_STAGE(PG8_SA(1, 1), a1 + hstep, voffA);
            PG8_WAIT_V(8); PG8_WAIT_L(0); PG8_BAR; PG8_MMA(0, 0, At, B0); PG8_MMA(0, 1, At, B1); PG8_BAR; PG8_SCHED;
            PG8_LDA(At, 0, 1); PG8_STAGE(PG8_SB(0, 0), b2, voffB); PG8_STAGE(PG8_SB(0, 1), b2 + hstep, voffB); PG8_STAGE(PG8_SA(0, 0), a2, voffA);
            PG8_WAIT_V(8); PG8_WAIT_L(0); PG8_BAR; PG8_MMA(1, 0, At, B0); PG8_MMA(1, 1, At, B1); PG8_BAR; PG8_SCHED;
            PG8_LDB(B0, 1, 0); PG8_LDB(B1, 1, 1); PG8_SCHED; PG8_LDA(At, 1, 0); PG8_STAGE(PG8_SA(0, 1), a2 + hstep, voffA);
            PG8_WAIT_V(8); PG8_WAIT_L(0); PG8_BAR; PG8_MMA(0, 0, At, B0); PG8_MMA(0, 1, At, B1); PG8_BAR; PG8_SCHED;
            PG8_LDA(At, 1, 1); PG8_STAGE(PG8_SB(1, 0), b3, voffB); PG8_STAGE(PG8_SB(1, 1), b3 + hstep, voffB); PG8_STAGE(PG8_SA(1, 0), a3, voffA);
            PG8_WAIT_V(8); PG8_WAIT_L(0); PG8_BAR; PG8_MMA(1, 0, At, B0); PG8_MMA(1, 1, At, B1); PG8_BAR; PG8_SCHED;
            } else {
            PG8_LDB(B0, 0, 0); PG8_SCHED; PG8_LDA(At, 0, 0); PG8_STAGE(PG8_SA(1, 1), a1 + hstep, voffA);
            PG8_WAIT_L(8); PG8_BAR; PG8_WAIT_L(0); PG8_MMA(0, 0, At, B0); PG8_BAR; PG8_SCHED;
            PG8_LDB(B1, 0, 1); PG8_STAGE(PG8_SB(0, 0), b2, voffB);
            PG8_BAR; PG8_WAIT_L(0); PG8_MMA(0, 1, At, B1); PG8_BAR;
            PG8_LDA(At, 0, 1); PG8_STAGE(PG8_SA(0, 0), a2, voffA);
            PG8_BAR; PG8_WAIT_L(0); PG8_MMA(1, 0, At, B0); PG8_BAR; PG8_SCHED;
            PG8_STAGE(PG8_SB(0, 1), b2 + hstep, voffB);
            PG8_WAIT_V(6); PG8_BAR; PG8_MMA(1, 1, At, B1); PG8_BAR;
            PG8_LDB(B0, 1, 0); PG8_SCHED; PG8_LDA(At, 1, 0); PG8_STAGE(PG8_SA(0, 1), a2 + hstep, voffA);
            PG8_WAIT_L(8); PG8_BAR; PG8_WAIT_L(0); PG8_MMA(0, 0, At, B0); PG8_BAR; PG8_SCHED;
            PG8_LDB(B1, 1, 1); PG8_STAGE(PG8_SB(1, 0), b3, voffB);
            PG8_BAR; PG8_WAIT_L(0); PG8_MMA(0, 1, At, B1); PG8_BAR;
            PG8_LDA(At, 1, 1); PG8_STAGE(PG8_SA(1, 0), a3, voffA);
            PG8_BAR; PG8_WAIT_L(0); PG8_MMA(1, 0, At, B0); PG8_BAR; PG8_SCHED;
            PG8_STAGE(PG8_SB(1, 1), b3 + hstep, voffB);
            PG8_WAIT_V(6); PG8_BAR; PG8_MMA(1, 1, At, B1); PG8_BAR;
            }
        }
        if constexpr (FP8) asm volatile("s_nop 7\n\ts_nop 7\n\ts_nop 7" ::: "memory");
        if constexpr (ALIGN_EPI) { if (wr == 0) PG8_BAR; }
        if constexpr (!Epi::AFTER_DRAIN) { { int l2_; asm volatile("v_mbcnt_lo_u32_b32 %0, -1, 0\n\tv_mbcnt_hi_u32_b32 %0, -1, %0" : "=v"(l2_)); E(acc, cur, wr, wc, l2_ & 15, l2_ >> 4); }     S.done(cur); }
        if (!has_next) break;
#pragma unroll
        for (int a = 0; a < 2; ++a)
#pragma unroll
            for (int b = 0; b < 2; ++b)
#pragma unroll
                for (int m = 0; m < 4; ++m)
#pragma unroll
                    for (int n = 0; n < 2; ++n) acc[a][b][m][n] = (f32x4){0.f, 0.f, 0.f, 0.f};
        cur = nxt; cA = nA; cB = nB; ++ui;
        if constexpr (ALIGN_EPI) { if (wr == 1) PG8_BAR; }
    }
    PG8_WAIT_V(0);
    if constexpr (!ALIGN_EPI) { if (wr == 0) PG8_BAR; }
    PG8_BAR;
    if constexpr (Epi::AFTER_DRAIN) { E.fused(acc, cur, wr, wc, fr, fq, lds, wid, lane); S.done(cur); }
#undef PG8_SA
#undef PG8_SB
#undef PG8_STAGE
#undef PG8_LDA
#undef PG8_LDB
#undef PG8_MMA
#undef PG8_WAIT_V
#undef PG8_WAIT_L
#undef PG8_BAR
#undef PG8_SCHED
}
}
namespace fa {
constexpr int D = 128;
constexpr float SCALE = 0.08838834764831845f;
constexpr float LOG2E = 1.4426950408889634f;
constexpr float THR2 = 8.f * LOG2E;
constexpr bool WSKIP = false;
constexpr int OPITCH = 4096;
constexpr int NW = 8, QBLK = 32, KVBLK = 64, QB = NW * QBLK;
constexpr int SHM_V = KVBLK * D * 2, SHM_K = KVBLK * D * 2;
constexpr int LDS_BYTES = 2 * SHM_V + 2 * SHM_K + NW * 64 * 4;
constexpr int TAB_MAX = 8192 + QB;
constexpr int FL_OFF = LDS_BYTES, RK_OFF = FL_OFF + TAB_MAX * 4, GG_OFF = RK_OFF + TAB_MAX * 4, SCR_OFF = GG_OFF + 512, FA_LDS_END = SCR_OFF + 64;
constexpr int WBIG = 1 << 30;

using bf16 = __hip_bfloat16;
typedef short bf16x8 __attribute__((ext_vector_type(8)));
typedef short s16x4 __attribute__((ext_vector_type(4)));
typedef float f32x16 __attribute__((ext_vector_type(16)));
typedef float f32x4 __attribute__((ext_vector_type(4)));
typedef unsigned u32x4 __attribute__((ext_vector_type(4)));
template <class A, class Bt> struct same_t { static constexpr bool v = false; };
template <class A> struct same_t<A, A> { static constexpr bool v = true; };

#define KSWZ(row, colB) ((row) * 256 + ((colB) ^ (((row) & 7) << 4)))
#define SBAR() __builtin_amdgcn_sched_barrier(0)
__device__ __forceinline__ int v_st(int k, int c) { const int kk = (k & ~0xC) | ((k & 4) << 1) | ((k & 8) >> 1); return ((kk >> 3) * 4 + (c >> 5)) * 512 + ((kk & 7) * 32 + (c & 31)) * 2; }
__device__ __forceinline__ int v_rd_base(int lane) { return ((lane & 3) << 3) | (((lane >> 2) & 3) << 6) | (((lane >> 4) & 1) << 5) | (((lane >> 5) & 1) << 8); }
constexpr int v_rd_off(int d0, int ks, int half) { return d0 * 512 + ks * 4096 + half * 2048; }
__device__ __forceinline__ int crow(int r, int hi) { return (r & 3) + 8 * (r >> 2) + 4 * hi; }
__device__ __forceinline__ unsigned cvtpk(float lo, float hi) {
    unsigned r; asm volatile("v_cvt_pk_bf16_f32 %0, %1, %2" : "=v"(r) : "v"(lo), "v"(hi)); return r;
}
__device__ __forceinline__ bf16x8 pack8(f32x4 a, f32x4 b) {
    u32x4 w = {cvtpk(a[0], a[1]), cvtpk(a[2], a[3]), cvtpk(b[0], b[1]), cvtpk(b[2], b[3])};
    return *reinterpret_cast<bf16x8*>(&w);
}
template <class T> __device__ __forceinline__ bf16x8 load8(const T* p) {
    if constexpr (same_t<T, float>::v) { return pack8(*(const f32x4*)p, *(const f32x4*)(p + 4)); }
    else { return *reinterpret_cast<const bf16x8*>(p); }
}
__device__ __forceinline__ void mask_tile(f32x16& p0, f32x16& p1, int dq, unsigned W) {
    const float NEG = -__builtin_inff();
#pragma unroll
    for (int r = 0; r < 16; ++r) {
        const int c = (r & 3) + 8 * (r >> 2);
        if ((unsigned)(dq - c) >= W) p0[r] = NEG;
        if ((unsigned)(dq - c - 32) >= W) p1[r] = NEG;
    }
}
__device__ __forceinline__ void partialSM(f32x16& p0, f32x16& p1, const float* FlL, const float* RKL, float& m_reg, float& mn, float& alpha) {
#pragma unroll
    for (int g = 0; g < 4; ++g) { const f32x4 f0 = *(const f32x4*)(FlL + 8 * g), k0 = *(const f32x4*)(RKL + 8 * g), f1 = *(const f32x4*)(FlL + 32 + 8 * g), k1 = *(const f32x4*)(RKL + 32 + 8 * g);
#pragma unroll
        for (int i = 0; i < 4; ++i) { p0[4 * g + i] = fmaf(p0[4 * g + i], k0[i], f0[i]); p1[4 * g + i] = fmaf(p1[4 * g + i], k1[i], f1[i]); } }
    float pmax = p0[0]; for (int r = 1; r < 16; ++r) pmax = fmaxf(pmax, p0[r]); for (int r = 0; r < 16; ++r) pmax = fmaxf(pmax, p1[r]);
    { auto rr = __builtin_amdgcn_permlane32_swap(__float_as_uint(pmax), __float_as_uint(pmax), false, false);
      pmax = fmaxf(__uint_as_float(rr[0]), __uint_as_float(rr[1])); }
    if (__builtin_expect(__all((pmax - m_reg) <= THR2), 1)) { mn = m_reg; alpha = 1.f; }
    else { mn = fmaxf(m_reg, pmax); alpha = __builtin_amdgcn_exp2f(m_reg - mn); m_reg = mn; }
    for (int r = 0; r < 16; ++r) p0[r] = p0[r] - mn; for (int r = 0; r < 16; ++r) p1[r] = p1[r] - mn;
    for (int r = 0; r < 16; ++r) p0[r] = __builtin_amdgcn_exp2f(p0[r]);
}
__device__ __forceinline__ void finishSM(f32x16& p0, f32x16& p1, float alpha, float& l_reg, bf16x8& pa0, bf16x8& pa1, bf16x8& pa2, bf16x8& pa3) {
    for (int r = 0; r < 16; ++r) p1[r] = __builtin_amdgcn_exp2f(p1[r]);
    float ps = 0; for (int r = 0; r < 16; ++r) ps += p0[r]; for (int r = 0; r < 16; ++r) ps += p1[r];
    { auto rr = __builtin_amdgcn_permlane32_swap(__float_as_uint(ps), __float_as_uint(ps), false, false);
      ps = __uint_as_float(rr[0]) + __uint_as_float(rr[1]); }
    l_reg = l_reg * alpha + ps;
#define PK4(P, B_, OUT) do { unsigned a0 = cvtpk(P[B_+0], P[B_+1]), a1 = cvtpk(P[B_+2], P[B_+3]);                          \
        unsigned b0 = cvtpk(P[B_+4], P[B_+5]), b1 = cvtpk(P[B_+6], P[B_+7]);                                             \
        auto r0 = __builtin_amdgcn_permlane32_swap(a0, b0, false, false); auto r1 = __builtin_amdgcn_permlane32_swap(a1, b1, false, false); \
        u32x4 w = {r0[0], r1[0], r0[1], r1[1]}; OUT = *reinterpret_cast<bf16x8*>(&w); } while (0)
    PK4(p0, 0, pa0); PK4(p0, 8, pa1); PK4(p1, 0, pa2); PK4(p1, 8, pa3);
#undef PK4
}
template <int KB, bool SK>
__device__ __forceinline__ void qkt(f32x16& p0, f32x16& p1, const char* K_lds, int r32, int hi, const bf16x8* qr, bool act) {
    if (SK && !act) { const float NEG = -__builtin_inff();
#pragma unroll
        for (int r = 0; r < 16; ++r) { p0[r] = NEG; p1[r] = NEG; } return; }
    p0 = f32x16{}; p1 = f32x16{};
    const char* kb[4];
#pragma unroll
    for (int dd = 0; dd < 4; ++dd) kb[dd] = K_lds + KB * SHM_K + KSWZ(r32, (dd * 16 + hi * 8) * 2);
#pragma unroll
    for (int d0 = 0; d0 < 8; ++d0) { const char* a = kb[d0 & 3] + (d0 >> 2) * 128;
        bf16x8 b0 = *reinterpret_cast<const bf16x8*>(a);
        bf16x8 b1 = *reinterpret_cast<const bf16x8*>(a + 32 * 256);
        p0 = __builtin_amdgcn_mfma_f32_32x32x16_bf16(b0, qr[d0], p0, 0, 0, 0);
        p1 = __builtin_amdgcn_mfma_f32_32x32x16_bf16(b1, qr[d0], p1, 0, 0, 0); }
}
template <int VB, bool SK>
__device__ __forceinline__ void pv_tile(f32x16* o, int vb0, bf16x8 pa0, bf16x8 pa1, bf16x8 pa2, bf16x8 pa3, bool act) {
    if (SK && !act) return;
#define TRRD(dst, off) asm volatile("ds_read_b64_tr_b16 %0, %1 offset:%2" : "=&v"(dst) : "v"(vb0), "i"(off) : "memory")
#define PV_D0(d0) do { s16x4 l0, l1, l2, l3, h0, h1, h2, h3; constexpr int b_ = VB * SHM_V + v_rd_off(d0, 0, 0);     \
        TRRD(l0, b_); TRRD(h0, b_ + 2048); TRRD(l1, b_ + 4096); TRRD(h1, b_ + 6144); TRRD(l2, b_ + 8192); TRRD(h2, b_ + 10240); TRRD(l3, b_ + 12288); TRRD(h3, b_ + 14336); \
        asm volatile("s_waitcnt lgkmcnt(0)" ::: "memory"); SBAR();                 \
        o[d0] = __builtin_amdgcn_mfma_f32_32x32x16_bf16(pa0, (bf16x8){l0[0], l0[1], l0[2], l0[3], h0[0], h0[1], h0[2], h0[3]}, o[d0], 0, 0, 0);   \
        o[d0] = __builtin_amdgcn_mfma_f32_32x32x16_bf16(pa1, (bf16x8){l1[0], l1[1], l1[2], l1[3], h1[0], h1[1], h1[2], h1[3]}, o[d0], 0, 0, 0);   \
        o[d0] = __builtin_amdgcn_mfma_f32_32x32x16_bf16(pa2, (bf16x8){l2[0], l2[1], l2[2], l2[3], h2[0], h2[1], h2[2], h2[3]}, o[d0], 0, 0, 0);   \
        o[d0] = __builtin_amdgcn_mfma_f32_32x32x16_bf16(pa3, (bf16x8){l3[0], l3[1], l3[2], l3[3], h3[0], h3[1], h3[2], h3[3]}, o[d0], 0, 0, 0); } while (0)
    PV_D0(0); PV_D0(1); PV_D0(2); PV_D0(3);
#undef PV_D0
#undef TRRD
}

template <class TIn, class TOut> struct BlockRef { const TIn* Q; const TIn* K; const TIn* V; TOut* O; int P0; int jlo; const float* LS; const float* PK; const float* PQ; float thr2; };

template <class TIn, class TOut>
__device__ __forceinline__ void fox_block(const BlockRef<TIn, TOut>& cur, char* lds, const int wave_s) {
    int lane_; asm volatile("v_mbcnt_lo_u32_b32 %0, -1, 0\n\tv_mbcnt_hi_u32_b32 %0, -1, %0" : "=v"(lane_));
    const int tid = wave_s * 64 + lane_, wid = wave_s, lane = lane_, r32 = lane & 31, hi = lane >> 5;
    const int j_lo = cur.jlo, NT = (cur.P0 + QB) / KVBLK - j_lo;
    const int qlo = cur.P0 + wid * QBLK, qm = qlo + r32 - 4 * hi;
    char* V_lds = lds; char* K_lds = lds + 2 * SHM_V;
    float* ws = (float*)(lds + 2 * SHM_V + 2 * SHM_K) + wid * 64; float* li_l = ws, * al_l = ws + 32;
    const int sr = tid >> 4, sc = (tid & 15) * 8, vst0 = v_st(sr, sc), vst1 = v_st(32 + sr, sc), kws = KSWZ(sr, sc * 2);
    const int vb0 = (int)(uintptr_t)V_lds + v_rd_base(lane);
    float* Flt = (float*)(lds + FL_OFF); float* RKt = (float*)(lds + RK_OFF); const float* GGt = (const float*)(lds + GG_OFF); float* wsum = (float*)(lds + SCR_OFF);
    bf16x8 st_v0, st_v1, st_k0, st_k1;
#define FB_LOAD(j) do { const size_t o_ = (size_t)((j) * KVBLK + sr) * D + sc; st_v0 = load8<TIn>(cur.V + o_); st_v1 = load8<TIn>(cur.V + o_ + 32 * D); st_k0 = load8<TIn>(cur.K + o_); st_k1 = load8<TIn>(cur.K + o_ + 32 * D); } while (0)
#define FB_WRITE(bf) do { *(bf16x8*)(K_lds + (bf) * SHM_K + kws) = st_k0; *(bf16x8*)(K_lds + (bf) * SHM_K + kws + 32 * 256) = st_k1; *(bf16x8*)(V_lds + (bf) * SHM_V + vst0) = st_v0; *(bf16x8*)(V_lds + (bf) * SHM_V + vst1) = st_v1; } while (0)
    FB_LOAD(j_lo);
    bf16x8 qr[8];
#pragma unroll
    for (int d0 = 0; d0 < 8; ++d0) qr[d0] = load8<TIn>(cur.Q + (size_t)(wid * QBLK + r32) * D + d0 * 16 + hi * 8);
    { const int s0 = j_lo * KVBLK, len = cur.P0 + QB - s0;
      float carry = 0.f;
      const f32x4 pq = *(const f32x4*)(cur.PQ + (size_t)(cur.P0 + wid * QBLK + r32) * 64);
      for (int base = 0; base < len; base += NW * 64) { const int i = base + tid;
          float x = (i < len) ? cur.LS[s0 + i] : 0.f;
          f32x4 pk = {1.f, 1.f, 1.f, 1.f}; if (i < len) pk = *(const f32x4*)(cur.PK + (size_t)(s0 + i) * 64);
#pragma unroll
          for (int o = 1; o < 64; o <<= 1) { const float y = __shfl_up(x, o); if (lane >= o) x += y; }
          if (lane == 63) wsum[wid] = x;
          __syncthreads();
          float off = carry, tot = 0.f;
#pragma unroll
          for (int w = 0; w < NW; ++w) { const float ws_ = wsum[w]; tot += ws_; if (w < wid) off += ws_; }
          if (i < len) { Flt[i] = -(x + off) * LOG2E;
              RKt[i] = (SCALE * LOG2E) / sqrtf(((pk[0] + pk[1]) + (pk[2] + pk[3])) * (1.f / 128.f) + 1e-6f); }
          carry += tot;
          __syncthreads(); }
      const float rq = 1.f / sqrtf(((pq[0] + pq[1]) + (pq[2] + pq[3])) * (1.f / 128.f) + 1e-6f);
#pragma unroll
      for (int d0 = 0; d0 < 8; ++d0) { const f32x4 g0 = *(const f32x4*)(GGt + d0 * 16 + hi * 8), g1 = *(const f32x4*)(GGt + d0 * 16 + hi * 8 + 4);
          f32x4 a, b;
#pragma unroll
          for (int j = 0; j < 4; ++j) { a[j] = __uint_as_float(((unsigned)(unsigned short)qr[d0][j]) << 16) * (rq * g0[j]); b[j] = __uint_as_float(((unsigned)(unsigned short)qr[d0][4 + j]) << 16) * (rq * g1[j]); }
          qr[d0] = pack8(a, b); }
    }
    const float* Flb = Flt + 4 * hi; const float* RKb = RKt + 4 * hi;
    asm volatile("s_waitcnt vmcnt(0)" ::: "memory"); FB_WRITE(0);
    __syncthreads();
    float m_reg = -1e30f, l_reg = 0; f32x16 o[4] = {};
    for (int t = 0; t < NT; ++t) {
        const int buf = t & 1, kb = (j_lo + t) * KVBLK;
        if (t + 1 < NT) FB_LOAD(j_lo + t + 1);
        if (kb <= qlo + QBLK - 1 && !(Flt[qlo - j_lo * KVBLK] - Flt[t * KVBLK + KVBLK - 1] > cur.thr2)) {
            f32x16 p0, p1; float mn, al; bf16x8 pa0, pa1, pa2, pa3;
            qkt<0, false>(p0, p1, K_lds + buf * SHM_K, r32, hi, qr, true);
            if (kb + KVBLK - 1 > qlo) mask_tile(p0, p1, qm - kb, (unsigned)WBIG);
            partialSM(p0, p1, Flb + t * KVBLK, RKb + t * KVBLK, m_reg, mn, al);
            if (__any(al < 1.f)) { if (hi == 0) al_l[r32] = al; asm volatile("s_waitcnt lgkmcnt(0)" ::: "memory");
                for (int d_ = 0; d_ < 4; ++d_) for (int r = 0; r < 16; ++r) o[d_][r] *= al_l[crow(r, hi)]; }
            finishSM(p0, p1, al, l_reg, pa0, pa1, pa2, pa3); SBAR();
            pv_tile<0, false>(o, vb0 + buf * SHM_V, pa0, pa1, pa2, pa3, true);
        }
        if (t + 1 < NT) { asm volatile("s_waitcnt vmcnt(0)" ::: "memory"); FB_WRITE(buf ^ 1); }
        __syncthreads();
    }
    if (hi == 0) li_l[r32] = l_reg; asm volatile("s_waitcnt lgkmcnt(0)" ::: "memory");
    float rli[16];
#pragma unroll
    for (int r = 0; r < 16; ++r) rli[r] = __builtin_amdgcn_rcpf(li_l[crow(r, hi)]);
    TOut* Ow = cur.O + (size_t)(wid * QBLK) * OPITCH;
#pragma unroll
    for (int r = 0; r < 16; ++r) { const int orow = crow(r, hi);
#pragma unroll
        for (int d0 = 0; d0 < 4; ++d0) { const float v = o[d0][r] * rli[r]; const float vn = __shfl_xor(v, 1);
            if ((r32 & 1) == 0) *(unsigned*)(Ow + (size_t)orow * OPITCH + d0 * 32 + r32) = cvtpk(v, vn); } }
    __syncthreads();
#undef FB_LOAD
#undef FB_WRITE
}
}
namespace hg {
#define HG_LAS __attribute__((address_space(3)))
typedef short bf16x8 __attribute__((ext_vector_type(8)));
typedef short s16x4 __attribute__((ext_vector_type(4)));
typedef float f32x4 __attribute__((ext_vector_type(4)));
typedef unsigned u32x4 __attribute__((ext_vector_type(4)));
constexpr int RB = 272;
constexpr int PL = 0, KT = 64 * RB, KH = 2 * 64 * RB, VL = 3 * 64 * RB, A1 = 4 * 64 * RB, A1RB = 144, SK = A1 + 64 * A1RB, SC = SK + 128 * RB, B63 = SC + 8 * 128 * 4, DK = B63 + 512, HG_END = DK + 512;
constexpr int OL = 0, ORB = 132 * 4;
static_assert(64 * ORB <= 2 * 64 * RB && HG_END + 1024 <= 131072, "hgrn LDS map");
typedef float f32x2_t __attribute__((ext_vector_type(2))); typedef __bf16 bf16x2_t __attribute__((ext_vector_type(2)));
__device__ __forceinline__ unsigned cvtpk(float lo, float hi) { f32x2_t v = {lo, hi}; bf16x2_t b = __builtin_convertvector(v, bf16x2_t); return __builtin_bit_cast(unsigned, b); }
__device__ __forceinline__ float bf_lo(unsigned w) { return __uint_as_float(w << 16); }
__device__ __forceinline__ float bf_hi(unsigned w) { return __uint_as_float(w & 0xffff0000u); }
__device__ __forceinline__ s16x4 vtr(const HG_LAS char* p) { typedef short v4i16_t __attribute__((ext_vector_type(4))); return __builtin_bit_cast(s16x4, __builtin_amdgcn_ds_read_tr16_b64_v4i16((HG_LAS v4i16_t*)p)); }
__device__ __forceinline__ bf16x8 tr2(const HG_LAS char* base, int row0, int col0, int lane) {
    const int i = lane & 15, kq = lane >> 4; const HG_LAS char* p = base + (row0 + 8 * kq + (i >> 2)) * RB + (col0 + 4 * (i & 3)) * 2;
    const s16x4 lo = vtr(p), hi = vtr(p + 4 * RB); return (bf16x8){lo[0], lo[1], lo[2], lo[3], hi[0], hi[1], hi[2], hi[3]};
}
__device__ __forceinline__ bf16x8 rd8(const HG_LAS char* base, int pitch, int row0, int col0, int lane) { return *(const HG_LAS bf16x8*)(base + (row0 + (lane & 15)) * pitch + (col0 + 8 * (lane >> 4)) * 2); }
#define HG_MFMA(a, b, c) __builtin_amdgcn_mfma_f32_16x16x32_bf16(a, b, c, 0, 0, 0)

struct SegArgs { const unsigned short* qb; const unsigned short* fb; const unsigned short* ib; const unsigned short* gb; unsigned short* out; const HG_LAS float* lb; const HG_LAS float* ghn; int c_begin, c_end; };
constexpr int WARM = 8;
constexpr int DSUM = HG_END, FLG = DSUM + 512, HG_END2 = FLG + 64;
__device__ __forceinline__ void hgrn_segment(HG_LAS char* lds, const SegArgs a, const int wave_s) {
    int lane_; asm volatile("v_mbcnt_lo_u32_b32 %0, -1, 0\n\tv_mbcnt_hi_u32_b32 %0, -1, %0" : "=v"(lane_));
    const int tid = wave_s * 64 + lane_, wid = wave_s;
    const int kc = tid & 15, tg = tid >> 4;
    constexpr float LOG2E = 1.4426950408889634f, LN2 = 0.6931471805599453f;
    float lbv[8];
#pragma unroll
    for (int e = 0; e < 8; ++e) lbv[e] = a.lb[8 * kc + e];
    const size_t eoff = (size_t)(2 * tg) * 128 + 8 * kc;
    const int tb = wid >> 1;
    int w0 = a.c_begin - WARM; if (w0 < 0) w0 = 0;
    for (;;) {
    f32x4 sT[8];
#pragma unroll
    for (int kb = 0; kb < 8; ++kb) sT[kb] = (f32x4){0.f, 0.f, 0.f, 0.f};
    for (int i = tid; i < 128 * RB / 16; i += 512) *(HG_LAS u32x4*)(lds + SK + i * 16) = (u32x4){0u, 0u, 0u, 0u};
    if (tid < 128) ((HG_LAS float*)(lds + DSUM))[tid] = 0.f;
    u32x4 zr[2], qr[2], vr[2];
#pragma unroll
    for (int r = 0; r < 2; ++r) { const size_t o_ = eoff + (size_t)w0 * 64 * 128 + r * 128; zr[r] = *(const u32x4*)(a.fb + o_); qr[r] = *(const u32x4*)(a.qb + o_); vr[r] = *(const u32x4*)(a.ib + o_); }
    __syncthreads();
    bool redo = false;
    for (int c = w0; c < a.c_end; ++c) {
        const bool warm = c < a.c_begin;
        float g0[8], tot[8], inc[8];
#pragma unroll
        for (int e = 0; e < 8; ++e) { const float omlb = 1.f - lbv[e];
            const unsigned w0_ = zr[0][e >> 1], w1_ = zr[1][e >> 1]; const float z0 = (e & 1) ? bf_hi(w0_) : bf_lo(w0_), z1 = (e & 1) ? bf_hi(w1_) : bf_lo(w1_);
            const float s0 = __builtin_amdgcn_rcpf(1.f + __builtin_amdgcn_exp2f(-z0 * LOG2E)), s1 = __builtin_amdgcn_rcpf(1.f + __builtin_amdgcn_exp2f(-z1 * LOG2E));
            g0[e] = __builtin_amdgcn_logf(lbv[e] + omlb * s0) * LN2; tot[e] = g0[e] + __builtin_amdgcn_logf(lbv[e] + omlb * s1) * LN2; inc[e] = tot[e]; }
#pragma unroll
        for (int e = 0; e < 8; ++e) { float y = __shfl_up(inc[e], 16); if (lane_ >= 16) inc[e] += y; y = __shfl_up(inc[e], 32); if (lane_ >= 32) inc[e] += y; }
        if (lane_ >= 48) {
#pragma unroll
            for (int e = 0; e < 8; ++e) ((HG_LAS float*)(lds + SC))[wid * 128 + 8 * kc + e] = inc[e]; }
        __syncthreads();
        float b63[8];
#pragma unroll
        for (int e = 0; e < 8; ++e) { float off = 0.f, all = 0.f;
#pragma unroll
            for (int w = 0; w < 8; ++w) { const float s = ((const HG_LAS float*)(lds + SC))[w * 128 + 8 * kc + e]; all += s; if (w < wid) off += s; }
            inc[e] = off + inc[e] - tot[e]; b63[e] = all * LOG2E; }
        if (tg == 0) {
#pragma unroll
            for (int e = 0; e < 8; ++e) { ((HG_LAS float*)(lds + DK))[8 * kc + e] = __builtin_amdgcn_exp2f(b63[e]); if (warm) ((HG_LAS float*)(lds + DSUM))[8 * kc + e] += b63[e]; } }
#pragma unroll
        for (int r = 0; r < 2; ++r) { float kh[8];
            const int ro = (2 * tg + r) * RB + 16 * kc;
            if (!warm) { float pv[8], kt[8];
#pragma unroll
                for (int e = 0; e < 8; ++e) {
                    const float km = 1.f - __builtin_amdgcn_exp2f((r ? tot[e] - g0[e] : g0[e]) * LOG2E);
                    const unsigned w = qr[r][e >> 1]; const float q = (e & 1) ? bf_hi(w) : bf_lo(w);
                    const float sq = q * __builtin_amdgcn_rcpf(1.f + __builtin_amdgcn_exp2f(-q * LOG2E)); const float bl = (inc[e] + (r ? tot[e] : g0[e])) * LOG2E;
                    pv[e] = sq * __builtin_amdgcn_exp2f(bl); kt[e] = km * __builtin_amdgcn_exp2f(-bl); kh[e] = km * __builtin_amdgcn_exp2f(b63[e] - bl); }
                *(HG_LAS u32x4*)(lds + PL + ro) = (u32x4){cvtpk(pv[0], pv[1]), cvtpk(pv[2], pv[3]), cvtpk(pv[4], pv[5]), cvtpk(pv[6], pv[7])};
                *(HG_LAS u32x4*)(lds + KT + ro) = (u32x4){cvtpk(kt[0], kt[1]), cvtpk(kt[2], kt[3]), cvtpk(kt[4], kt[5]), cvtpk(kt[6], kt[7])};
            } else {
#pragma unroll
                for (int e = 0; e < 8; ++e) { const float km = 1.f - __builtin_amdgcn_exp2f((r ? tot[e] - g0[e] : g0[e]) * LOG2E);
                    const float bl = (inc[e] + (r ? tot[e] : g0[e])) * LOG2E; kh[e] = km * __builtin_amdgcn_exp2f(b63[e] - bl); }
            }
            *(HG_LAS u32x4*)(lds + KH + ro) = (u32x4){cvtpk(kh[0], kh[1]), cvtpk(kh[2], kh[3]), cvtpk(kh[4], kh[5]), cvtpk(kh[6], kh[7])};
            *(HG_LAS u32x4*)(lds + VL + ro) = vr[r]; }
        if (c + 1 < a.c_end) { const size_t no = eoff + (size_t)(c + 1) * 64 * 128;
#pragma unroll
            for (int r = 0; r < 2; ++r) { zr[r] = *(const u32x4*)(a.fb + no + r * 128); qr[r] = *(const u32x4*)(a.qb + no + r * 128); vr[r] = *(const u32x4*)(a.ib + no + r * 128); } }
        __syncthreads();
        u32x4 gcur[2];
        if (!warm) {
#pragma unroll
            for (int r = 0; r < 2; ++r) gcur[r] = *(const u32x4*)(a.gb + eoff + (size_t)c * 64 * 128 + r * 128); }
        int lane = lane_; asm volatile("" : "+v"(lane));
        const int q4 = lane >> 4, n16 = lane & 15;
        if (!warm) {
        { const int sb0 = 2 * (wid & 1); f32x4 c0 = {0.f, 0.f, 0.f, 0.f}, c1 = {0.f, 0.f, 0.f, 0.f};
          if (sb0 <= tb) {
#pragma unroll
            for (int ks = 0; ks < 4; ++ks) { const bf16x8 af = rd8(lds + PL, RB, 16 * tb, 32 * ks, lane);
                c0 = HG_MFMA(af, rd8(lds + KT, RB, 16 * sb0, 32 * ks, lane), c0); c1 = HG_MFMA(af, rd8(lds + KT, RB, 16 * sb0 + 16, 32 * ks, lane), c1); } }
#pragma unroll
          for (int r = 0; r < 4; ++r) { const int t = 16 * tb + 4 * q4 + r, s0 = 16 * sb0 + n16, s1 = s0 + 16;
              const float x0 = (s0 <= t) ? c0[r] : 0.f, x1 = (s1 <= t) ? c1[r] : 0.f;
              *(HG_LAS unsigned short*)(lds + A1 + t * A1RB + s0 * 2) = (unsigned short)(cvtpk(x0, 0.f) & 0xffffu);
              *(HG_LAS unsigned short*)(lds + A1 + t * A1RB + s1 * 2) = (unsigned short)(cvtpk(x1, 0.f) & 0xffffu); } }
        __syncthreads();
        f32x4 oc[4];
#pragma unroll
        for (int j = 0; j < 4; ++j) oc[j] = (f32x4){0.f, 0.f, 0.f, 0.f};
        { const int vb0 = 4 * (wid & 1);
#pragma unroll
          for (int ks = 0; ks < 4; ++ks) { const bf16x8 af = rd8(lds + PL, RB, 16 * tb, 32 * ks, lane);
#pragma unroll
              for (int j = 0; j < 4; ++j) oc[j] = HG_MFMA(af, tr2(lds + SK, 32 * ks, 16 * (vb0 + j), lane), oc[j]); }
#pragma unroll
          for (int ks = 0; ks < 2; ++ks) { const bf16x8 af = rd8(lds + A1, A1RB, 16 * tb, 32 * ks, lane);
#pragma unroll
              for (int j = 0; j < 4; ++j) oc[j] = HG_MFMA(af, tr2(lds + VL, 32 * ks, 16 * (vb0 + j), lane), oc[j]); } }
        __syncthreads();
        { const int vb0 = 4 * (wid & 1);
#pragma unroll
          for (int j = 0; j < 4; ++j)
#pragma unroll
              for (int r = 0; r < 4; ++r) *(HG_LAS float*)(lds + OL + (16 * tb + 4 * q4 + r) * ORB + (16 * (vb0 + j) + n16) * 4) = oc[j][r]; }
        }
#pragma unroll
        for (int kb = 0; kb < 8; ++kb) { const float d = ((const HG_LAS float*)(lds + DK))[16 * kb + n16]; sT[kb] = sT[kb] * d; }
#pragma unroll
        for (int ks = 0; ks < 2; ++ks) { const bf16x8 af = tr2(lds + VL, 32 * ks, 16 * wid, lane);
#pragma unroll
            for (int kb = 0; kb < 8; ++kb) sT[kb] = HG_MFMA(af, tr2(lds + KH, 32 * ks, 16 * kb, lane), sT[kb]); }
#pragma unroll
        for (int kb = 0; kb < 8; ++kb) { typedef unsigned u32x2 __attribute__((ext_vector_type(2)));
            *(HG_LAS u32x2*)(lds + SK + (16 * kb + n16) * RB + (16 * wid + 4 * q4) * 2) = (u32x2){cvtpk(sT[kb][0], sT[kb][1]), cvtpk(sT[kb][2], sT[kb][3])}; }
        if (!warm) {
        __syncthreads();
#pragma unroll
        for (int r = 0; r < 2; ++r) { const int t = 2 * tg + r;
            const f32x4 o0 = *(const HG_LAS f32x4*)(lds + OL + t * ORB + 32 * kc), o1 = *(const HG_LAS f32x4*)(lds + OL + t * ORB + 32 * kc + 16);
            float ss = ((o0[0] * o0[0] + o0[1] * o0[1]) + (o0[2] * o0[2] + o0[3] * o0[3])) + ((o1[0] * o1[0] + o1[1] * o1[1]) + (o1[2] * o1[2] + o1[3] * o1[3]));
            ss += __shfl_xor(ss, 1); ss += __shfl_xor(ss, 2); ss += __shfl_xor(ss, 4); ss += __shfl_xor(ss, 8);
            const float rstd = 1.f / sqrtf(ss * (1.f / 128.f) + 1e-6f);
            float y[8], ghv[8]; { const f32x4 ga = *(const HG_LAS f32x4*)(a.ghn + 8 * kc), gb_ = *(const HG_LAS f32x4*)(a.ghn + 8 * kc + 4); ghv[0] = ga[0]; ghv[1] = ga[1]; ghv[2] = ga[2]; ghv[3] = ga[3]; ghv[4] = gb_[0]; ghv[5] = gb_[1]; ghv[6] = gb_[2]; ghv[7] = gb_[3]; }
#pragma unroll
            for (int e = 0; e < 8; ++e) { const unsigned w = gcur[r][e >> 1]; const float gt = (e & 1) ? bf_hi(w) : bf_lo(w);
                const float sgt = gt * __builtin_amdgcn_rcpf(1.f + __builtin_amdgcn_exp2f(-gt * LOG2E)); const float o = (e < 4) ? o0[e & 3] : o1[e & 3];
                y[e] = (o * rstd * ghv[e]) * sgt; }
            *(u32x4*)(a.out + ((size_t)c * 64 + t) * 4096 + 8 * kc) = (u32x4){cvtpk(y[0], y[1]), cvtpk(y[2], y[3]), cvtpk(y[4], y[5]), cvtpk(y[6], y[7])}; }
        } else if (c + 1 == a.c_begin && w0 > 0) {
            __syncthreads();
            bool ok = true;
#pragma unroll
            for (int e = 0; e < 8; ++e) ok = ok && (((const HG_LAS float*)(lds + DSUM))[8 * kc + e] < -104.f * LOG2E);
            const bool wok = __all(ok);
            if (lane == 0) ((HG_LAS unsigned*)(lds + FLG))[wid] = wok ? 1u : 0u;
            __syncthreads();
            unsigned allok = 1u;
#pragma unroll
            for (int w = 0; w < 8; ++w) allok &= ((const HG_LAS unsigned*)(lds + FLG))[w];
#if !defined(PROBE_NOCHECK)
            if (!allok) { redo = true; break; }
#else
            (void)allok;
#endif
        }
    }
    if (!redo) break;
    __syncthreads();
    w0 -= WARM; if (w0 < 0) w0 = 0;
    }
    __syncthreads();
}
#undef HG_MFMA
}
#define GAS __attribute__((address_space(1)))
#define LAS __attribute__((address_space(3)))
typedef unsigned short bf16;
typedef unsigned v4u __attribute__((ext_vector_type(4)));
typedef float f32x4 __attribute__((ext_vector_type(4)));
typedef short bf16x8 __attribute__((ext_vector_type(8)));
typedef GAS unsigned gu32;
typedef GAS unsigned long long gu64;
#define RLX_AGENT __ATOMIC_RELAXED, __HIP_MEMORY_SCOPE_AGENT
#define LDS_WAIT() asm volatile("s_waitcnt lgkmcnt(0)" ::: "memory")
#define VM_WAIT() asm volatile("s_waitcnt vmcnt(0)" ::: "memory")
__device__ __forceinline__ unsigned long long rt() { return __builtin_amdgcn_s_memrealtime(); }
__device__ __forceinline__ unsigned f2bf(float f) { unsigned u = __builtin_bit_cast(unsigned, f); return (u + 0x7fffu + ((u >> 16) & 1u)) >> 16; }
__device__ __forceinline__ unsigned pk2(float lo, float hi) { return f2bf(lo) | (f2bf(hi) << 16); }

#define XB_TMO      128
#define XB_XCNT(j)  (256  + 64 * (j))
#define XB_XSUB(j)  (1280 + 64 * (j))
#define XB_XGEN(j)  (2304 + 64 * (j))
#define XB_TOP      3328
#define XB_TOPGEN   3392
#define XCD_BAR_WORDS 3456
#define XB_SPIN_CAP (1u << 18)

__device__ __forceinline__ unsigned xb_ld(unsigned* p)              { return __hip_atomic_load(p, __ATOMIC_RELAXED, __HIP_MEMORY_SCOPE_AGENT); }
__device__ __forceinline__ unsigned xb_add(unsigned* p, unsigned v) { return __hip_atomic_fetch_add(p, v, __ATOMIC_RELAXED, __HIP_MEMORY_SCOPE_AGENT); }
__device__ __forceinline__ unsigned xb_xcc_id() { return (unsigned)__builtin_amdgcn_s_getreg((3 << 11) | 20) & 0xFu; }
#define XB_SPIN(cond, bar) do { unsigned _sp = 0; while (cond) { __builtin_amdgcn_s_sleep(1); \
    if ((++_sp & 255u) == 0u) { if (xb_ld(&(bar)[XB_TMO])) break; if (_sp > XB_SPIN_CAP) { atomicAdd(&(bar)[XB_TMO], 1u); break; } } } } while (0)

__device__ __forceinline__ int lane_now() { int l; asm volatile("v_mbcnt_lo_u32_b32 %0, -1, 0\n\tv_mbcnt_hi_u32_b32 %0, -1, %0" : "=v"(l)); return l; }
struct XcdBarrier {
    unsigned* bar; unsigned x; int w0;
    volatile LAS unsigned* st;
};

__device__ __forceinline__ XcdBarrier xcd_barrier_post(unsigned* bar, volatile LAS unsigned* st) {
    XcdBarrier b; b.bar = bar; b.x = xb_xcc_id(); b.st = st; b.w0 = __builtin_amdgcn_readfirstlane((int)threadIdx.x >> 6);
    if (threadIdx.x == 0) (void)xb_add(&bar[XB_XCNT(b.x)], 1u);
    return b;
}
__device__ __forceinline__ void xcd_barrier_complete(unsigned* bar, unsigned x, unsigned& nloc, unsigned& nx) {
    const unsigned G = gridDim.x * gridDim.y * gridDim.z;
    unsigned sum, cnt, mine, sp = 0u;
    for (;;) {
        sum = 0u; cnt = 0u; mine = 0u;
#pragma unroll
        for (unsigned j = 0; j < 16; ++j) { const unsigned c = xb_ld(&bar[XB_XCNT(j)]); sum += c; cnt += (c > 0u) ? 1u : 0u; mine = (j == x) ? c : mine; }
        if (sum == G) break;
        __builtin_amdgcn_s_sleep(1);
        if ((++sp & 255u) == 0u) { if (xb_ld(&bar[XB_TMO])) break; if (sp > XB_SPIN_CAP) { atomicAdd(&bar[XB_TMO], 1u); break; } }
    }
    nloc = mine > 0u ? mine : 1u; nx = cnt > 0u ? cnt : 1u;
}

__device__ __forceinline__ void xcd_barrier(const XcdBarrier& b) {
    asm volatile("s_waitcnt vmcnt(0)" ::: "memory");
    __syncthreads();
    if (b.w0 == 0 && lane_now() == 0) {
        unsigned* bar = b.bar;
        __builtin_amdgcn_s_waitcnt(0);
        unsigned nloc = b.st[0], nx = b.st[1];
        if (nloc == 0u) { xcd_barrier_complete(bar, b.x, nloc, nx); b.st[0] = nloc; b.st[1] = nx; }
        const unsigned old = xb_add(&bar[XB_XSUB(b.x)], 1u);
        const unsigned gen = old / nloc;
        if (old + 1u == (gen + 1u) * nloc) {
            __builtin_amdgcn_fence(__ATOMIC_RELEASE, "agent");
            asm volatile("s_waitcnt vmcnt(0)" ::: "memory");
            const unsigned og = xb_add(&bar[XB_TOP], 1u);
            const unsigned tg = og / nx;
            if (og + 1u == (tg + 1u) * nx) xb_add(&bar[XB_TOPGEN], 1u);
            else XB_SPIN(xb_ld(&bar[XB_TOPGEN]) == tg, bar);
            __builtin_amdgcn_fence(__ATOMIC_ACQUIRE, "agent");
            xb_add(&bar[XB_XGEN(b.x)], 1u);
            asm volatile("s_waitcnt vmcnt(0)" ::: "memory");
        } else {
            XB_SPIN(xb_ld(&bar[XB_XGEN(b.x)]) == gen, bar);
            __builtin_amdgcn_fence(__ATOMIC_ACQUIRE, "agent");
            asm volatile("s_waitcnt vmcnt(0)" ::: "memory");
        }
    }
    __syncthreads();
}
__device__ __forceinline__ void group_sync(const XcdBarrier& b, unsigned* cnt, unsigned n) {
    asm volatile("s_waitcnt vmcnt(0)" ::: "memory");
    __syncthreads();
    if (b.w0 == 0 && lane_now() == 0) {
        __builtin_amdgcn_s_waitcnt(0);
        __builtin_amdgcn_fence(__ATOMIC_RELEASE, "agent");
        asm volatile("s_waitcnt vmcnt(0)" ::: "memory");
        (void)xb_add(cnt, 1u);
        XB_SPIN(xb_ld(cnt) < n, b.bar);
        __builtin_amdgcn_fence(__ATOMIC_ACQUIRE, "agent");
        asm volatile("s_waitcnt vmcnt(0)" ::: "memory");
    }
    __syncthreads();
}
typedef unsigned short u16;
constexpr int NWAVES = 8;
constexpr int BATCH = 2, SEQ = 8192, DM = 4096, NH = 16, HD = 128, DFF = 16384, PLE = 256;
constexpr int M = BATCH * SEQ;
constexpr int NIN = 14352, NPROJ = 14336, FA_COL = 6144;
constexpr float RMS_EPS = 1e-6f;
constexpr size_t MiB = 1u << 20;
constexpr size_t WS_CTL = 0, CTL_ZERO_BYTES = 65536;
constexpr size_t WS_WFA = 1 * MiB;
constexpr size_t WS_LS = 2 * MiB;
constexpr size_t WS_BS = 3 * MiB;
constexpr size_t WS_PQK = 4 * MiB;
constexpr size_t WS_P1 = 12 * MiB, WS_P2 = 16 * MiB, WS_PE = 20 * MiB;
constexpr size_t WS_WGATE = 24 * MiB, WS_WDOWN = 40 * MiB, WS_WUP = 168 * MiB, WS_WOUT = 296 * MiB, WS_WPLE = 328 * MiB;
constexpr size_t WS_PB = 330 * MiB;
constexpr size_t WS_ACTA = 338 * MiB;
constexpr size_t WS_WIN = 466 * MiB;
constexpr size_t WS_PROJ = 578 * MiB;
constexpr size_t WS_H1B = 808 * MiB;
constexpr size_t WS_HID = 296 * MiB;
constexpr size_t WS_ERAW = 936 * MiB;
constexpr size_t WS_H2F8 = 1064 * MiB;
constexpr size_t WS_RS0 = 12 * MiB;
constexpr size_t WS_IDB = 1128 * MiB;
constexpr size_t WS_END = 1130 * MiB;
constexpr size_t PROJ_T = (size_t)2 * 16 * 8192 * 128;
constexpr int CW_TMO = 0, CW_BAR = 4096, CW_GRP = 8192;
static_assert(CW_BAR + XCD_BAR_WORDS <= CW_GRP && (CW_GRP + 2 * 64 * 64) * 4 <= (int)CTL_ZERO_BYTES, "control words");
constexpr int LDS_BYTES = 163840;
constexpr int RING_OFF = 0;
constexpr int TAB_OFF = 160768, TAB_RS = TAB_OFF, TAB_RSE = TAB_OFF + 1024;
constexpr int MISC_OFF = 162816;
static_assert(fa::FA_LDS_END <= TAB_OFF && hg::HG_END2 + 1024 <= TAB_OFF, "LDS map");

struct Frame {
    LAS unsigned char* lds; volatile LAS unsigned* MISC; gu32* ctl;
    int tid, lane, wave, vcu, G;
};
__device__ __forceinline__ float wave_sum(float v) {
#pragma unroll
    for (int o = 1; o < 64; o <<= 1) v += __shfl_xor(v, o);
    return v;
}
struct TItem { const float* W; const float* g; unsigned char* WT; int ldw, K, k0, src0, dst0; float scale; int fp8; };
__device__ __forceinline__ void p0_item_load(const TItem& t, float (&wv)[32], int lane) {
#pragma unroll
    for (int i = 0; i < 32; ++i) wv[i] = t.W[(size_t)(t.k0 + 2 * i + (lane >> 5)) * t.ldw + t.src0 + (lane & 31)];
}
__device__ __forceinline__ unsigned pk4_fp8(float a, float b, float c, float d) { int p = __builtin_amdgcn_cvt_pk_fp8_f32(a, b, 0, false); p = __builtin_amdgcn_cvt_pk_fp8_f32(c, d, p, true); return (unsigned)p; }
__device__ __forceinline__ void p0_item_finish(const TItem& t, const float (&wv)[32], LAS float* scr, int lane) {
#pragma unroll
    for (int i = 0; i < 32; ++i) { const int kk = 2 * i + (lane >> 5); float w = wv[i] * t.scale; if (t.g) w *= t.g[t.k0 + kk]; scr[kk * 33 + (lane & 31)] = w; }
    LDS_WAIT(); asm volatile("" ::: "memory");
    const int c = lane & 7;
    if (t.fp8) {
#pragma unroll
        for (int j = 0; j < 4; ++j) { const int n = (lane >> 3) + 8 * j; const LAS float* s = scr + (8 * c) * 33 + n;
            typedef unsigned u32x2_ __attribute__((ext_vector_type(2)));
            u32x2_ o; o.x = pk4_fp8(s[0 * 33], s[1 * 33], s[2 * 33], s[3 * 33]); o.y = pk4_fp8(s[4 * 33], s[5 * 33], s[6 * 33], s[7 * 33]);
            *(GAS u32x2_*)(t.WT + (size_t)(t.dst0 + n) * t.K + t.k0 + 8 * c) = o; }
    } else {
#pragma unroll
        for (int j = 0; j < 4; ++j) { const int n = (lane >> 3) + 8 * j; const LAS float* s = scr + (8 * c) * 33 + n;
            v4u o; o.x = pk2(s[0 * 33], s[1 * 33]); o.y = pk2(s[2 * 33], s[3 * 33]); o.z = pk2(s[4 * 33], s[5 * 33]); o.w = pk2(s[6 * 33], s[7 * 33]);
            *(GAS v4u*)((u16*)t.WT + (size_t)(t.dst0 + n) * t.K + t.k0 + 8 * c) = o; }
    }
    LDS_WAIT(); asm volatile("" ::: "memory");
}
constexpr float GATE_WSCALE = 64.f;
struct Args { const float* in[17]; float* out; unsigned char* ws; };
typedef const __attribute__((address_space(4))) Args KArgs;
__device__ __forceinline__ KArgs* karg_ptr() { KArgs* kp = (KArgs*)__builtin_amdgcn_kernarg_segment_ptr(); asm volatile("" : "+s"(kp)); return kp; }

__device__ __forceinline__ void p0_prologue(Frame& F) {
    KArgs& A = *karg_ptr(); unsigned char* ws = A.ws;
    LAS float* scr = (LAS float*)(F.lds + RING_OFF + F.wave * 16384);
    const int gw = F.vcu * NWAVES + F.wave, NGW = F.G * NWAVES;
    constexpr int I_IN = (DM / 64) * (NPROJ / 32), I_OUT = (DM / 64) * (DM / 32), I_UP = (DM / 64) * (DFF / 32), I_DN = (DFF / 64) * (DM / 32), I_GT = I_OUT, I_PL = (PLE / 64) * (DM / 32);
    constexpr int NITEMS = I_IN + I_OUT + I_UP + I_DN + I_GT + I_PL;
    auto decode = [&](int r) { TItem t; t.scale = 1.f; t.fp8 = 0; t.g = nullptr;
        if (r < I_IN) { const int nblk = NPROJ / 32, kb = r / nblk, n0 = 32 * (r % nblk); t.W = A.in[3]; t.ldw = NIN; t.K = DM; t.g = A.in[2]; t.WT = ws + WS_WIN; t.k0 = 64 * kb; t.src0 = n0 + (n0 >= FA_COL ? 16 : 0); t.dst0 = n0; return t; } r -= I_IN;
        if (r < I_OUT) { const int nblk = DM / 32; t.W = A.in[9]; t.ldw = DM; t.K = DM; t.WT = ws + WS_WOUT; t.k0 = 64 * (r / nblk); t.src0 = t.dst0 = 32 * (r % nblk); return t; } r -= I_OUT;
        if (r < I_UP) { const int nblk = DFF / 32; t.W = A.in[11]; t.ldw = DFF; t.K = DM; t.g = A.in[10]; t.WT = ws + WS_WUP; t.k0 = 64 * (r / nblk); t.src0 = t.dst0 = 32 * (r % nblk); return t; } r -= I_UP;
        if (r < I_DN) { const int nblk = DM / 32; t.W = A.in[12]; t.ldw = DM; t.K = DFF; t.WT = ws + WS_WDOWN; t.k0 = 64 * (r / nblk); t.src0 = t.dst0 = 32 * (r % nblk); return t; } r -= I_DN;
        if (r < I_GT) { const int nblk = DM / 32; t.W = A.in[14]; t.ldw = DM; t.K = DM; t.g = A.in[13]; t.scale = GATE_WSCALE; t.fp8 = 1; t.WT = ws + WS_WGATE; t.k0 = 64 * (r / nblk); t.src0 = t.dst0 = 32 * (r % nblk); return t; } r -= I_GT;
        { const int nblk = DM / 32; t.W = A.in[15]; t.ldw = DM; t.K = PLE; t.WT = ws + WS_WPLE; t.k0 = 64 * (r / nblk); t.src0 = t.dst0 = 32 * (r % nblk); return t; } };
    if (gw < NITEMS) {
        float wa[32], wb[32]; int it = gw; TItem ta = decode(it), tb = ta; p0_item_load(ta, wa, F.lane);
        for (;;) {
            const bool hb = it + NGW < NITEMS; if (hb) { tb = decode(it + NGW); p0_item_load(tb, wb, F.lane); }
            p0_item_finish(ta, wa, scr, F.lane); if (!hb) break;
            const bool ha = it + 2 * NGW < NITEMS; if (ha) { ta = decode(it + 2 * NGW); p0_item_load(ta, wa, F.lane); }
            p0_item_finish(tb, wb, scr, F.lane); if (!ha) break;
            it += 2 * NGW; }
    }
    { const int gt = F.vcu * 512 + F.tid, NT = F.G * 512;
      for (int i = gt; i < 16 * DM; i += NT) { const int n = i >> 12, k = i & 4095; ((u16*)(ws + WS_WFA))[i] = (u16)f2bf(A.in[3][(size_t)k * NIN + FA_COL + n] * A.in[2][k]); }
      for (int i = gt; i < 256 * 256; i += NT) ((u16*)(ws + WS_IDB))[(size_t)(i >> 8) * DM + (i & 255)] = ((i >> 8) == (i & 255)) ? (u16)0x3F80u : (u16)0u;
      const f32x4* p4 = (const f32x4*)A.in[1]; unsigned long long* pb = (unsigned long long*)(ws + WS_PB);
      for (int i = gt; i < M * PLE / 4; i += NT) { const f32x4 v = p4[i]; pb[i] = (unsigned long long)pk2(v.x, v.y) | ((unsigned long long)pk2(v.z, v.w) << 32); } }
    { float* RS0 = (float*)(ws + WS_RS0);
      auto xload = [&](f32x4 (&v)[16], int m) { const f32x4* xr = (const f32x4*)(A.in[0] + (size_t)m * DM);
#pragma unroll
          for (int j = 0; j < 8; ++j) { v[2 * j] = xr[128 * j + 2 * F.lane]; v[2 * j + 1] = xr[128 * j + 2 * F.lane + 1]; } };
      auto xrow = [&](const f32x4 (&v)[16], int m) { float s = 0.f;
          v4u* xo = (v4u*)((u16*)A.out + (size_t)m * DM);
#pragma unroll
          for (int j = 0; j < 8; ++j) { v4u xw; xw.x = pk2(v[2 * j].x, v[2 * j].y); xw.y = pk2(v[2 * j].z, v[2 * j].w); xw.z = pk2(v[2 * j + 1].x, v[2 * j + 1].y); xw.w = pk2(v[2 * j + 1].z, v[2 * j + 1].w); xo[64 * j + F.lane] = xw; }
#pragma unroll
          for (int j = 0; j < 16; ++j) s += (v[j].x * v[j].x + v[j].y * v[j].y) + (v[j].z * v[j].z + v[j].w * v[j].w);
          const float rstd = 1.f / sqrtf(wave_sum(s) * (1.f / DM) + RMS_EPS);
          if (F.lane == 0) RS0[m] = rstd; };
      if (gw < M) {
          f32x4 va[16], vb[16]; int m = gw; xload(va, m);
          for (;;) {
              const bool hb = m + NGW < M; if (hb) xload(vb, m + NGW);
              xrow(va, m); if (!hb) break;
              const bool ha = m + 2 * NGW < M; if (ha) xload(va, m + 2 * NGW);
              xrow(vb, m + NGW); if (!ha) break;
              m += 2 * NGW; } } }
}
__device__ __forceinline__ void fa_tile(Frame& F, int tile) {
    KArgs& A = *karg_ptr(); unsigned char* ws = A.ws; const u16* U = (const u16*)A.out; const u16* WF = (const u16*)(ws + WS_WFA);
    const int R0 = tile * 64, b = R0 >> 13, t0 = R0 & 8191, n16 = F.lane & 15, q4 = F.lane >> 4;
    f32x4 acc[4];
#pragma unroll
    for (int rb = 0; rb < 4; ++rb) acc[rb] = (f32x4){0.f, 0.f, 0.f, 0.f};
    const u16* ap = U + (size_t)(R0 + n16) * DM + F.wave * 512 + 8 * q4; const u16* bp = WF + (size_t)n16 * DM + F.wave * 512 + 8 * q4;
#pragma unroll
    for (int h = 0; h < 2; ++h) { bf16x8 af[8][4], bfr[8];
#pragma unroll
        for (int s = 0; s < 8; ++s) { bfr[s] = *(const bf16x8*)(bp + 32 * (8 * h + s));
#pragma unroll
            for (int rb = 0; rb < 4; ++rb) af[s][rb] = *(const bf16x8*)(ap + (size_t)(16 * rb) * DM + 32 * (8 * h + s)); }
#pragma unroll
        for (int s = 0; s < 8; ++s)
#pragma unroll
            for (int rb = 0; rb < 4; ++rb) acc[rb] = __builtin_amdgcn_mfma_f32_16x16x32_bf16(af[s][rb], bfr[s], acc[rb], 0, 0, 0); }
    LAS float* red = (LAS float*)(F.lds + RING_OFF);
    LAS float* bsum = (LAS float*)(F.lds + RING_OFF + 32768);
#pragma unroll
    for (int rb = 0; rb < 4; ++rb) *(LAS f32x4*)(red + ((F.wave * 4 + rb) * 64 + F.lane) * 4) = acc[rb];
    __syncthreads();
    if (F.wave < 4) { const int rb = F.wave; f32x4 o = {0.f, 0.f, 0.f, 0.f};
#pragma unroll
        for (int w = 0; w < 8; ++w) o += *(const LAS f32x4*)(red + ((w * 4 + rb) * 64 + F.lane) * 4);
        const float bias = A.in[4][n16]; float ts = 0.f;
        const f32x4 rs = *(const f32x4*)((const float*)(ws + WS_RS0) + R0 + 16 * rb + 4 * q4);
        float* LS = (float*)(ws + WS_LS) + (size_t)(b * 16 + n16) * 8192 + t0 + 16 * rb + 4 * q4;
        f32x4 l;
#pragma unroll
        for (int r = 0; r < 4; ++r) { const float v = o[r] * rs[r] + bias; l[r] = fminf(v, 0.f) - __builtin_amdgcn_logf(1.f + __builtin_amdgcn_exp2f(-fabsf(v) * 1.4426950408889634f)) * 0.6931471805599453f; ts += l[r]; }
        *(f32x4*)LS = l;
        ts += __shfl_xor(ts, 16); ts += __shfl_xor(ts, 32);
        if (q4 == 0) bsum[rb * 16 + n16] = ts; }
    __syncthreads();
    if (F.tid < 16) { const float s = (bsum[F.tid] + bsum[16 + F.tid]) + (bsum[32 + F.tid] + bsum[48 + F.tid]); ((float*)(ws + WS_BS))[(b * 16 + F.tid) * 128 + (t0 >> 6)] = s; }
    __syncthreads();
}
__device__ __forceinline__ void row_table(Frame& F, const float* part, int row0, LAS float* tab) {
    if (F.tid < 256) { const f32x4* p = (const f32x4*)(part + (size_t)(row0 + F.tid) * 64); float s = 0.f;
#pragma unroll
        for (int j = 0; j < 16; ++j) { const f32x4 v = p[j]; s += (v.x + v.y) + (v.z + v.w); }
        tab[F.tid] = 1.f / sqrtf(s * (1.f / DM) + RMS_EPS); }
    __syncthreads();
}

typedef __hip_bfloat16 hbf; typedef fa::BlockRef<hbf, hbf> FoxRef;
__device__ __forceinline__ FoxRef fox_ref(int L, const u16* PJ, u16* MIX, const float* BS, const float* LS, const float* PQK, float bqk2) {
    const int bh = L >> 5, qb = L & 31, b = bh >> 4, h = bh & 15; FoxRef r;
    r.Q = (const hbf*)(PJ + 0 * PROJ_T + ((size_t)bh * 8192 + qb * 256) * 128); r.K = (const hbf*)(PJ + 1 * PROJ_T + (size_t)bh * 8192 * 128); r.V = (const hbf*)(PJ + 2 * PROJ_T + (size_t)bh * 8192 * 128);
    r.O = (hbf*)(MIX + ((size_t)b * 8192 + qb * 256) * 4096 + 128 * h); r.P0 = qb * 256;
    int jlo = qb * 4; float sacc = 0.f; while (jlo > 0 && bqk2 + sacc >= -110.f) { --jlo; sacc += BS[bh * 128 + jlo]; }
    r.jlo = jlo; r.thr2 = (110.f + bqk2) * 1.4426950408889634f; r.LS = LS + (size_t)bh * 8192; r.PK = PQK + ((size_t)(16384 + b * 8192) * 16 + h) * 4; r.PQ = PQK + ((size_t)(b * 8192) * 16 + h) * 4; return r;
}

__global__ void __launch_bounds__(NWAVES * 64, 2) fwd_kernel(Args args) {
    extern __shared__ __attribute__((aligned(16))) unsigned char lds[];
    Frame F;
    F.lds = (LAS unsigned char*)lds;
    F.MISC = (volatile LAS unsigned*)(F.lds + MISC_OFF);
#define REFRESH_TID() do { const int l_ = lane_now(); F.tid = wave0 * 64 + l_; F.lane = l_; F.wave = wave0; } while (0)
    const int wave0 = __builtin_amdgcn_readfirstlane((int)threadIdx.x >> 6);
    REFRESH_TID();
    F.G = gridDim.x; { const int bx = blockIdx.x; F.vcu = (F.G % 8 == 0) ? (bx % 8) * (F.G / 8) + bx / 8 : bx; }
    F.ctl = (gu32*)(karg_ptr()->ws + WS_CTL);
    for (int u = F.tid; u < (LDS_BYTES - MISC_OFF) / 4; u += NWAVES * 64) ((LAS unsigned*)(F.lds + MISC_OFF))[u] = 0u;
    __syncthreads();
    XcdBarrier bar = xcd_barrier_post((unsigned*)(F.ctl + CW_BAR), F.MISC + 8);
    const int G = F.G, cb = (int)blockIdx.x;

#ifndef PHM
#define PHM 0xff
#endif
#if PHM & 1
    REFRESH_TID(); p0_prologue(F);
#endif
    xcd_barrier(bar);

#if PHM & 2
    REFRESH_TID();
    for (int tile = F.vcu; tile < M / 64; tile += G) fa_tile(F, tile);
    { unsigned char* ws = karg_ptr()->ws;
      pg8::Gemm g{(const pg8::bf16_t*)karg_ptr()->out, (const pg8::bf16_t*)(ws + WS_WIN), M, NPROJ, DM, nullptr, nullptr}; pg8::StaticOrder S; S.init(M, NPROJ, G, cb);
      { pg8::Unit u0; if (S.next(0, u0) && F.tid < 256) ((LAS float*)(F.lds + TAB_RS))[F.tid] = ((const float*)(ws + WS_RS0))[u0.pm * 256 + F.tid]; __syncthreads(); }
      pg8::EpiProj E{(pg8::bf16_t*)(ws + WS_PROJ), (float*)(ws + WS_PQK), (const LAS float*)(F.lds + TAB_RS)};
      pg8::gemm_phase<pg8::EpiProj, pg8::StaticOrder, true, true>(F.lds + RING_OFF, g, S, E, wave0); }
#endif
    xcd_barrier(bar);

#if PHM & 4
    REFRESH_TID();
    {
        KArgs& args = *karg_ptr(); unsigned char* ws = args.ws;
        const u16* PJ = (const u16*)(ws + WS_PROJ); u16* MIX = (u16*)(ws + WS_ACTA);
        constexpr int HSEG = 16, NSEG = (SEQ / 64) / HSEG, NHITEM = 32 * NSEG;
#if defined(PROBE_HG)
        for (int it2 = F.vcu; it2 < 2 * NHITEM; it2 += G) { const int it = it2 % NHITEM;
#else
        for (int it = F.vcu; it < NHITEM; it += G) {
#endif
            LAS float* lbt = (LAS float*)(F.lds + hg::HG_END2);
            const int bh = it / NSEG, seg = it % NSEG, b = bh >> 4, h = bh & 15;
            if (F.tid < 128) { const float l0 = args.in[7][h * 128 + F.tid], l1 = args.in[7][2048 + h * 128 + F.tid]; const float mx = fmaxf(l0, l1), e0 = __expf(l0 - mx), e1 = __expf(l1 - mx); lbt[F.tid] = e0 / (e0 + e1); lbt[128 + F.tid] = args.in[8][F.tid]; }
            __syncthreads();
            hg::SegArgs a{PJ + 3 * PROJ_T + (size_t)bh * 8192 * 128, PJ + 4 * PROJ_T + (size_t)bh * 8192 * 128, PJ + 5 * PROJ_T + (size_t)bh * 8192 * 128, PJ + 6 * PROJ_T + (size_t)bh * 8192 * 128,
                          MIX + (size_t)b * 8192 * 4096 + 2048 + 128 * h, (const HG_LAS float*)lbt, (const HG_LAS float*)(lbt + 128), seg * HSEG, seg * HSEG + HSEG};
            hg::hgrn_segment((HG_LAS char*)F.lds, a, wave0);
        }
        {
            typedef hbf hb; typedef FoxRef Ref;
            LAS float* GGt = (LAS float*)(F.lds + fa::GG_OFF);
            if (F.tid < 128) GGt[F.tid] = args.in[5][F.tid] * args.in[6][F.tid];
            float gq = 0.f, gk = 0.f;
            for (int i = 0; i < 128; ++i) { gq = fmaxf(gq, fabsf(args.in[5][i])); gk = fmaxf(gk, fabsf(args.in[6][i])); }
            const float bqk2 = 2.f * 11.313708499f * gq * gk * 1.03f;
            __syncthreads();
            const int NITEM = 32 * 32;
            const float* BS = (const float*)(ws + WS_BS); const float* LS = (const float*)(ws + WS_LS); const float* PQK = (const float*)(ws + WS_PQK);
#if defined(PROBE_ATT)
            for (int L2 = F.vcu; L2 < 2 * NITEM; L2 += G) { const int L = L2 % NITEM; const Ref cur = fox_ref(L, PJ, MIX, BS, LS, PQK, bqk2); fa::fox_block<hb, hb>(cur, (char*)lds, wave0); }
#else
            for (int L = F.vcu; L < NITEM; L += G) { const Ref cur = fox_ref(L, PJ, MIX, BS, LS, PQK, bqk2); fa::fox_block<hb, hb>(cur, (char*)lds, wave0); }
#endif
        }
    }
#endif
    xcd_barrier(bar);

#if PHM & 8
    REFRESH_TID();
    { KArgs& args = *karg_ptr(); unsigned char* ws = args.ws;
      pg8::Gemm g{(const pg8::bf16_t*)(ws + WS_ACTA), (const pg8::bf16_t*)(ws + WS_WOUT), M, DM, DM, (const pg8::bf16_t*)args.out, (const pg8::bf16_t*)(ws + WS_IDB)}; pg8::StaticOrder S; S.init(M, DM, G, cb);
      pg8::EpiOut E{(pg8::bf16_t*)(ws + WS_H1B), (float*)(ws + WS_P1)};
      pg8::gemm_phase<pg8::EpiOut, pg8::StaticOrder, true, true, false, 4>(F.lds + RING_OFF, g, S, E, wave0); }
    { unsigned char* ws = karg_ptr()->ws;
      pg8::Gemm g{(const pg8::bf16_t*)(ws + WS_PB), (const pg8::bf16_t*)(ws + WS_WPLE), M, DM, PLE, nullptr, nullptr}; pg8::StaticOrder S; S.init(M, DM, G, cb);
      pg8::EpiE E{(pg8::bf16_t*)(ws + WS_ERAW), (float*)(ws + WS_PE), karg_ptr()->in[16]};
      pg8::gemm_phase<pg8::EpiE, pg8::StaticOrder, true, true>(F.lds + RING_OFF, g, S, E, wave0); }
#endif
    xcd_barrier(bar);

#if PHM & 16
    REFRESH_TID();
    { unsigned char* ws = karg_ptr()->ws;
      pg8::Gemm g{(const pg8::bf16_t*)(ws + WS_H1B), (const pg8::bf16_t*)(ws + WS_WUP), M, DFF, DM, nullptr, nullptr}; pg8::StaticOrder S; S.init(M, DFF, G, cb);
      pg8::Unit u0; if (S.next(0, u0)) row_table(F, (const float*)(ws + WS_P1), u0.pm * 256, (LAS float*)(F.lds + TAB_RS)); else __syncthreads();
      pg8::EpiUp E{(pg8::bf16_t*)(ws + WS_HID), (const LAS float*)(F.lds + TAB_RS)};
      pg8::gemm_phase<pg8::EpiUp, pg8::StaticOrder, true, true>(F.lds + RING_OFF, g, S, E, wave0); }
    int pmg; { pg8::StaticOrder S; S.init(M, DM, G, cb); pg8::Unit u0; pmg = S.next(0, u0) ? u0.pm : 0; }
    if (G == 256) group_sync(bar, (unsigned*)(F.ctl + CW_GRP + 64 * pmg), 4u); else xcd_barrier(bar);
    REFRESH_TID();
    { KArgs& args = *karg_ptr(); unsigned char* ws = args.ws;
      pg8::Gemm g{(const pg8::bf16_t*)(ws + WS_HID), (const pg8::bf16_t*)(ws + WS_WDOWN), M, DM, DFF, nullptr, nullptr}; pg8::StaticOrder S; S.init(M, DM, G, cb);
      pg8::EpiDown E{(const pg8::bf16_t*)(ws + WS_H1B), (pg8::bf16_t*)(ws + WS_H1B), (unsigned char*)(ws + WS_H2F8), (float*)(ws + WS_P2), 0};
      pg8::gemm_phase<pg8::EpiDown, pg8::StaticOrder, true, true>(F.lds + RING_OFF, g, S, E, wave0); }
    if (G == 256) group_sync(bar, (unsigned*)(F.ctl + CW_GRP + 64 * (64 + pmg)), 4u); else xcd_barrier(bar);
#endif
#if PHM & 32
    REFRESH_TID();
    { KArgs& args = *karg_ptr(); unsigned char* ws = args.ws;
      pg8::Gemm g{(const pg8::bf16_t*)(ws + WS_H2F8), (const pg8::bf16_t*)(ws + WS_WGATE), M, DM, DM / 2, nullptr, nullptr}; pg8::StaticOrder S; S.init(M, DM, G, cb);
      pg8::Unit u0; if (S.next(0, u0)) { row_table(F, (const float*)(ws + WS_P2), u0.pm * 256, (LAS float*)(F.lds + TAB_RS)); row_table(F, (const float*)(ws + WS_PE), u0.pm * 256, (LAS float*)(F.lds + TAB_RSE)); }
      pg8::EpiGate E{args.out, (const pg8::bf16_t*)(ws + WS_H1B), (const pg8::bf16_t*)(ws + WS_ERAW), 1.f / GATE_WSCALE, (const LAS float*)(F.lds + TAB_RS), (const LAS float*)(F.lds + TAB_RSE)};
      pg8::gemm_phase<pg8::EpiGate, pg8::StaticOrder, true, true, true>(F.lds + RING_OFF, g, S, E, wave0); }
#endif
    if (__hip_atomic_load((gu32*)((unsigned*)(F.ctl + CW_BAR) + XB_TMO), RLX_AGENT) != 0u) { asm volatile("s_waitcnt vmcnt(0)" ::: "memory"); __syncthreads();
        float* o = karg_ptr()->out; const float qn = __builtin_nanf(""); const int t_ = wave0 * 64 + lane_now(); for (int i = t_; i < DM; i += NWAVES * 64) o[(size_t)blockIdx.x * 64 * DM + i] = qn; }
}

extern "C" void kernel_launch(void* const* d_in, const int* in_sizes, int n_in, void* d_out, int out_size, void* d_ws, size_t ws_size, hipStream_t stream) {
    static int grid = 0;
    if (grid == 0) {
        if (n_in != 17 || in_sizes[0] != M * DM || out_size != M * DM || ws_size < WS_END) { fprintf(stderr, "kernel_launch: shape / workspace mismatch (n_in %d, ws %zu, need %zu); nothing launched\n", n_in, ws_size, (size_t)WS_END); grid = -1; return; }
        int dev = 0, cus = 0, per_cu = 0;
        if (hipGetDevice(&dev) != hipSuccess || hipDeviceGetAttribute(&cus, hipDeviceAttributeMultiprocessorCount, dev) != hipSuccess) { grid = -1; return; }
        if (hipFuncSetAttribute((const void*)fwd_kernel, hipFuncAttributeMaxDynamicSharedMemorySize, LDS_BYTES) != hipSuccess) { fprintf(stderr, "kernel_launch: hipFuncSetAttribute failed\n"); grid = -1; return; }
        if (hipOccupancyMaxActiveBlocksPerMultiprocessor(&per_cu, (const void*)fwd_kernel, NWAVES * 64, LDS_BYTES) != hipSuccess || per_cu < 1) fprintf(stderr, "kernel_launch: note: occupancy query reports %d workgroups per CU\n", per_cu);
        (void)hipGetLastError();
        grid = cus;
    }
    if (grid < 0) return;
    if (hipMemsetAsync((char*)d_ws + WS_CTL, 0, CTL_ZERO_BYTES, stream) != hipSuccess) return;
    Args a{};
    for (int i = 0; i < 17; ++i) a.in[i] = (const float*)d_in[i];
    a.out = (float*)d_out; a.ws = (unsigned char*)d_ws;
    hipLaunchKernelGGL(fwd_kernel, dim3(grid), dim3(NWAVES * 64), LDS_BYTES, stream, a);
}
```

```cpp
#include <hip/hip_runtime.h>
#include <hip/hip_bf16.h>
#include <cstdio>
#include <cstdint>
namespace pg8 {
#define PG8_LAS __attribute__((address_space(3)))
typedef unsigned short bf16_t;
typedef short bf16x8 __attribute__((ext_vector_type(8)));
typedef float f32x4 __attribute__((ext_vector_type(4)));
typedef unsigned u32x4 __attribute__((ext_vector_type(4)));
constexpr int BM = 256, BK = 64, HALF = 128, HTB = HALF * BK * 2  , STAGE_BYTES = 8 * HTB, NXCD = 8, WGM = 8;

__host__ __device__ __forceinline__ int lds_byte(int r, int c) { const int st = (r >> 4) * 2 + (c >> 5), rr = r & 15, cc = c & 31, ob = rr * 64 + cc * 2; return st * 1024 + (ob ^ (((ob >> 9) & 1) << 5)); }
__host__ __device__ __forceinline__ void stage_rc(int b, int& R, int& C) { const int st = b / 1024, sb = b % 1024, swz = sb ^ (((sb >> 9) & 1) << 5); R = (st >> 1) * 16 + swz / 64; C = (st & 1) * 32 + (swz % 64) / 2; }
__host__ __device__ __forceinline__ int perm32(int rho) { const int n = rho >> 4, i = rho & 15; return 8 * (i >> 2) + 4 * n + (i & 3); }

struct Unit { int pm, pn; };
struct Gemm { const bf16_t* A; const bf16_t* Bt; int M, N, K; const bf16_t* A2; const bf16_t* B2; };

struct StaticOrder {
    int nM, nN, nwg, G, c;
    __host__ __device__ void init(int M, int N, int G_, int c_) { nM = M / BM; nN = N / BM; nwg = nM * nN; G = G_; c = c_; }
    __host__ __device__ bool next(int i, Unit& u) const {
        const long L = (long)i * G + c; if (L >= nwg) return false;
        int wgid = (int)L; { const int q = nwg / NXCD, r = nwg % NXCD, xcd = wgid % NXCD, off = wgid / NXCD; wgid = (xcd < r ? xcd * (q + 1) : r * (q + 1) + (xcd - r) * q) + off; }
        const int nig = WGM * nN, gid = wgid / nig, fm = gid * WGM, gsz = (nM - fm) < WGM ? (nM - fm) : WGM;
        u.pm = fm + ((wgid % nig) % gsz); u.pn = (wgid % nig) / gsz; return true;
    }
    __device__ __forceinline__ void a_ready(const Unit&) const {}
    __device__ __forceinline__ void done(const Unit&) const {}
};
typedef float f32x2c_t __attribute__((ext_vector_type(2))); typedef __bf16 bf16x2c_t __attribute__((ext_vector_type(2)));
__device__ __forceinline__ unsigned cvt_pk_bf16(float lo, float hi) { f32x2c_t v = {lo, hi}; bf16x2c_t b = __builtin_convertvector(v, bf16x2c_t); return __builtin_bit_cast(unsigned, b); }
typedef float f32x2 __attribute__((ext_vector_type(2)));
__device__ __forceinline__ u32x4 pack8v(const f32x4 v0, const f32x4 v1) { u32x4 w; w.x = cvt_pk_bf16(v0[0], v0[1]); w.y = cvt_pk_bf16(v0[2], v0[3]); w.z = cvt_pk_bf16(v1[0], v1[1]); w.w = cvt_pk_bf16(v1[2], v1[3]); return w; }
__device__ __forceinline__ float dot8(const f32x4 a, const f32x4 b) { return ((a[0] * a[0] + a[1] * a[1]) + (a[2] * a[2] + a[3] * a[3])) + ((b[0] * b[0] + b[1] * b[1]) + (b[2] * b[2] + b[3] * b[3])); }
__device__ __forceinline__ float red_fq(float s) { s += __shfl_xor(s, 16); s += __shfl_xor(s, 32); return s; }

struct EpiProj {
    static constexpr bool PERM = true, AFTER_DRAIN = false;
    bf16_t* proj; float* pqk; const PG8_LAS float* rs;
    __device__ __forceinline__ void operator()(const f32x4 (&acc)[2][2][4][2], const Unit& u, int wr, int wc, int fr, int fq) const {
        const int C = u.pn * BM, which = C >> 11, hp = (C & 2047) >> 8, dcol = wc * 32 + 8 * fq;
#pragma unroll
        for (int ai = 0; ai < 2; ++ai)
#pragma unroll
            for (int m = 0; m < 4; ++m) { const int lr = ai * HALF + wr * 64 + m * 16 + fr, row = u.pm * BM + lr, b = row >> 13, t = row & 8191; const float r = rs[lr];
#pragma unroll
                for (int bj = 0; bj < 2; ++bj) { const int head = 2 * hp + bj;
                    const f32x4 v0 = acc[ai][bj][m][0] * r, v1 = acc[ai][bj][m][1] * r;
                    *(u32x4*)(proj + ((size_t)((which * 2 + b) * 16 + head) * 8192 + t) * 128 + dcol) = pack8v(v0, v1);
                    if (which < 2) { const float ss = red_fq(dot8(v0, v1)); if (fq == 0) pqk[((size_t)(which * 16384 + row) * 16 + head) * 4 + wc] = ss; } } }
    }
};
struct EpiOut {
    static constexpr bool PERM = true, AFTER_DRAIN = false;
    bf16_t* hb; float* part;
    __device__ __forceinline__ void operator()(const f32x4 (&acc)[2][2][4][2], const Unit& u, int wr, int wc, int fr, int fq) const {
        const int col0 = u.pn * BM + wc * 32 + 8 * fq, row0 = u.pm * BM + wr * 64 + fr;
#pragma unroll
        for (int g = 0; g < 8; ++g) { const int ai = g >> 2, m = g & 3, row = row0 + ai * HALF + m * 16; float ss = 0.f;
#pragma unroll
            for (int bj = 0; bj < 2; ++bj) { const size_t off = (size_t)row * 4096 + col0 + bj * HALF;
                const f32x4 v0 = acc[ai][bj][m][0], v1 = acc[ai][bj][m][1];
                *(u32x4*)(hb + off) = pack8v(v0, v1); ss += dot8(v0, v1); }
            ss = red_fq(ss); if (fq == 0) part[(size_t)row * 64 + u.pn * 4 + wc] = ss; }
    }
};
struct EpiE {
    static constexpr bool PERM = true, AFTER_DRAIN = false;
    bf16_t* eb; float* part; const float* gpost;
    __device__ __forceinline__ void operator()(const f32x4 (&acc)[2][2][4][2], const Unit& u, int wr, int wc, int fr, int fq) const {
        int fr_ = fr, fq_ = fq; asm volatile("" : "+v"(fr_), "+v"(fq_));
        const int col0 = u.pn * BM + wc * 32 + 8 * fq_;
        f32x4 gp[2][2];
#pragma unroll
        for (int bj = 0; bj < 2; ++bj) { gp[bj][0] = *(const f32x4*)(gpost + col0 + bj * HALF); gp[bj][1] = *(const f32x4*)(gpost + col0 + bj * HALF + 4); }
#pragma unroll
        for (int ai = 0; ai < 2; ++ai)
#pragma unroll
            for (int m = 0; m < 4; ++m) { const int row = u.pm * BM + ai * HALF + wr * 64 + m * 16 + fr_; float ss = 0.f;
#pragma unroll
                for (int bj = 0; bj < 2; ++bj) { const size_t off = (size_t)row * 4096 + col0 + bj * HALF;
                    const f32x4 v0 = acc[ai][bj][m][0], v1 = acc[ai][bj][m][1];
                    *(u32x4*)(eb + off) = pack8v(v0 * gp[bj][0], v1 * gp[bj][1]); ss += dot8(v0, v1); }
                ss = red_fq(ss); if (fq_ == 0) part[(size_t)row * 64 + u.pn * 4 + wc] = ss; }
    }
};
struct EpiUp {
    static constexpr bool PERM = true, AFTER_DRAIN = false;
    bf16_t* hid; const PG8_LAS float* rs;
    __device__ __forceinline__ void operator()(const f32x4 (&acc)[2][2][4][2], const Unit& u, int wr, int wc, int fr, int fq) const {
        const int col0 = u.pn * BM + wc * 32 + 8 * fq;
#pragma unroll
        for (int ai = 0; ai < 2; ++ai)
#pragma unroll
            for (int m = 0; m < 4; ++m) { const int lr = ai * HALF + wr * 64 + m * 16 + fr, row = u.pm * BM + lr; const float r = rs[lr];
#pragma unroll
                for (int bj = 0; bj < 2; ++bj) { f32x4 v0 = acc[ai][bj][m][0] * r, v1 = acc[ai][bj][m][1] * r;
#pragma unroll
                    for (int i = 0; i < 4; ++i) { const float a = fmaxf(v0[i], 0.f), b = fmaxf(v1[i], 0.f); v0[i] = a * a; v1[i] = b * b; }
                    *(u32x4*)(hid + (size_t)row * 16384 + col0 + bj * HALF) = pack8v(v0, v1); } }
    }
};
struct EpiDown {
    static constexpr bool PERM = true, AFTER_DRAIN = false;
    const bf16_t* h1b; bf16_t* hb; unsigned char* h8; float* part; int row_off;
    __device__ __forceinline__ void operator()(const f32x4 (&acc)[2][2][4][2], const Unit& u, int wr, int wc, int fr, int fq) const {
        const int col0 = u.pn * BM + wc * 32 + 8 * fq, row0 = row_off + u.pm * BM + wr * 64 + fr;
        u32x4 nx[2];
#pragma unroll
        for (int bj = 0; bj < 2; ++bj) nx[bj] = *(const u32x4*)(h1b + (size_t)row0 * 4096 + col0 + bj * HALF);
#pragma unroll
        for (int g = 0; g < 8; ++g) { const int ai = g >> 2, m = g & 3, row = row0 + ai * HALF + m * 16; float ss = 0.f;
            u32x4 cx[2];
#pragma unroll
            for (int bj = 0; bj < 2; ++bj) cx[bj] = nx[bj];
            if (g < 7) { const int rown = row0 + ((g + 1) >> 2) * HALF + ((g + 1) & 3) * 16;
#pragma unroll
                for (int bj = 0; bj < 2; ++bj) nx[bj] = *(const u32x4*)(h1b + (size_t)rown * 4096 + col0 + bj * HALF); }
#pragma unroll
            for (int bj = 0; bj < 2; ++bj) { const size_t off = (size_t)row * 4096 + col0 + bj * HALF; const u32x4 w = cx[bj];
                f32x4 v0 = acc[ai][bj][m][0], v1 = acc[ai][bj][m][1];
                v0[0] += __uint_as_float(w.x << 16); v0[1] += __uint_as_float(w.x & 0xffff0000u); v0[2] += __uint_as_float(w.y << 16); v0[3] += __uint_as_float(w.y & 0xffff0000u);
                v1[0] += __uint_as_float(w.z << 16); v1[1] += __uint_as_float(w.z & 0xffff0000u); v1[2] += __uint_as_float(w.w << 16); v1[3] += __uint_as_float(w.w & 0xffff0000u);
                *(u32x4*)(hb + off) = pack8v(v0, v1); ss += dot8(v0, v1);
                { typedef unsigned u32x2_ __attribute__((ext_vector_type(2))); u32x2_ q;
                  int p0 = __builtin_amdgcn_cvt_pk_fp8_f32(v0[0], v0[1], 0, false); p0 = __builtin_amdgcn_cvt_pk_fp8_f32(v0[2], v0[3], p0, true);
                  int p1 = __builtin_amdgcn_cvt_pk_fp8_f32(v1[0], v1[1], 0, false); p1 = __builtin_amdgcn_cvt_pk_fp8_f32(v1[2], v1[3], p1, true);
                  q.x = (unsigned)p0; q.y = (unsigned)p1; *(u32x2_*)(h8 + off) = q; } }
            ss = red_fq(ss); if (fq == 0) part[(size_t)row * 64 + u.pn * 4 + wc] = ss;
            asm volatile("" ::: "memory"); }
    }
};
struct EpiGate {
    static constexpr bool PERM = true, AFTER_DRAIN = false;
    float* out; const bf16_t* h2b; const bf16_t* eb; float wscale_inv; const PG8_LAS float* rs2; const PG8_LAS float* rse;
    __device__ __forceinline__ void operator()(const f32x4 (&acc)[2][2][4][2], const Unit& u, int wr, int wc, int fr, int fq) const {
        int fr_ = fr, fq_ = fq; asm volatile("" : "+v"(fr_), "+v"(fq_));
        const int col0 = u.pn * BM + wc * 32 + 8 * fq_, lr0 = wr * 64 + fr_, row0 = u.pm * BM + lr0;
        u32x4 nx[2], ne[2];
#pragma unroll
        for (int bj = 0; bj < 2; ++bj) { const size_t off = (size_t)row0 * 4096 + col0 + bj * HALF; nx[bj] = *(const u32x4*)(h2b + off); ne[bj] = *(const u32x4*)(eb + off); }
#pragma unroll
        for (int g = 0; g < 8; ++g) { const int ai = g >> 2, m = g & 3, lr = lr0 + ai * HALF + m * 16, row = row0 + ai * HALF + m * 16;
            const float r2 = rs2[lr] * wscale_inv * -1.4426950408889634f, re = rse[lr];
            u32x4 cx[2], ce[2];
#pragma unroll
            for (int bj = 0; bj < 2; ++bj) { cx[bj] = nx[bj]; ce[bj] = ne[bj]; }
            if (g < 7) { const int rown = row0 + ((g + 1) >> 2) * HALF + ((g + 1) & 3) * 16;
#pragma unroll
                for (int bj = 0; bj < 2; ++bj) { const size_t off = (size_t)rown * 4096 + col0 + bj * HALF; nx[bj] = *(const u32x4*)(h2b + off); ne[bj] = *(const u32x4*)(eb + off); } }
#pragma unroll
            for (int bj = 0; bj < 2; ++bj) { const size_t off = (size_t)row * 4096 + col0 + bj * HALF;
                const u32x4 ew = ce[bj], hw = cx[bj];
                f32x4 e0, e1, v0, v1;
                e0[0] = __uint_as_float(ew.x << 16); e0[1] = __uint_as_float(ew.x & 0xffff0000u); e0[2] = __uint_as_float(ew.y << 16); e0[3] = __uint_as_float(ew.y & 0xffff0000u);
                e1[0] = __uint_as_float(ew.z << 16); e1[1] = __uint_as_float(ew.z & 0xffff0000u); e1[2] = __uint_as_float(ew.w << 16); e1[3] = __uint_as_float(ew.w & 0xffff0000u);
                v0[0] = __uint_as_float(hw.x << 16); v0[1] = __uint_as_float(hw.x & 0xffff0000u); v0[2] = __uint_as_float(hw.y << 16); v0[3] = __uint_as_float(hw.y & 0xffff0000u);
                v1[0] = __uint_as_float(hw.z << 16); v1[1] = __uint_as_float(hw.z & 0xffff0000u); v1[2] = __uint_as_float(hw.w << 16); v1[3] = __uint_as_float(hw.w & 0xffff0000u);
#pragma unroll
                for (int i = 0; i < 4; ++i) { const float g0 = __builtin_amdgcn_rcpf(1.f + __builtin_amdgcn_exp2f(acc[ai][bj][m][0][i] * r2)), g1 = __builtin_amdgcn_rcpf(1.f + __builtin_amdgcn_exp2f(acc[ai][bj][m][1][i] * r2));
                    v0[i] += g0 * (e0[i] * re); v1[i] += g1 * (e1[i] * re); }
                *(f32x4*)(out + off) = v0; *(f32x4*)(out + off + 4) = v1; }
            asm volatile("" ::: "memory"); }
    }
};
template <class Epi, class Sched, bool ALIGN_EPI = false, bool SP2 = false, bool FP8 = false, int EXT = 0>
__device__ __forceinline__ void gemm_phase(PG8_LAS unsigned char* lds, const Gemm g, const Sched& S, const Epi& E, const int wave_s  ) {
    int lane_; asm volatile("v_mbcnt_lo_u32_b32 %0, -1, 0\n\tv_mbcnt_hi_u32_b32 %0, -1, %0" : "=v"(lane_)); const int tid_ = wave_s * 64 + lane_;
    const int tid = tid_, wid = wave_s, lane = lane_, wr = wid >> 2, wc = wid & 3, fr = lane & 15, fq = lane >> 4;
    const int K = g.K, nt = K / BK;
    unsigned voffA[2], voffB[2];
#pragma unroll
    for (int i = 0; i < 2; ++i) { int R, C; stage_rc(tid * 16 + i * 8192, R, C); const int Rb = Epi::PERM ? ((R & ~31) + perm32(R & 31)) : R;
        voffA[i] = (unsigned)(R * K + C) * 2u; voffB[i] = (unsigned)(Rb * K + C) * 2u; }
    const size_t kstep = (size_t)(BK * 2);
    const size_t hstep = (size_t)HALF * K * 2;
    const size_t tstep = 2 * hstep;
    const unsigned ldsw = (unsigned)wid * 1024u;
    const int aoff = lds_byte(wr * 64 + fr, fq * 8), boff = lds_byte(wc * 32 + fr, fq * 8);
    const int aoff8 = lds_byte(wr * 64 + fr, fq * 16), boff8 = lds_byte(wc * 32 + fr, fq * 16);
#define PG8_SA(b, h) (((b) * 2 + (h)) * HTB)
#define PG8_SB(b, h) ((4 + (b) * 2 + (h)) * HTB)
#define PG8_STAGE(bufoff, gbase, voff) do { const char* gb_ = (const char*)(gbase); asm volatile("" : "+s"(gb_)); _Pragma("unroll") for (int _i = 0; _i < 2; ++_i) { asm volatile("" : "+v"((voff)[_i])); \
        __builtin_amdgcn_global_load_lds((const unsigned*)(gb_ + (voff)[_i]), (PG8_LAS unsigned*)(lds + (bufoff) + ldsw + _i * 8192), 16, 0, 0); } } while (0)
#define PG8_LDA(dst, b, h) do { _Pragma("unroll") for (int m = 0; m < 4; ++m) _Pragma("unroll") for (int k = 0; k < 2; ++k) dst[m][k] = *(const PG8_LAS bf16x8*)(lds + PG8_SA(b, h) + (FP8 ? aoff8 + m * 2048 + k * 16 : aoff + m * 2048 + k * 1024)); } while (0)
#define PG8_LDB(dst, b, h) do { _Pragma("unroll") for (int n = 0; n < 2; ++n) _Pragma("unroll") for (int k = 0; k < 2; ++k) dst[n][k] = *(const PG8_LAS bf16x8*)(lds + PG8_SB(b, h) + (FP8 ? boff8 + n * 2048 + k * 16 : boff + n * 2048 + k * 1024)); } while (0)
#define PG8_MMA(ai, bj, At, Bt) do { __builtin_amdgcn_s_setprio(1); if constexpr (FP8) { typedef int v8i_ __attribute__((ext_vector_type(8))); \
        _Pragma("unroll") for (int m = 0; m < 4; ++m) _Pragma("unroll") for (int n = 0; n < 2; ++n) \
            { const v8i_ b8_ = __builtin_bit_cast(v8i_, __builtin_shufflevector(Bt[n][0], Bt[n][1], 0, 1, 2, 3, 4, 5, 6, 7, 8, 9, 10, 11, 12, 13, 14, 15)), a8_ = __builtin_bit_cast(v8i_, __builtin_shufflevector(At[m][0], At[m][1], 0, 1, 2, 3, 4, 5, 6, 7, 8, 9, 10, 11, 12, 13, 14, 15)); \
              asm volatile("v_mfma_f32_16x16x128_f8f6f4 %0, %1, %2, %0" : "+v"(acc[ai][bj][m][n]) : "v"(b8_), "v"(a8_)); }     \
            } else { \
        _Pragma("unroll") for (int m = 0; m < 4; ++m) _Pragma("unroll") for (int n = 0; n < 2; ++n) _Pragma("unroll") for (int k = 0; k < 2; ++k) \
        acc[ai][bj][m][n] = __builtin_amdgcn_mfma_f32_16x16x32_bf16(Bt[n][k], At[m][k], acc[ai][bj][m][n], 0, 0, 0); } __builtin_amdgcn_s_setprio(0); } while (0)
#define PG8_WAIT_V(n) asm volatile("s_waitcnt vmcnt(" #n ")" ::: "memory")
#define PG8_WAIT_L(n) asm volatile("s_waitcnt lgkmcnt(" #n ")" ::: "memory")
#define PG8_BAR __builtin_amdgcn_s_barrier()
#define PG8_SCHED __builtin_amdgcn_sched_barrier(0)
    Unit cur, nxt; int ui = 0;
    if (!S.next(0, cur)) return;
    f32x4 acc[2][2][4][2];
#pragma unroll
    for (int a = 0; a < 2; ++a)
#pragma unroll
        for (int b = 0; b < 2; ++b)
#pragma unroll
            for (int m = 0; m < 4; ++m)
#pragma unroll
                for (int n = 0; n < 2; ++n) acc[a][b][m][n] = (f32x4){0.f, 0.f, 0.f, 0.f};
    bf16x8 At[4][2], B0[2][2], B1[2][2];
    const char* cA = (const char*)g.A + (size_t)cur.pm * tstep; const char* cB = (const char*)g.Bt + (size_t)cur.pn * tstep;
    S.a_ready(cur);
    if constexpr (SP2) {
        PG8_STAGE(PG8_SB(0, 0), cB, voffB); PG8_STAGE(PG8_SB(0, 1), cB + hstep, voffB); PG8_STAGE(PG8_SA(0, 0), cA, voffA); PG8_STAGE(PG8_SA(0, 1), cA + hstep, voffA);
        if (wr == 1) PG8_BAR;
        PG8_WAIT_V(2); PG8_BAR;
        PG8_STAGE(PG8_SB(1, 0), cB + kstep, voffB); PG8_STAGE(PG8_SA(1, 0), cA + kstep, voffA); PG8_STAGE(PG8_SB(1, 1), cB + hstep + kstep, voffB);
        PG8_WAIT_V(6); PG8_BAR;
    } else {
        PG8_STAGE(PG8_SB(0, 0), cB, voffB); PG8_STAGE(PG8_SA(0, 0), cA, voffA); PG8_STAGE(PG8_SB(0, 1), cB + hstep, voffB); PG8_STAGE(PG8_SA(0, 1), cA + hstep, voffA);
        if (wr == 1) PG8_BAR;
        PG8_WAIT_V(4); PG8_BAR;
        PG8_STAGE(PG8_SB(1, 0), cB + kstep, voffB); PG8_STAGE(PG8_SA(1, 0), cA + kstep, voffA); PG8_STAGE(PG8_SB(1, 1), cB + hstep + kstep, voffB);
        PG8_WAIT_V(6); PG8_BAR;
    }
    for (;;) {
        const bool has_next = S.next(ui + 1, nxt);
        const char* nA = has_next ? (const char*)g.A + (size_t)nxt.pm * tstep : cA; const char* nB = has_next ? (const char*)g.Bt + (size_t)nxt.pn * tstep : cB;
        static_assert(EXT % 2 == 0, "EXT");
        const char* xA = EXT ? (const char*)g.A2 + (size_t)cur.pm * tstep + (size_t)cur.pn * (BM * 2) : cA; const char* xB = EXT ? (const char*)g.B2 : cB;
        const int NT = nt + EXT;
        for (int t = 0; t < NT; t += 2) {
            const bool last = (t == NT - 2);
            const char* a1 = (!EXT || t < nt) ? cA + (size_t)(t + 1) * kstep : xA + (size_t)(t + 1 - nt) * kstep;
            const char* a2; const char* b2;
            if (last) { a2 = nA; b2 = nB; } else if (!EXT || t + 2 < nt) { a2 = cA + (size_t)(t + 2) * kstep; b2 = cB + (size_t)(t + 2) * kstep; } else { a2 = xA + (size_t)(t + 2 - nt) * kstep; b2 = xB + (size_t)(t + 2 - nt) * kstep; }
            const char* a3 = a2 + kstep; const char* b3 = b2 + kstep;
            if (last && has_next) S.a_ready(nxt);
            if constexpr (SP2) {
            PG8_LDB(B0, 0, 0); PG8_LDB(B1, 0, 1); PG8_SCHED; PG8_LDA(At, 0, 0); PG8_STAGE(PG8_SA(1, 1), a1 + hstep, voffA);
            PG8_WAIT_V(8); PG8_WAIT_L(0); PG8_BAR; PG8_MMA(0, 0, At, B0); PG8_MMA(0, 1, At, B1); PG8_BAR; PG8_SCHED;
            PG8_LDA(At, 0, 1); PG8_STAGE(PG8_SB(0, 0), b2, voffB); PG8_STAGE(PG8_SB(0, 1), b2 + hstep, voffB); PG8_STAGE(PG8_SA(0, 0), a2, voffA);
            PG8_WAIT_V(8); PG8_WAIT_L(0); PG8_BAR; PG8_MMA(1, 0, At, B0); PG8_MMA(1, 1, At, B1); PG8_BAR; PG8_SCHED;
            PG8_LDB(B0, 1, 0); PG8_LDB(B1, 1, 1); PG8_SCHED; PG8_LDA(At, 1, 0); PG8_STAGE(PG8_SA(0, 1), a2 + hstep, voffA);
            PG8_WAIT_V(8); PG8_WAIT_L(0); PG8_BAR; PG8_MMA(0, 0, At, B0); PG8_MMA(0, 1, At, B1); PG8_BAR; PG8_SCHED;
            PG8_LDA(At, 1, 1); PG8_STAGE(PG8_SB(1, 0), b3, voffB); PG8_STAGE(PG8_SB(1, 1), b3 + hstep, voffB); PG8_STAGE(PG8_SA(1, 0), a3, voffA);
            PG8_WAIT_V(8); PG8_WAIT_L(0); PG8_BAR; PG8_MMA(1, 0, At, B0); PG8_MMA(1, 1, At, B1); PG8_BAR; PG8_SCHED;
            } else {
            PG8_LDB(B0, 0, 0); PG8_SCHED; PG8_LDA(At, 0, 0); PG8_STAGE(PG8_SA(1, 1), a1 + hstep, voffA);
            PG8_WAIT_L(8); PG8_BAR; PG8_WAIT_L(0); PG8_MMA(0, 0, At, B0); PG8_BAR; PG8_SCHED;
            PG8_LDB(B1, 0, 1); PG8_STAGE(PG8_SB(0, 0), b2, voffB);
            PG8_BAR; PG8_WAIT_L(0); PG8_MMA(0, 1, At, B1); PG8_BAR;
            PG8_LDA(At, 0, 1); PG8_STAGE(PG8_SA(0, 0), a2, voffA);
            PG8_BAR; PG8_WAIT_L(0); PG8_MMA(1, 0, At, B0); PG8_BAR; PG8_SCHED;
            PG8_STAGE(PG8_SB(0, 1), b2 + hstep, voffB);
            PG8_WAIT_V(6); PG8_BAR; PG8_MMA(1, 1, At, B1); PG8_BAR;
            PG8_LDB(B0, 1, 0); PG8_SCHED; PG8_LDA(At, 1, 0); PG8_STAGE(PG8_SA(0, 1), a2 + hstep, voffA);
            PG8_WAIT_L(8); PG8_BAR; PG8_WAIT_L(0); PG8_MMA(0, 0, At, B0); PG8_BAR; PG8_SCHED;
            PG8_LDB(B1, 1, 1); PG8_STAGE(PG8_SB(1, 0), b3, voffB);
            PG8_BAR; PG8_WAIT_L(0); PG8_MMA(0, 1, At, B1); PG8_BAR;
            PG8_LDA(At, 1, 1); PG8_STAGE(PG8_SA(1, 0), a3, voffA);
            PG8_BAR; PG8_WAIT_L(0); PG8_MMA(1, 0, At, B0); PG8_BAR; PG8_SCHED;
            PG8_STAGE(PG8_SB(1, 1), b3 + hstep, voffB);
            PG8_WAIT_V(6); PG8_BAR; PG8_MMA(1, 1, At, B1); PG8_BAR;
            }
        }
        if constexpr (FP8) asm volatile("s_nop 7\n\ts_nop 7\n\ts_nop 7" ::: "memory");
        if constexpr (ALIGN_EPI) { if (wr == 0) PG8_BAR; }
        if constexpr (!Epi::AFTER_DRAIN) { { int l2_; asm volatile("v_mbcnt_lo_u32_b32 %0, -1, 0\n\tv_mbcnt_hi_u32_b32 %0, -1, %0" : "=v"(l2_)); E(acc, cur, wr, wc, l2_ & 15, l2_ >> 4); }     S.done(cur); }
        if (!has_next) break;
#pragma unroll
        for (int a = 0; a < 2; ++a)
#pragma unroll
            for (int b = 0; b < 2; ++b)
#pragma unroll
                for (int m = 0; m < 4; ++m)
#pragma unroll
                    for (int n = 0; n < 2; ++n) acc[a][b][m][n] = (f32x4){0.f, 0.f, 0.f, 0.f};
        cur = nxt; cA = nA; cB = nB; ++ui;
        if constexpr (ALIGN_EPI) { if (wr == 1) PG8_BAR; }
    }
    PG8_WAIT_V(0);
    if constexpr (!ALIGN_EPI) { if (wr == 0) PG8_BAR; }
    PG8_BAR;
    if constexpr (Epi::AFTER_DRAIN) { E.fused(acc, cur, wr, wc, fr, fq, lds, wid, lane); S.done(cur); }
#undef PG8_SA
#undef PG8_SB
#undef PG8_STAGE
#undef PG8_LDA
#undef PG8_LDB
#undef PG8_MMA
#undef PG8_WAIT_V
#undef PG8_WAIT_L
#undef PG8_BAR
#undef PG8_SCHED
}
}
namespace fa {
constexpr int D = 128;
constexpr float SCALE = 0.08838834764831845f;
constexpr float LOG2E = 1.4426950408889634f;
constexpr float THR2 = 8.f * LOG2E;
constexpr bool WSKIP = false;
constexpr int OPITCH = 4096;
constexpr int NW = 8, QBLK = 32, KVBLK = 64, QB = NW * QBLK;
constexpr int SHM_V = KVBLK * D * 2, SHM_K = KVBLK * D * 2;
constexpr int LDS_BYTES = 2 * SHM_V + 2 * SHM_K + NW * 64 * 4;
constexpr int TAB_MAX = 8192 + QB;
constexpr int FL_OFF = LDS_BYTES, RK_OFF = FL_OFF + TAB_MAX * 4, GG_OFF = RK_OFF + TAB_MAX * 4, SCR_OFF = GG_OFF + 512, FA_LDS_END = SCR_OFF + 64;
constexpr int WBIG = 1 << 30;

using bf16 = __hip_bfloat16;
typedef short bf16x8 __attribute__((ext_vector_type(8)));
typedef short s16x4 __attribute__((ext_vector_type(4)));
typedef float f32x16 __attribute__((ext_vector_type(16)));
typedef float f32x4 __attribute__((ext_vector_type(4)));
typedef unsigned u32x4 __attribute__((ext_vector_type(4)));
template <class A, class Bt> struct same_t { static constexpr bool v = false; };
template <class A> struct same_t<A, A> { static constexpr bool v = true; };

#define KSWZ(row, colB) ((row) * 256 + ((colB) ^ (((row) & 7) << 4)))
#define SBAR() __builtin_amdgcn_sched_barrier(0)
__device__ __forceinline__ int v_st(int k, int c) { const int kk = (k & ~0xC) | ((k & 4) << 1) | ((k & 8) >> 1); return ((kk >> 3) * 4 + (c >> 5)) * 512 + ((kk & 7) * 32 + (c & 31)) * 2; }
__device__ __forceinline__ int v_rd_base(int lane) { return ((lane & 3) << 3) | (((lane >> 2) & 3) << 6) | (((lane >> 4) & 1) << 5) | (((lane >> 5) & 1) << 8); }
constexpr int v_rd_off(int d0, int ks, int half) { return d0 * 512 + ks * 4096 + half * 2048; }
__device__ __forceinline__ int crow(int r, int hi) { return (r & 3) + 8 * (r >> 2) + 4 * hi; }
__device__ __forceinline__ unsigned cvtpk(float lo, float hi) {
    unsigned r; asm volatile("v_cvt_pk_bf16_f32 %0, %1, %2" : "=v"(r) : "v"(lo), "v"(hi)); return r;
}
__device__ __forceinline__ bf16x8 pack8(f32x4 a, f32x4 b) {
    u32x4 w = {cvtpk(a[0], a[1]), cvtpk(a[2], a[3]), cvtpk(b[0], b[1]), cvtpk(b[2], b[3])};
    return *reinterpret_cast<bf16x8*>(&w);
}
template <class T> __device__ __forceinline__ bf16x8 load8(const T* p) {
    if constexpr (same_t<T, float>::v) { return pack8(*(const f32x4*)p, *(const f32x4*)(p + 4)); }
    else { return *reinterpret_cast<const bf16x8*>(p); }
}
__device__ __forceinline__ void mask_tile(f32x16& p0, f32x16& p1, int dq, unsigned W) {
    const float NEG = -__builtin_inff();
#pragma unroll
    for (int r = 0; r < 16; ++r) {
        const int c = (r & 3) + 8 * (r >> 2);
        if ((unsigned)(dq - c) >= W) p0[r] = NEG;
        if ((unsigned)(dq - c - 32) >= W) p1[r] = NEG;
    }
}
__device__ __forceinline__ void partialSM(f32x16& p0, f32x16& p1, const float* FlL, const float* RKL, float& m_reg, float& mn, float& alpha) {
#pragma unroll
    for (int g = 0; g < 4; ++g) { const f32x4 f0 = *(const f32x4*)(FlL + 8 * g), k0 = *(const f32x4*)(RKL + 8 * g), f1 = *(const f32x4*)(FlL + 32 + 8 * g), k1 = *(const f32x4*)(RKL + 32 + 8 * g);
#pragma unroll
        for (int i = 0; i < 4; ++i) { p0[4 * g + i] = fmaf(p0[4 * g + i], k0[i], f0[i]); p1[4 * g + i] = fmaf(p1[4 * g + i], k1[i], f1[i]); } }
    float pmax = p0[0]; for (int r = 1; r < 16; ++r) pmax = fmaxf(pmax, p0[r]); for (int r = 0; r < 16; ++r) pmax = fmaxf(pmax, p1[r]);
    { auto rr = __builtin_amdgcn_permlane32_swap(__float_as_uint(pmax), __float_as_uint(pmax), false, false);
      pmax = fmaxf(__uint_as_float(rr[0]), __uint_as_float(rr[1])); }
    if (__builtin_expect(__all((pmax - m_reg) <= THR2), 1)) { mn = m_reg; alpha = 1.f; }
    else { mn = fmaxf(m_reg, pmax); alpha = __builtin_amdgcn_exp2f(m_reg - mn); m_reg = mn; }
    for (int r = 0; r < 16; ++r) p0[r] = p0[r] - mn; for (int r = 0; r < 16; ++r) p1[r] = p1[r] - mn;
    for (int r = 0; r < 16; ++r) p0[r] = __builtin_amdgcn_exp2f(p0[r]);
}
__device__ __forceinline__ void finishSM(f32x16& p0, f32x16& p1, float alpha, float& l_reg, bf16x8& pa0, bf16x8& pa1, bf16x8& pa2, bf16x8& pa3) {
    for (int r = 0; r < 16; ++r) p1[r] = __builtin_amdgcn_exp2f(p1[r]);
    float ps = 0; for (int r = 0; r < 16; ++r) ps += p0[r]; for (int r = 0; r < 16; ++r) ps += p1[r];
    { auto rr = __builtin_amdgcn_permlane32_swap(__float_as_uint(ps), __float_as_uint(ps), false, false);
      ps = __uint_as_float(rr[0]) + __uint_as_float(rr[1]); }
    l_reg = l_reg * alpha + ps;
#define PK4(P, B_, OUT) do { unsigned a0 = cvtpk(P[B_+0], P[B_+1]), a1 = cvtpk(P[B_+2], P[B_+3]);                          \
        unsigned b0 = cvtpk(P[B_+4], P[B_+5]), b1 = cvtpk(P[B_+6], P[B_+7]);                                             \
        auto r0 = __builtin_amdgcn_permlane32_swap(a0, b0, false, false); auto r1 = __builtin_amdgcn_permlane32_swap(a1, b1, false, false); \
        u32x4 w = {r0[0], r1[0], r0[1], r1[1]}; OUT = *reinterpret_cast<bf16x8*>(&w); } while (0)
    PK4(p0, 0, pa0); PK4(p0, 8, pa1); PK4(p1, 0, pa2); PK4(p1, 8, pa3);
#undef PK4
}
template <int KB, bool SK>
__device__ __forceinline__ void qkt(f32x16& p0, f32x16& p1, const char* K_lds, int r32, int hi, const bf16x8* qr, bool act) {
    if (SK && !act) { const float NEG = -__builtin_inff();
#pragma unroll
        for (int r = 0; r < 16; ++r) { p0[r] = NEG; p1[r] = NEG; } return; }
    p0 = f32x16{}; p1 = f32x16{};
    const char* kb[4];
#pragma unroll
    for (int dd = 0; dd < 4; ++dd) kb[dd] = K_lds + KB * SHM_K + KSWZ(r32, (dd * 16 + hi * 8) * 2);
#pragma unroll
    for (int d0 = 0; d0 < 8; ++d0) { const char* a = kb[d0 & 3] + (d0 >> 2) * 128;
        bf16x8 b0 = *reinterpret_cast<const bf16x8*>(a);
        bf16x8 b1 = *reinterpret_cast<const bf16x8*>(a + 32 * 256);
        p0 = __builtin_amdgcn_mfma_f32_32x32x16_bf16(b0, qr[d0], p0, 0, 0, 0);
        p1 = __builtin_amdgcn_mfma_f32_32x32x16_bf16(b1, qr[d0], p1, 0, 0, 0); }
}
template <int VB, bool SK>
__device__ __forceinline__ void pv_tile(f32x16* o, int vb0, bf16x8 pa0, bf16x8 pa1, bf16x8 pa2, bf16x8 pa3, bool act) {
    if (SK && !act) return;
#define TRRD(dst, off) asm volatile("ds_read_b64_tr_b16 %0, %1 offset:%2" : "=&v"(dst) : "v"(vb0), "i"(off) : "memory")
#define PV_D0(d0) do { s16x4 l0, l1, l2, l3, h0, h1, h2, h3; constexpr int b_ = VB * SHM_V + v_rd_off(d0, 0, 0);     \
        TRRD(l0, b_); TRRD(h0, b_ + 2048); TRRD(l1, b_ + 4096); TRRD(h1, b_ + 6144); TRRD(l2, b_ + 8192); TRRD(h2, b_ + 10240); TRRD(l3, b_ + 12288); TRRD(h3, b_ + 14336); \
        asm volatile("s_waitcnt lgkmcnt(0)" ::: "memory"); SBAR();                 \
        o[d0] = __builtin_amdgcn_mfma_f32_32x32x16_bf16(pa0, (bf16x8){l0[0], l0[1], l0[2], l0[3], h0[0], h0[1], h0[2], h0[3]}, o[d0], 0, 0, 0);   \
        o[d0] = __builtin_amdgcn_mfma_f32_32x32x16_bf16(pa1, (bf16x8){l1[0], l1[1], l1[2], l1[3], h1[0], h1[1], h1[2], h1[3]}, o[d0], 0, 0, 0);   \
        o[d0] = __builtin_amdgcn_mfma_f32_32x32x16_bf16(pa2, (bf16x8){l2[0], l2[1], l2[2], l2[3], h2[0], h2[1], h2[2], h2[3]}, o[d0], 0, 0, 0);   \
        o[d0] = __builtin_amdgcn_mfma_f32_32x32x16_bf16(pa3, (bf16x8){l3[0], l3[1], l3[2], l3[3], h3[0], h3[1], h3[2], h3[3]}, o[d0], 0, 0, 0); } while (0)
    PV_D0(0); PV_D0(1); PV_D0(2); PV_D0(3);
#undef PV_D0
#undef TRRD
}

template <class TIn, class TOut> struct BlockRef { const TIn* Q; const TIn* K; const TIn* V; TOut* O; int P0; int jlo; const float* LS; const float* PK; const float* PQ; float thr2; };

template <class TIn, class TOut>
__device__ __forceinline__ void fox_block(const BlockRef<TIn, TOut>& cur, char* lds, const int wave_s) {
    int lane_; asm volatile("v_mbcnt_lo_u32_b32 %0, -1, 0\n\tv_mbcnt_hi_u32_b32 %0, -1, %0" : "=v"(lane_));
    const int tid = wave_s * 64 + lane_, wid = wave_s, lane = lane_, r32 = lane & 31, hi = lane >> 5;
    const int j_lo = cur.jlo, NT = (cur.P0 + QB) / KVBLK - j_lo;
    const int qlo = cur.P0 + wid * QBLK, qm = qlo + r32 - 4 * hi;
    char* V_lds = lds; char* K_lds = lds + 2 * SHM_V;
    float* ws = (float*)(lds + 2 * SHM_V + 2 * SHM_K) + wid * 64; float* li_l = ws, * al_l = ws + 32;
    const int sr = tid >> 4, sc = (tid & 15) * 8, vst0 = v_st(sr, sc), vst1 = v_st(32 + sr, sc), kws = KSWZ(sr, sc * 2);
    const int vb0 = (int)(uintptr_t)V_lds + v_rd_base(lane);
    float* Flt = (float*)(lds + FL_OFF); float* RKt = (float*)(lds + RK_OFF); const float* GGt = (const float*)(lds + GG_OFF); float* wsum = (float*)(lds + SCR_OFF);
    bf16x8 st_v0, st_v1, st_k0, st_k1;
#define FB_LOAD(j) do { const size_t o_ = (size_t)((j) * KVBLK + sr) * D + sc; st_v0 = load8<TIn>(cur.V + o_); st_v1 = load8<TIn>(cur.V + o_ + 32 * D); st_k0 = load8<TIn>(cur.K + o_); st_k1 = load8<TIn>(cur.K + o_ + 32 * D); } while (0)
#define FB_WRITE(bf) do { *(bf16x8*)(K_lds + (bf) * SHM_K + kws) = st_k0; *(bf16x8*)(K_lds + (bf) * SHM_K + kws + 32 * 256) = st_k1; *(bf16x8*)(V_lds + (bf) * SHM_V + vst0) = st_v0; *(bf16x8*)(V_lds + (bf) * SHM_V + vst1) = st_v1; } while (0)
    FB_LOAD(j_lo);
    bf16x8 qr[8];
#pragma unroll
    for (int d0 = 0; d0 < 8; ++d0) qr[d0] = load8<TIn>(cur.Q + (size_t)(wid * QBLK + r32) * D + d0 * 16 + hi * 8);
    { const int s0 = j_lo * KVBLK, len = cur.P0 + QB - s0;
      float carry = 0.f;
      const f32x4 pq = *(const f32x4*)(cur.PQ + (size_t)(cur.P0 + wid * QBLK + r32) * 64);
      for (int base = 0; base < len; base += NW * 64) { const int i = base + tid;
          float x = (i < len) ? cur.LS[s0 + i] : 0.f;
          f32x4 pk = {1.f, 1.f, 1.f, 1.f}; if (i < len) pk = *(const f32x4*)(cur.PK + (size_t)(s0 + i) * 64);
#pragma unroll
          for (int o = 1; o < 64; o <<= 1) { const float y = __shfl_up(x, o); if (lane >= o) x += y; }
          if (lane == 63) wsum[wid] = x;
          __syncthreads();
          float off = carry, tot = 0.f;
#pragma unroll
          for (int w = 0; w < NW; ++w) { const float ws_ = wsum[w]; tot += ws_; if (w < wid) off += ws_; }
          if (i < len) { Flt[i] = -(x + off) * LOG2E;
              RKt[i] = (SCALE * LOG2E) / sqrtf(((pk[0] + pk[1]) + (pk[2] + pk[3])) * (1.f / 128.f) + 1e-6f); }
          carry += tot;
          __syncthreads(); }
      const float rq = 1.f / sqrtf(((pq[0] + pq[1]) + (pq[2] + pq[3])) * (1.f / 128.f) + 1e-6f);
#pragma unroll
      for (int d0 = 0; d0 < 8; ++d0) { const f32x4 g0 = *(const f32x4*)(GGt + d0 * 16 + hi * 8), g1 = *(const f32x4*)(GGt + d0 * 16 + hi * 8 + 4);
          f32x4 a, b;
#pragma unroll
          for (int j = 0; j < 4; ++j) { a[j] = __uint_as_float(((unsigned)(unsigned short)qr[d0][j]) << 16) * (rq * g0[j]); b[j] = __uint_as_float(((unsigned)(unsigned short)qr[d0][4 + j]) << 16) * (rq * g1[j]); }
          qr[d0] = pack8(a, b); }
    }
    const float* Flb = Flt + 4 * hi; const float* RKb = RKt + 4 * hi;
    asm volatile("s_waitcnt vmcnt(0)" ::: "memory"); FB_WRITE(0);
    __syncthreads();
    float m_reg = -1e30f, l_reg = 0; f32x16 o[4] = {};
    for (int t = 0; t < NT; ++t) {
        const int buf = t & 1, kb = (j_lo + t) * KVBLK;
        if (t + 1 < NT) FB_LOAD(j_lo + t + 1);
        if (kb <= qlo + QBLK - 1 && !(Flt[qlo - j_lo * KVBLK] - Flt[t * KVBLK + KVBLK - 1] > cur.thr2)) {
            f32x16 p0, p1; float mn, al; bf16x8 pa0, pa1, pa2, pa3;
            qkt<0, false>(p0, p1, K_lds + buf * SHM_K, r32, hi, qr, true);
            if (kb + KVBLK - 1 > qlo) mask_tile(p0, p1, qm - kb, (unsigned)WBIG);
            partialSM(p0, p1, Flb + t * KVBLK, RKb + t * KVBLK, m_reg, mn, al);
            if (__any(al < 1.f)) { if (hi == 0) al_l[r32] = al; asm volatile("s_waitcnt lgkmcnt(0)" ::: "memory");
                for (int d_ = 0; d_ < 4; ++d_) for (int r = 0; r < 16; ++r) o[d_][r] *= al_l[crow(r, hi)]; }
            finishSM(p0, p1, al, l_reg, pa0, pa1, pa2, pa3); SBAR();
            pv_tile<0, false>(o, vb0 + buf * SHM_V, pa0, pa1, pa2, pa3, true);
        }
        if (t + 1 < NT) { asm volatile("s_waitcnt vmcnt(0)" ::: "memory"); FB_WRITE(buf ^ 1); }
        __syncthreads();
    }
    if (hi == 0) li_l[r32] = l_reg; asm volatile("s_waitcnt lgkmcnt(0)" ::: "memory");
    float rli[16];
#pragma unroll
    for (int r = 0; r < 16; ++r) rli[r] = __builtin_amdgcn_rcpf(li_l[crow(r, hi)]);
    TOut* Ow = cur.O + (size_t)(wid * QBLK) * OPITCH;
#pragma unroll
    for (int r = 0; r < 16; ++r) { const int orow = crow(r, hi);
#pragma unroll
        for (int d0 = 0; d0 < 4; ++d0) { const float v = o[d0][r] * rli[r]; const float vn = __shfl_xor(v, 1);
            if ((r32 & 1) == 0) *(unsigned*)(Ow + (size_t)orow * OPITCH + d0 * 32 + r32) = cvtpk(v, vn); } }
    __syncthreads();
#undef FB_LOAD
#undef FB_WRITE
}
}
namespace hg {
#define HG_LAS __attribute__((address_space(3)))
typedef short bf16x8 __attribute__((ext_vector_type(8)));
typedef short s16x4 __attribute__((ext_vector_type(4)));
typedef float f32x4 __attribute__((ext_vector_type(4)));
typedef unsigned u32x4 __attribute__((ext_vector_type(4)));
constexpr int RB = 272;
constexpr int PL = 0, KT = 64 * RB, KH = 2 * 64 * RB, VL = 3 * 64 * RB, A1 = 4 * 64 * RB, A1RB = 144, SK = A1 + 64 * A1RB, SC = SK + 128 * RB, B63 = SC + 8 * 128 * 4, DK = B63 + 512, HG_END = DK + 512;
constexpr int OL = 0, ORB = 132 * 4;
static_assert(64 * ORB <= 2 * 64 * RB && HG_END + 1024 <= 131072, "hgrn LDS map");
typedef float f32x2_t __attribute__((ext_vector_type(2))); typedef __bf16 bf16x2_t __attribute__((ext_vector_type(2)));
__device__ __forceinline__ unsigned cvtpk(float lo, float hi) { f32x2_t v = {lo, hi}; bf16x2_t b = __builtin_convertvector(v, bf16x2_t); return __builtin_bit_cast(unsigned, b); }
__device__ __forceinline__ float bf_lo(unsigned w) { return __uint_as_float(w << 16); }
__device__ __forceinline__ float bf_hi(unsigned w) { return __uint_as_float(w & 0xffff0000u); }
__device__ __forceinline__ s16x4 vtr(const HG_LAS char* p) { typedef short v4i16_t __attribute__((ext_vector_type(4))); return __builtin_bit_cast(s16x4, __builtin_amdgcn_ds_read_tr16_b64_v4i16((HG_LAS v4i16_t*)p)); }
__device__ __forceinline__ bf16x8 tr2(const HG_LAS char* base, int row0, int col0, int lane) {
    const int i = lane & 15, kq = lane >> 4; const HG_LAS char* p = base + (row0 + 8 * kq + (i >> 2)) * RB + (col0 + 4 * (i & 3)) * 2;
    const s16x4 lo = vtr(p), hi = vtr(p + 4 * RB); return (bf16x8){lo[0], lo[1], lo[2], lo[3], hi[0], hi[1], hi[2], hi[3]};
}
__device__ __forceinline__ bf16x8 rd8(const HG_LAS char* base, int pitch, int row0, int col0, int lane) { return *(const HG_LAS bf16x8*)(base + (row0 + (lane & 15)) * pitch + (col0 + 8 * (lane >> 4)) * 2); }
#define HG_MFMA(a, b, c) __builtin_amdgcn_mfma_f32_16x16x32_bf16(a, b, c, 0, 0, 0)

struct SegArgs { const unsigned short* qb; const unsigned short* fb; const unsigned short* ib; const unsigned short* gb; unsigned short* out; const HG_LAS float* lb; const HG_LAS float* ghn; int c_begin, c_end; };
constexpr int WARM = 8;
constexpr int DSUM = HG_END, FLG = DSUM + 512, HG_END2 = FLG + 64;
__device__ __forceinline__ void hgrn_segment(HG_LAS char* lds, const SegArgs a, const int wave_s) {
    int lane_; asm volatile("v_mbcnt_lo_u32_b32 %0, -1, 0\n\tv_mbcnt_hi_u32_b32 %0, -1, %0" : "=v"(lane_));
    const int tid = wave_s * 64 + lane_, wid = wave_s;
    const int kc = tid & 15, tg = tid >> 4;
    constexpr float LOG2E = 1.4426950408889634f, LN2 = 0.6931471805599453f;
    float lbv[8];
#pragma unroll
    for (int e = 0; e < 8; ++e) lbv[e] = a.lb[8 * kc + e];
    const size_t eoff = (size_t)(2 * tg) * 128 + 8 * kc;
    const int tb = wid >> 1;
    int w0 = a.c_begin - WARM; if (w0 < 0) w0 = 0;
    for (;;) {
    f32x4 sT[8];
#pragma unroll
    for (int kb = 0; kb < 8; ++kb) sT[kb] = (f32x4){0.f, 0.f, 0.f, 0.f};
    for (int i = tid; i < 128 * RB / 16; i += 512) *(HG_LAS u32x4*)(lds + SK + i * 16) = (u32x4){0u, 0u, 0u, 0u};
    if (tid < 128) ((HG_LAS float*)(lds + DSUM))[tid] = 0.f;
    u32x4 zr[2], qr[2], vr[2];
#pragma unroll
    for (int r = 0; r < 2; ++r) { const size_t o_ = eoff + (size_t)w0 * 64 * 128 + r * 128; zr[r] = *(const u32x4*)(a.fb + o_); qr[r] = *(const u32x4*)(a.qb + o_); vr[r] = *(const u32x4*)(a.ib + o_); }
    __syncthreads();
    bool redo = false;
    for (int c = w0; c < a.c_end; ++c) {
        const bool warm = c < a.c_begin;
        float g0[8], tot[8], inc[8];
#pragma unroll
        for (int e = 0; e < 8; ++e) { const float omlb = 1.f - lbv[e];
            const unsigned w0_ = zr[0][e >> 1], w1_ = zr[1][e >> 1]; const float z0 = (e & 1) ? bf_hi(w0_) : bf_lo(w0_), z1 = (e & 1) ? bf_hi(w1_) : bf_lo(w1_);
            const float s0 = __builtin_amdgcn_rcpf(1.f + __builtin_amdgcn_exp2f(-z0 * LOG2E)), s1 = __builtin_amdgcn_rcpf(1.f + __builtin_amdgcn_exp2f(-z1 * LOG2E));
            g0[e] = __builtin_amdgcn_logf(lbv[e] + omlb * s0) * LN2; tot[e] = g0[e] + __builtin_amdgcn_logf(lbv[e] + omlb * s1) * LN2; inc[e] = tot[e]; }
#pragma unroll
        for (int e = 0; e < 8; ++e) { float y = __shfl_up(inc[e], 16); if (lane_ >= 16) inc[e] += y; y = __shfl_up(inc[e], 32); if (lane_ >= 32) inc[e] += y; }
        if (lane_ >= 48) {
#pragma unroll
            for (int e = 0; e < 8; ++e) ((HG_LAS float*)(lds + SC))[wid * 128 + 8 * kc + e] = inc[e]; }
        __syncthreads();
        float b63[8];
#pragma unroll
        for (int e = 0; e < 8; ++e) { float off = 0.f, all = 0.f;
#pragma unroll
            for (int w = 0; w < 8; ++w) { const float s = ((const HG_LAS float*)(lds + SC))[w * 128 + 8 * kc + e]; all += s; if (w < wid) off += s; }
            inc[e] = off + inc[e] - tot[e]; b63[e] = all * LOG2E; }
        if (tg == 0) {
#pragma unroll
            for (int e = 0; e < 8; ++e) { ((HG_LAS float*)(lds + DK))[8 * kc + e] = __builtin_amdgcn_exp2f(b63[e]); if (warm) ((HG_LAS float*)(lds + DSUM))[8 * kc + e] += b63[e]; } }
#pragma unroll
        for (int r = 0; r < 2; ++r) { float kh[8];
            const int ro = (2 * tg + r) * RB + 16 * kc;
            if (!warm) { float pv[8], kt[8];
#pragma unroll
                for (int e = 0; e < 8; ++e) {
                    const float km = 1.f - __builtin_amdgcn_exp2f((r ? tot[e] - g0[e] : g0[e]) * LOG2E);
                    const unsigned w = qr[r][e >> 1]; const float q = (e & 1) ? bf_hi(w) : bf_lo(w);
                    const float sq = q * __builtin_amdgcn_rcpf(1.f + __builtin_amdgcn_exp2f(-q * LOG2E)); const float bl = (inc[e] + (r ? tot[e] : g0[e])) * LOG2E;
                    pv[e] = sq * __builtin_amdgcn_exp2f(bl); kt[e] = km * __builtin_amdgcn_exp2f(-bl); kh[e] = km * __builtin_amdgcn_exp2f(b63[e] - bl); }
                *(HG_LAS u32x4*)(lds + PL + ro) = (u32x4){cvtpk(pv[0], pv[1]), cvtpk(pv[2], pv[3]), cvtpk(pv[4], pv[5]), cvtpk(pv[6], pv[7])};
                *(HG_LAS u32x4*)(lds + KT + ro) = (u32x4){cvtpk(kt[0], kt[1]), cvtpk(kt[2], kt[3]), cvtpk(kt[4], kt[5]), cvtpk(kt[6], kt[7])};
            } else {
#pragma unroll
                for (int e = 0; e < 8; ++e) { const float km = 1.f - __builtin_amdgcn_exp2f((r ? tot[e] - g0[e] : g0[e]) * LOG2E);
                    const float bl = (inc[e] + (r ? tot[e] : g0[e])) * LOG2E; kh[e] = km * __builtin_amdgcn_exp2f(b63[e] - bl); }
            }
            *(HG_LAS u32x4*)(lds + KH + ro) = (u32x4){cvtpk(kh[0], kh[1]), cvtpk(kh[2], kh[3]), cvtpk(kh[4], kh[5]), cvtpk(kh[6], kh[7])};
            *(HG_LAS u32x4*)(lds + VL + ro) = vr[r]; }
        if (c + 1 < a.c_end) { const size_t no = eoff + (size_t)(c + 1) * 64 * 128;
#pragma unroll
            for (int r = 0; r < 2; ++r) { zr[r] = *(const u32x4*)(a.fb + no + r * 128); qr[r] = *(const u32x4*)(a.qb + no + r * 128); vr[r] = *(const u32x4*)(a.ib + no + r * 128); } }
        __syncthreads();
        u32x4 gcur[2];
        if (!warm) {
#pragma unroll
            for (int r = 0; r < 2; ++r) gcur[r] = *(const u32x4*)(a.gb + eoff + (size_t)c * 64 * 128 + r * 128); }
        int lane = lane_; asm volatile("" : "+v"(lane));
        const int q4 = lane >> 4, n16 = lane & 15;
        if (!warm) {
        { const int sb0 = 2 * (wid & 1); f32x4 c0 = {0.f, 0.f, 0.f, 0.f}, c1 = {0.f, 0.f, 0.f, 0.f};
          if (sb0 <= tb) {
#pragma unroll
            for (int ks = 0; ks < 4; ++ks) { const bf16x8 af = rd8(lds + PL, RB, 16 * tb, 32 * ks, lane);
                c0 = HG_MFMA(af, rd8(lds + KT, RB, 16 * sb0, 32 * ks, lane), c0); c1 = HG_MFMA(af, rd8(lds + KT, RB, 16 * sb0 + 16, 32 * ks, lane), c1); } }
#pragma unroll
          for (int r = 0; r < 4; ++r) { const int t = 16 * tb + 4 * q4 + r, s0 = 16 * sb0 + n16, s1 = s0 + 16;
              const float x0 = (s0 <= t) ? c0[r] : 0.f, x1 = (s1 <= t) ? c1[r] : 0.f;
              *(HG_LAS unsigned short*)(lds + A1 + t * A1RB + s0 * 2) = (unsigned short)(cvtpk(x0, 0.f) & 0xffffu);
              *(HG_LAS unsigned short*)(lds + A1 + t * A1RB + s1 * 2) = (unsigned short)(cvtpk(x1, 0.f) & 0xffffu); } }
        __syncthreads();
        f32x4 oc[4];
#pragma unroll
        for (int j = 0; j < 4; ++j) oc[j] = (f32x4){0.f, 0.f, 0.f, 0.f};
        { const int vb0 = 4 * (wid & 1);
#pragma unroll
          for (int ks = 0; ks < 4; ++ks) { const bf16x8 af = rd8(lds + PL, RB, 16 * tb, 32 * ks, lane);
#pragma unroll
              for (int j = 0; j < 4; ++j) oc[j] = HG_MFMA(af, tr2(lds + SK, 32 * ks, 16 * (vb0 + j), lane), oc[j]); }
#pragma unroll
          for (int ks = 0; ks < 2; ++ks) { const bf16x8 af = rd8(lds + A1, A1RB, 16 * tb, 32 * ks, lane);
#pragma unroll
              for (int j = 0; j < 4; ++j) oc[j] = HG_MFMA(af, tr2(lds + VL, 32 * ks, 16 * (vb0 + j), lane), oc[j]); } }
        __syncthreads();
        { const int vb0 = 4 * (wid & 1);
#pragma unroll
          for (int j = 0; j < 4; ++j)
#pragma unroll
              for (int r = 0; r < 4; ++r) *(HG_LAS float*)(lds + OL + (16 * tb + 4 * q4 + r) * ORB + (16 * (vb0 + j) + n16) * 4) = oc[j][r]; }
        }
#pragma unroll
        for (int kb = 0; kb < 8; ++kb) { const float d = ((const HG_LAS float*)(lds + DK))[16 * kb + n16]; sT[kb] = sT[kb] * d; }
#pragma unroll
        for (int ks = 0; ks < 2; ++ks) { const bf16x8 af = tr2(lds + VL, 32 * ks, 16 * wid, lane);
#pragma unroll
            for (int kb = 0; kb < 8; ++kb) sT[kb] = HG_MFMA(af, tr2(lds + KH, 32 * ks, 16 * kb, lane), sT[kb]); }
#pragma unroll
        for (int kb = 0; kb < 8; ++kb) { typedef unsigned u32x2 __attribute__((ext_vector_type(2)));
            *(HG_LAS u32x2*)(lds + SK + (16 * kb + n16) * RB + (16 * wid + 4 * q4) * 2) = (u32x2){cvtpk(sT[kb][0], sT[kb][1]), cvtpk(sT[kb][2], sT[kb][3])}; }
        if (!warm) {
        __syncthreads();
#pragma unroll
        for (int r = 0; r < 2; ++r) { const int t = 2 * tg + r;
            const f32x4 o0 = *(const HG_LAS f32x4*)(lds + OL + t * ORB + 32 * kc), o1 = *(const HG_LAS f32x4*)(lds + OL + t * ORB + 32 * kc + 16);
            float ss = ((o0[0] * o0[0] + o0[1] * o0[1]) + (o0[2] * o0[2] + o0[3] * o0[3])) + ((o1[0] * o1[0] + o1[1] * o1[1]) + (o1[2] * o1[2] + o1[3] * o1[3]));
            ss += __shfl_xor(ss, 1); ss += __shfl_xor(ss, 2); ss += __shfl_xor(ss, 4); ss += __shfl_xor(ss, 8);
            const float rstd = 1.f / sqrtf(ss * (1.f / 128.f) + 1e-6f);
            float y[8], ghv[8]; { const f32x4 ga = *(const HG_LAS f32x4*)(a.ghn + 8 * kc), gb_ = *(const HG_LAS f32x4*)(a.ghn + 8 * kc + 4); ghv[0] = ga[0]; ghv[1] = ga[1]; ghv[2] = ga[2]; ghv[3] = ga[3]; ghv[4] = gb_[0]; ghv[5] = gb_[1]; ghv[6] = gb_[2]; ghv[7] = gb_[3]; }
#pragma unroll
            for (int e = 0; e < 8; ++e) { const unsigned w = gcur[r][e >> 1]; const float gt = (e & 1) ? bf_hi(w) : bf_lo(w);
                const float sgt = gt * __builtin_amdgcn_rcpf(1.f + __builtin_amdgcn_exp2f(-gt * LOG2E)); const float o = (e < 4) ? o0[e & 3] : o1[e & 3];
                y[e] = (o * rstd * ghv[e]) * sgt; }
            *(u32x4*)(a.out + ((size_t)c * 64 + t) * 4096 + 8 * kc) = (u32x4){cvtpk(y[0], y[1]), cvtpk(y[2], y[3]), cvtpk(y[4], y[5]), cvtpk(y[6], y[7])}; }
        } else if (c + 1 == a.c_begin && w0 > 0) {
            __syncthreads();
            bool ok = true;
#pragma unroll
            for (int e = 0; e < 8; ++e) ok = ok && (((const HG_LAS float*)(lds + DSUM))[8 * kc + e] < -104.f * LOG2E);
            const bool wok = __all(ok);
            if (lane == 0) ((HG_LAS unsigned*)(lds + FLG))[wid] = wok ? 1u : 0u;
            __syncthreads();
            unsigned allok = 1u;
#pragma unroll
            for (int w = 0; w < 8; ++w) allok &= ((const HG_LAS unsigned*)(lds + FLG))[w];
#if !defined(PROBE_NOCHECK)
            if (!allok) { redo = true; break; }
#else
            (void)allok;
#endif
        }
    }
    if (!redo) break;
    __syncthreads();
    w0 -= WARM; if (w0 < 0) w0 = 0;
    }
    __syncthreads();
}
#undef HG_MFMA
}
#define GAS __attribute__((address_space(1)))
#define LAS __attribute__((address_space(3)))
typedef unsigned short bf16;
typedef unsigned v4u __attribute__((ext_vector_type(4)));
typedef float f32x4 __attribute__((ext_vector_type(4)));
typedef short bf16x8 __attribute__((ext_vector_type(8)));
typedef GAS unsigned gu32;
typedef GAS unsigned long long gu64;
#define RLX_AGENT __ATOMIC_RELAXED, __HIP_MEMORY_SCOPE_AGENT
#define LDS_WAIT() asm volatile("s_waitcnt lgkmcnt(0)" ::: "memory")
#define VM_WAIT() asm volatile("s_waitcnt vmcnt(0)" ::: "memory")
__device__ __forceinline__ unsigned long long rt() { return __builtin_amdgcn_s_memrealtime(); }
__device__ __forceinline__ unsigned f2bf(float f) { unsigned u = __builtin_bit_cast(unsigned, f); return (u + 0x7fffu + ((u >> 16) & 1u)) >> 16; }
__device__ __forceinline__ unsigned pk2(float lo, float hi) { return f2bf(lo) | (f2bf(hi) << 16); }

#define XB_TMO      128
#define XB_XCNT(j)  (256  + 64 * (j))
#define XB_XSUB(j)  (1280 + 64 * (j))
#define XB_XGEN(j)  (2304 + 64 * (j))
#define XB_TOP      3328
#define XB_TOPGEN   3392
#define XCD_BAR_WORDS 3456
#define XB_SPIN_CAP (1u << 18)

__device__ __forceinline__ unsigned xb_ld(unsigned* p)              { return __hip_atomic_load(p, __ATOMIC_RELAXED, __HIP_MEMORY_SCOPE_AGENT); }
__device__ __forceinline__ unsigned xb_add(unsigned* p, unsigned v) { return __hip_atomic_fetch_add(p, v, __ATOMIC_RELAXED, __HIP_MEMORY_SCOPE_AGENT); }
__device__ __forceinline__ unsigned xb_xcc_id() { return (unsigned)__builtin_amdgcn_s_getreg((3 << 11) | 20) & 0xFu; }
#define XB_SPIN(cond, bar) do { unsigned _sp = 0; while (cond) { __builtin_amdgcn_s_sleep(1); \
    if ((++_sp & 255u) == 0u) { if (xb_ld(&(bar)[XB_TMO])) break; if (_sp > XB_SPIN_CAP) { atomicAdd(&(bar)[XB_TMO], 1u); break; } } } } while (0)

__device__ __forceinline__ int lane_now() { int l; asm volatile("v_mbcnt_lo_u32_b32 %0, -1, 0\n\tv_mbcnt_hi_u32_b32 %0, -1, %0" : "=v"(l)); return l; }
struct XcdBarrier {
    unsigned* bar; unsigned x; int w0;
    volatile LAS unsigned* st;
};

__device__ __forceinline__ XcdBarrier xcd_barrier_post(unsigned* bar, volatile LAS unsigned* st) {
    XcdBarrier b; b.bar = bar; b.x = xb_xcc_id(); b.st = st; b.w0 = __builtin_amdgcn_readfirstlane((int)threadIdx.x >> 6);
    if (threadIdx.x == 0) (void)xb_add(&bar[XB_XCNT(b.x)], 1u);
    return b;
}
__device__ __forceinline__ void xcd_barrier_complete(unsigned* bar, unsigned x, unsigned& nloc, unsigned& nx) {
    const unsigned G = gridDim.x * gridDim.y * gridDim.z;
    unsigned sum, cnt, mine, sp = 0u;
    for (;;) {
        sum = 0u; cnt = 0u; mine = 0u;
#pragma unroll
        for (unsigned j = 0; j < 16; ++j) { const unsigned c = xb_ld(&bar[XB_XCNT(j)]); sum += c; cnt += (c > 0u) ? 1u : 0u; mine = (j == x) ? c : mine; }
        if (sum == G) break;
        __builtin_amdgcn_s_sleep(1);
        if ((++sp & 255u) == 0u) { if (xb_ld(&bar[XB_TMO])) break; if (sp > XB_SPIN_CAP) { atomicAdd(&bar[XB_TMO], 1u); break; } }
    }
    nloc = mine > 0u ? mine : 1u; nx = cnt > 0u ? cnt : 1u;
}

__device__ __forceinline__ void xcd_barrier(const XcdBarrier& b) {
    asm volatile("s_waitcnt vmcnt(0)" ::: "memory");
    __syncthreads();
    if (b.w0 == 0 && lane_now() == 0) {
        unsigned* bar = b.bar;
        __builtin_amdgcn_s_waitcnt(0);
        unsigned nloc = b.st[0], nx = b.st[1];
        if (nloc == 0u) { xcd_barrier_complete(bar, b.x, nloc, nx); b.st[0] = nloc; b.st[1] = nx; }
        const unsigned old = xb_add(&bar[XB_XSUB(b.x)], 1u);
        const unsigned gen = old / nloc;
        if (old + 1u == (gen + 1u) * nloc) {
            __builtin_amdgcn_fence(__ATOMIC_RELEASE, "agent");
            asm volatile("s_waitcnt vmcnt(0)" ::: "memory");
            const unsigned og = xb_add(&bar[XB_TOP], 1u);
            const unsigned tg = og / nx;
            if (og + 1u == (tg + 1u) * nx) xb_add(&bar[XB_TOPGEN], 1u);
            else XB_SPIN(xb_ld(&bar[XB_TOPGEN]) == tg, bar);
            __builtin_amdgcn_fence(__ATOMIC_ACQUIRE, "agent");
            xb_add(&bar[XB_XGEN(b.x)], 1u);
            asm volatile("s_waitcnt vmcnt(0)" ::: "memory");
        } else {
            XB_SPIN(xb_ld(&bar[XB_XGEN(b.x)]) == gen, bar);
            __builtin_amdgcn_fence(__ATOMIC_ACQUIRE, "agent");
            asm volatile("s_waitcnt vmcnt(0)" ::: "memory");
        }
    }
    __syncthreads();
}
__device__ __forceinline__ void group_sync(const XcdBarrier& b, unsigned* cnt, unsigned n) {
    asm volatile("s_waitcnt vmcnt(0)" ::: "memory");
    __syncthreads();
    if (b.w0 == 0 && lane_now() == 0) {
        __builtin_amdgcn_s_waitcnt(0);
        __builtin_amdgcn_fence(__ATOMIC_RELEASE, "agent");
        asm volatile("s_waitcnt vmcnt(0)" ::: "memory");
        (void)xb_add(cnt, 1u);
        XB_SPIN(xb_ld(cnt) < n, b.bar);
        __builtin_amdgcn_fence(__ATOMIC_ACQUIRE, "agent");
        asm volatile("s_waitcnt vmcnt(0)" ::: "memory");
    }
    __syncthreads();
}
typedef unsigned short u16;
constexpr int NWAVES = 8;
constexpr int BATCH = 2, SEQ = 8192, DM = 4096, NH = 16, HD = 128, DFF = 16384, PLE = 256;
constexpr int M = BATCH * SEQ;
constexpr int NIN = 14352, NPROJ = 14336, FA_COL = 6144;
constexpr float RMS_EPS = 1e-6f;
constexpr size_t MiB = 1u << 20;
constexpr size_t WS_CTL = 0, CTL_ZERO_BYTES = 65536;
constexpr size_t WS_WFA = 1 * MiB;
constexpr size_t WS_LS = 2 * MiB;
constexpr size_t WS_BS = 3 * MiB;
constexpr size_t WS_PQK = 4 * MiB;
constexpr size_t WS_P1 = 12 * MiB, WS_P2 = 16 * MiB, WS_PE = 20 * MiB;
constexpr size_t WS_WGATE = 24 * MiB, WS_WDOWN = 40 * MiB, WS_WUP = 168 * MiB, WS_WOUT = 296 * MiB, WS_WPLE = 328 * MiB;
constexpr size_t WS_PB = 330 * MiB;
constexpr size_t WS_ACTA = 338 * MiB;
constexpr size_t WS_WIN = 466 * MiB;
constexpr size_t WS_PROJ = 578 * MiB;
constexpr size_t WS_H1B = 808 * MiB;
constexpr size_t WS_HID = 296 * MiB;
constexpr size_t WS_ERAW = 936 * MiB;
constexpr size_t WS_H2F8 = 1064 * MiB;
constexpr size_t WS_RS0 = 12 * MiB;
constexpr size_t WS_IDB = 1128 * MiB;
constexpr size_t WS_END = 1130 * MiB;
constexpr size_t PROJ_T = (size_t)2 * 16 * 8192 * 128;
constexpr int CW_TMO = 0, CW_BAR = 4096, CW_GRP = 8192;
static_assert(CW_BAR + XCD_BAR_WORDS <= CW_GRP && (CW_GRP + 2 * 64 * 64) * 4 <= (int)CTL_ZERO_BYTES, "control words");
constexpr int LDS_BYTES = 163840;
constexpr int RING_OFF = 0;
constexpr int TAB_OFF = 160768, TAB_RS = TAB_OFF, TAB_RSE = TAB_OFF + 1024;
constexpr int MISC_OFF = 162816;
static_assert(fa::FA_LDS_END <= TAB_OFF && hg::HG_END2 + 1024 <= TAB_OFF, "LDS map");

struct Frame {
    LAS unsigned char* lds; volatile LAS unsigned* MISC; gu32* ctl;
    int tid, lane, wave, vcu, G;
};
__device__ __forceinline__ float wave_sum(float v) {
#pragma unroll
    for (int o = 1; o < 64; o <<= 1) v += __shfl_xor(v, o);
    return v;
}
struct TItem { const float* W; const float* g; unsigned char* WT; int ldw, K, k0, src0, dst0; float scale; int fp8; };
__device__ __forceinline__ void p0_item_load(const TItem& t, float (&wv)[32], int lane) {
#pragma unroll
    for (int i = 0; i < 32; ++i) wv[i] = t.W[(size_t)(t.k0 + 2 * i + (lane >> 5)) * t.ldw + t.src0 + (lane & 31)];
}
__device__ __forceinline__ unsigned pk4_fp8(float a, float b, float c, float d) { int p = __builtin_amdgcn_cvt_pk_fp8_f32(a, b, 0, false); p = __builtin_amdgcn_cvt_pk_fp8_f32(c, d, p, true); return (unsigned)p; }
__device__ __forceinline__ void p0_item_finish(const TItem& t, const float (&wv)[32], LAS float* scr, int lane) {
#pragma unroll
    for (int i = 0; i < 32; ++i) { const int kk = 2 * i + (lane >> 5); float w = wv[i] * t.scale; if (t.g) w *= t.g[t.k0 + kk]; scr[kk * 33 + (lane & 31)] = w; }
    LDS_WAIT(); asm volatile("" ::: "memory");
    const int c = lane & 7;
    if (t.fp8) {
#pragma unroll
        for (int j = 0; j < 4; ++j) { const int n = (lane >> 3) + 8 * j; const LAS float* s = scr + (8 * c) * 33 + n;
            typedef unsigned u32x2_ __attribute__((ext_vector_type(2)));
            u32x2_ o; o.x = pk4_fp8(s[0 * 33], s[1 * 33], s[2 * 33], s[3 * 33]); o.y = pk4_fp8(s[4 * 33], s[5 * 33], s[6 * 33], s[7 * 33]);
            *(GAS u32x2_*)(t.WT + (size_t)(t.dst0 + n) * t.K + t.k0 + 8 * c) = o; }
    } else {
#pragma unroll
        for (int j = 0; j < 4; ++j) { const int n = (lane >> 3) + 8 * j; const LAS float* s = scr + (8 * c) * 33 + n;
            v4u o; o.x = pk2(s[0 * 33], s[1 * 33]); o.y = pk2(s[2 * 33], s[3 * 33]); o.z = pk2(s[4 * 33], s[5 * 33]); o.w = pk2(s[6 * 33], s[7 * 33]);
            *(GAS v4u*)((u16*)t.WT + (size_t)(t.dst0 + n) * t.K + t.k0 + 8 * c) = o; }
    }
    LDS_WAIT(); asm volatile("" ::: "memory");
}
constexpr float GATE_WSCALE = 64.f;
struct Args { const float* in[17]; float* out; unsigned char* ws; };
typedef const __attribute__((address_space(4))) Args KArgs;
__device__ __forceinline__ KArgs* karg_ptr() { KArgs* kp = (KArgs*)__builtin_amdgcn_kernarg_segment_ptr(); asm volatile("" : "+s"(kp)); return kp; }

__device__ __forceinline__ void p0_prologue(Frame& F) {
    KArgs& A = *karg_ptr(); unsigned char* ws = A.ws;
    LAS float* scr = (LAS float*)(F.lds + RING_OFF + F.wave * 16384);
    const int gw = F.vcu * NWAVES + F.wave, NGW = F.G * NWAVES;
    constexpr int I_IN = (DM / 64) * (NPROJ / 32), I_OUT = (DM / 64) * (DM / 32), I_UP = (DM / 64) * (DFF / 32), I_DN = (DFF / 64) * (DM / 32), I_GT = I_OUT, I_PL = (PLE / 64) * (DM / 32);
    constexpr int NITEMS = I_IN + I_OUT + I_UP + I_DN + I_GT + I_PL;
    auto decode = [&](int r) { TItem t; t.scale = 1.f; t.fp8 = 0; t.g = nullptr;
        if (r < I_IN) { const int nblk = NPROJ / 32, kb = r / nblk, n0 = 32 * (r % nblk); t.W = A.in[3]; t.ldw = NIN; t.K = DM; t.g = A.in[2]; t.WT = ws + WS_WIN; t.k0 = 64 * kb; t.src0 = n0 + (n0 >= FA_COL ? 16 : 0); t.dst0 = n0; return t; } r -= I_IN;
        if (r < I_OUT) { const int nblk = DM / 32; t.W = A.in[9]; t.ldw = DM; t.K = DM; t.WT = ws + WS_WOUT; t.k0 = 64 * (r / nblk); t.src0 = t.dst0 = 32 * (r % nblk); return t; } r -= I_OUT;
        if (r < I_UP) { const int nblk = DFF / 32; t.W = A.in[11]; t.ldw = DFF; t.K = DM; t.g = A.in[10]; t.WT = ws + WS_WUP; t.k0 = 64 * (r / nblk); t.src0 = t.dst0 = 32 * (r % nblk); return t; } r -= I_UP;
        if (r < I_DN) { const int nblk = DM / 32; t.W = A.in[12]; t.ldw = DM; t.K = DFF; t.WT = ws + WS_WDOWN; t.k0 = 64 * (r / nblk); t.src0 = t.dst0 = 32 * (r % nblk); return t; } r -= I_DN;
        if (r < I_GT) { const int nblk = DM / 32; t.W = A.in[14]; t.ldw = DM; t.K = DM; t.g = A.in[13]; t.scale = GATE_WSCALE; t.fp8 = 1; t.WT = ws + WS_WGATE; t.k0 = 64 * (r / nblk); t.src0 = t.dst0 = 32 * (r % nblk); return t; } r -= I_GT;
        { const int nblk = DM / 32; t.W = A.in[15]; t.ldw = DM; t.K = PLE; t.WT = ws + WS_WPLE; t.k0 = 64 * (r / nblk); t.src0 = t.dst0 = 32 * (r % nblk); return t; } };
    if (gw < NITEMS) {
        float wa[32], wb[32]; int it = gw; TItem ta = decode(it), tb = ta; p0_item_load(ta, wa, F.lane);
        for (;;) {
            const bool hb = it + NGW < NITEMS; if (hb) { tb = decode(it + NGW); p0_item_load(tb, wb, F.lane); }
            p0_item_finish(ta, wa, scr, F.lane); if (!hb) break;
            const bool ha = it + 2 * NGW < NITEMS; if (ha) { ta = decode(it + 2 * NGW); p0_item_load(ta, wa, F.lane); }
            p0_item_finish(tb, wb, scr, F.lane); if (!ha) break;
            it += 2 * NGW; }
    }
    { const int gt = F.vcu * 512 + F.tid, NT = F.G * 512;
      for (int i = gt; i < 16 * DM; i += NT) { const int n = i >> 12, k = i & 4095; ((u16*)(ws + WS_WFA))[i] = (u16)f2bf(A.in[3][(size_t)k * NIN + FA_COL + n] * A.in[2][k]); }
      for (int i = gt; i < 256 * 256; i += NT) ((u16*)(ws + WS_IDB))[(size_t)(i >> 8) * DM + (i & 255)] = ((i >> 8) == (i & 255)) ? (u16)0x3F80u : (u16)0u;
      const f32x4* p4 = (const f32x4*)A.in[1]; unsigned long long* pb = (unsigned long long*)(ws + WS_PB);
      for (int i = gt; i < M * PLE / 4; i += NT) { const f32x4 v = p4[i]; pb[i] = (unsigned long long)pk2(v.x, v.y) | ((unsigned long long)pk2(v.z, v.w) << 32); } }
    { float* RS0 = (float*)(ws + WS_RS0);
      auto xload = [&](f32x4 (&v)[16], int m) { const f32x4* xr = (const f32x4*)(A.in[0] + (size_t)m * DM);
#pragma unroll
          for (int j = 0; j < 8; ++j) { v[2 * j] = xr[128 * j + 2 * F.lane]; v[2 * j + 1] = xr[128 * j + 2 * F.lane + 1]; } };
      auto xrow = [&](const f32x4 (&v)[16], int m) { float s = 0.f;
          v4u* xo = (v4u*)((u16*)A.out + (size_t)m * DM);
#pragma unroll
          for (int j = 0; j < 8; ++j) { v4u xw; xw.x = pk2(v[2 * j].x, v[2 * j].y); xw.y = pk2(v[2 * j].z, v[2 * j].w); xw.z = pk2(v[2 * j + 1].x, v[2 * j + 1].y); xw.w = pk2(v[2 * j + 1].z, v[2 * j + 1].w); xo[64 * j + F.lane] = xw; }
#pragma unroll
          for (int j = 0; j < 16; ++j) s += (v[j].x * v[j].x + v[j].y * v[j].y) + (v[j].z * v[j].z + v[j].w * v[j].w);
          const float rstd = 1.f / sqrtf(wave_sum(s) * (1.f / DM) + RMS_EPS);
          if (F.lane == 0) RS0[m] = rstd; };
      if (gw < M) {
          f32x4 va[16], vb[16]; int m = gw; xload(va, m);
          for (;;) {
              const bool hb = m + NGW < M; if (hb) xload(vb, m + NGW);
              xrow(va, m); if (!hb) break;
              const bool ha = m + 2 * NGW < M; if (ha) xload(va, m + 2 * NGW);
              xrow(vb, m + NGW); if (!ha) break;
              m += 2 * NGW; } } }
}
__device__ __forceinline__ void fa_tile(Frame& F, int tile) {
    KArgs& A = *karg_ptr(); unsigned char* ws = A.ws; const u16* U = (const u16*)A.out; const u16* WF = (const u16*)(ws + WS_WFA);
    const int R0 = tile * 64, b = R0 >> 13, t0 = R0 & 8191, rb = F.wave & 3, kh = F.wave >> 2, n16 = F.lane & 15, q4 = F.lane >> 4;
    f32x4 acc = {0.f, 0.f, 0.f, 0.f};
    const u16* ap = U + (size_t)(R0 + 16 * rb + n16) * DM + kh * 2048 + 8 * q4; const u16* bp = WF + (size_t)n16 * DM + kh * 2048 + 8 * q4;
#pragma unroll 16
    for (int s = 0; s < 64; ++s) acc = __builtin_amdgcn_mfma_f32_16x16x32_bf16(*(const bf16x8*)(ap + 32 * s), *(const bf16x8*)(bp + 32 * s), acc, 0, 0, 0);
    LAS float* red = (LAS float*)(F.lds + RING_OFF);
    LAS float* bsum = (LAS float*)(F.lds + RING_OFF + 4096);
    if (kh == 1) *(LAS f32x4*)(red + (rb * 64 + F.lane) * 4) = acc;
    __syncthreads();
    if (kh == 0) { const f32x4 o = *(const LAS f32x4*)(red + (rb * 64 + F.lane) * 4); const float bias = A.in[4][n16]; float ts = 0.f;
        const f32x4 rs = *(const f32x4*)((const float*)(ws + WS_RS0) + R0 + 16 * rb + 4 * q4);
        float* LS = (float*)(ws + WS_LS) + (size_t)(b * 16 + n16) * 8192 + t0 + 16 * rb + 4 * q4;
        f32x4 l;
#pragma unroll
        for (int r = 0; r < 4; ++r) { const float v = (acc[r] + o[r]) * rs[r] + bias; l[r] = fminf(v, 0.f) - __builtin_amdgcn_logf(1.f + __builtin_amdgcn_exp2f(-fabsf(v) * 1.4426950408889634f)) * 0.6931471805599453f; ts += l[r]; }
        *(f32x4*)LS = l;
        ts += __shfl_xor(ts, 16); ts += __shfl_xor(ts, 32);
        if (q4 == 0) bsum[rb * 16 + n16] = ts; }
    __syncthreads();
    if (F.tid < 16) { const float s = (bsum[F.tid] + bsum[16 + F.tid]) + (bsum[32 + F.tid] + bsum[48 + F.tid]); ((float*)(ws + WS_BS))[(b * 16 + F.tid) * 128 + (t0 >> 6)] = s; }
    __syncthreads();
}
__device__ __forceinline__ void row_table(Frame& F, const float* part, int row0, LAS float* tab) {
    if (F.tid < 256) { const f32x4* p = (const f32x4*)(part + (size_t)(row0 + F.tid) * 64); float s = 0.f;
#pragma unroll
        for (int j = 0; j < 16; ++j) { const f32x4 v = p[j]; s += (v.x + v.y) + (v.z + v.w); }
        tab[F.tid] = 1.f / sqrtf(s * (1.f / DM) + RMS_EPS); }
    __syncthreads();
}

typedef __hip_bfloat16 hbf; typedef fa::BlockRef<hbf, hbf> FoxRef;
__device__ __forceinline__ FoxRef fox_ref(int L, const u16* PJ, u16* MIX, const float* BS, const float* LS, const float* PQK, float bqk2) {
    const int bh = L >> 5, qb = L & 31, b = bh >> 4, h = bh & 15; FoxRef r;
    r.Q = (const hbf*)(PJ + 0 * PROJ_T + ((size_t)bh * 8192 + qb * 256) * 128); r.K = (const hbf*)(PJ + 1 * PROJ_T + (size_t)bh * 8192 * 128); r.V = (const hbf*)(PJ + 2 * PROJ_T + (size_t)bh * 8192 * 128);
    r.O = (hbf*)(MIX + ((size_t)b * 8192 + qb * 256) * 4096 + 128 * h); r.P0 = qb * 256;
    int jlo = qb * 4; float sacc = 0.f; while (jlo > 0 && bqk2 + sacc >= -110.f) { --jlo; sacc += BS[bh * 128 + jlo]; }
    r.jlo = jlo; r.thr2 = (110.f + bqk2) * 1.4426950408889634f; r.LS = LS + (size_t)bh * 8192; r.PK = PQK + ((size_t)(16384 + b * 8192) * 16 + h) * 4; r.PQ = PQK + ((size_t)(b * 8192) * 16 + h) * 4; return r;
}

__global__ void __launch_bounds__(NWAVES * 64, 2) fwd_kernel(Args args) {
    extern __shared__ __attribute__((aligned(16))) unsigned char lds[];
    Frame F;
    F.lds = (LAS unsigned char*)lds;
    F.MISC = (volatile LAS unsigned*)(F.lds + MISC_OFF);
#define REFRESH_TID() do { const int l_ = lane_now(); F.tid = wave0 * 64 + l_; F.lane = l_; F.wave = wave0; } while (0)
    const int wave0 = __builtin_amdgcn_readfirstlane((int)threadIdx.x >> 6);
    REFRESH_TID();
    F.G = gridDim.x; { const int bx = blockIdx.x; F.vcu = (F.G % 8 == 0) ? (bx % 8) * (F.G / 8) + bx / 8 : bx; }
    F.ctl = (gu32*)(karg_ptr()->ws + WS_CTL);
    for (int u = F.tid; u < (LDS_BYTES - MISC_OFF) / 4; u += NWAVES * 64) ((LAS unsigned*)(F.lds + MISC_OFF))[u] = 0u;
    __syncthreads();
    XcdBarrier bar = xcd_barrier_post((unsigned*)(F.ctl + CW_BAR), F.MISC + 8);
    const int G = F.G, cb = (int)blockIdx.x;

#ifndef PHM
#define PHM 0xff
#endif
#if PHM & 1
    REFRESH_TID(); p0_prologue(F);
#endif
    xcd_barrier(bar);

#if PHM & 2
    REFRESH_TID();
    for (int tile = F.vcu; tile < M / 64; tile += G) fa_tile(F, tile);
    { unsigned char* ws = karg_ptr()->ws;
      pg8::Gemm g{(const pg8::bf16_t*)karg_ptr()->out, (const pg8::bf16_t*)(ws + WS_WIN), M, NPROJ, DM, nullptr, nullptr}; pg8::StaticOrder S; S.init(M, NPROJ, G, cb);
      { pg8::Unit u0; if (S.next(0, u0) && F.tid < 256) ((LAS float*)(F.lds + TAB_RS))[F.tid] = ((const float*)(ws + WS_RS0))[u0.pm * 256 + F.tid]; __syncthreads(); }
      pg8::EpiProj E{(pg8::bf16_t*)(ws + WS_PROJ), (float*)(ws + WS_PQK), (const LAS float*)(F.lds + TAB_RS)};
      pg8::gemm_phase<pg8::EpiProj, pg8::StaticOrder, true, true>(F.lds + RING_OFF, g, S, E, wave0); }
#endif
    xcd_barrier(bar);

#if PHM & 4
    REFRESH_TID();
    {
        KArgs& args = *karg_ptr(); unsigned char* ws = args.ws;
        const u16* PJ = (const u16*)(ws + WS_PROJ); u16* MIX = (u16*)(ws + WS_ACTA);
        constexpr int HSEG = 16, NSEG = (SEQ / 64) / HSEG, NHITEM = 32 * NSEG;
#if defined(PROBE_HG)
        for (int it2 = F.vcu; it2 < 2 * NHITEM; it2 += G) { const int it = it2 % NHITEM;
#else
        for (int it = F.vcu; it < NHITEM; it += G) {
#endif
            LAS float* lbt = (LAS float*)(F.lds + hg::HG_END2);
            const int bh = it / NSEG, seg = it % NSEG, b = bh >> 4, h = bh & 15;
            if (F.tid < 128) { const float l0 = args.in[7][h * 128 + F.tid], l1 = args.in[7][2048 + h * 128 + F.tid]; const float mx = fmaxf(l0, l1), e0 = __expf(l0 - mx), e1 = __expf(l1 - mx); lbt[F.tid] = e0 / (e0 + e1); lbt[128 + F.tid] = args.in[8][F.tid]; }
            __syncthreads();
            hg::SegArgs a{PJ + 3 * PROJ_T + (size_t)bh * 8192 * 128, PJ + 4 * PROJ_T + (size_t)bh * 8192 * 128, PJ + 5 * PROJ_T + (size_t)bh * 8192 * 128, PJ + 6 * PROJ_T + (size_t)bh * 8192 * 128,
                          MIX + (size_t)b * 8192 * 4096 + 2048 + 128 * h, (const HG_LAS float*)lbt, (const HG_LAS float*)(lbt + 128), seg * HSEG, seg * HSEG + HSEG};
            hg::hgrn_segment((HG_LAS char*)F.lds, a, wave0);
        }
        {
            typedef hbf hb; typedef FoxRef Ref;
            LAS float* GGt = (LAS float*)(F.lds + fa::GG_OFF);
            if (F.tid < 128) GGt[F.tid] = args.in[5][F.tid] * args.in[6][F.tid];
            float gq = 0.f, gk = 0.f;
            for (int i = 0; i < 128; ++i) { gq = fmaxf(gq, fabsf(args.in[5][i])); gk = fmaxf(gk, fabsf(args.in[6][i])); }
            const float bqk2 = 2.f * 11.313708499f * gq * gk * 1.03f;
            __syncthreads();
            const int NITEM = 32 * 32;
            const float* BS = (const float*)(ws + WS_BS); const float* LS = (const float*)(ws + WS_LS); const float* PQK = (const float*)(ws + WS_PQK);
#if defined(PROBE_ATT)
            for (int L2 = F.vcu; L2 < 2 * NITEM; L2 += G) { const int L = L2 % NITEM; const Ref cur = fox_ref(L, PJ, MIX, BS, LS, PQK, bqk2); fa::fox_block<hb, hb>(cur, (char*)lds, wave0); }
#else
            for (int L = F.vcu; L < NITEM; L += G) { const Ref cur = fox_ref(L, PJ, MIX, BS, LS, PQK, bqk2); fa::fox_block<hb, hb>(cur, (char*)lds, wave0); }
#endif
        }
    }
#endif
    xcd_barrier(bar);

#if PHM & 8
    REFRESH_TID();
    { KArgs& args = *karg_ptr(); unsigned char* ws = args.ws;
      pg8::Gemm g{(const pg8::bf16_t*)(ws + WS_ACTA), (const pg8::bf16_t*)(ws + WS_WOUT), M, DM, DM, (const pg8::bf16_t*)args.out, (const pg8::bf16_t*)(ws + WS_IDB)}; pg8::StaticOrder S; S.init(M, DM, G, cb);
      pg8::EpiOut E{(pg8::bf16_t*)(ws + WS_H1B), (float*)(ws + WS_P1)};
      pg8::gemm_phase<pg8::EpiOut, pg8::StaticOrder, true, true, false, 4>(F.lds + RING_OFF, g, S, E, wave0); }
    { unsigned char* ws = karg_ptr()->ws;
      pg8::Gemm g{(const pg8::bf16_t*)(ws + WS_PB), (const pg8::bf16_t*)(ws + WS_WPLE), M, DM, PLE, nullptr, nullptr}; pg8::StaticOrder S; S.init(M, DM, G, cb);
      pg8::EpiE E{(pg8::bf16_t*)(ws + WS_ERAW), (float*)(ws + WS_PE), karg_ptr()->in[16]};
      pg8::gemm_phase<pg8::EpiE, pg8::StaticOrder, true, true>(F.lds + RING_OFF, g, S, E, wave0); }
#endif
    xcd_barrier(bar);

#if PHM & 16
    REFRESH_TID();
    { unsigned char* ws = karg_ptr()->ws;
      pg8::Gemm g{(const pg8::bf16_t*)(ws + WS_H1B), (const pg8::bf16_t*)(ws + WS_WUP), M, DFF, DM, nullptr, nullptr}; pg8::StaticOrder S; S.init(M, DFF, G, cb);
      pg8::Unit u0; if (S.next(0, u0)) row_table(F, (const float*)(ws + WS_P1), u0.pm * 256, (LAS float*)(F.lds + TAB_RS)); else __syncthreads();
      pg8::EpiUp E{(pg8::bf16_t*)(ws + WS_HID), (const LAS float*)(F.lds + TAB_RS)};
      pg8::gemm_phase<pg8::EpiUp, pg8::StaticOrder, true, true>(F.lds + RING_OFF, g, S, E, wave0); }
    int pmg; { pg8::StaticOrder S; S.init(M, DM, G, cb); pg8::Unit u0; pmg = S.next(0, u0) ? u0.pm : 0; }
    if (G == 256) group_sync(bar, (unsigned*)(F.ctl + CW_GRP + 64 * pmg), 4u); else xcd_barrier(bar);
    REFRESH_TID();
    { KArgs& args = *karg_ptr(); unsigned char* ws = args.ws;
      pg8::Gemm g{(const pg8::bf16_t*)(ws + WS_HID), (const pg8::bf16_t*)(ws + WS_WDOWN), M, DM, DFF, nullptr, nullptr}; pg8::StaticOrder S; S.init(M, DM, G, cb);
      pg8::EpiDown E{(const pg8::bf16_t*)(ws + WS_H1B), (pg8::bf16_t*)(ws + WS_H1B), (unsigned char*)(ws + WS_H2F8), (float*)(ws + WS_P2), 0};
      pg8::gemm_phase<pg8::EpiDown, pg8::StaticOrder, true, true>(F.lds + RING_OFF, g, S, E, wave0); }
    if (G == 256) group_sync(bar, (unsigned*)(F.ctl + CW_GRP + 64 * (64 + pmg)), 4u); else xcd_barrier(bar);
#endif
#if PHM & 32
    REFRESH_TID();
    { KArgs& args = *karg_ptr(); unsigned char* ws = args.ws;
      pg8::Gemm g{(const pg8::bf16_t*)(ws + WS_H2F8), (const pg8::bf16_t*)(ws + WS_WGATE), M, DM, DM / 2, nullptr, nullptr}; pg8::StaticOrder S; S.init(M, DM, G, cb);
      pg8::Unit u0; if (S.next(0, u0)) { row_table(F, (const float*)(ws + WS_P2), u0.pm * 256, (LAS float*)(F.lds + TAB_RS)); row_table(F, (const float*)(ws + WS_PE), u0.pm * 256, (LAS float*)(F.lds + TAB_RSE)); }
      pg8::EpiGate E{args.out, (const pg8::bf16_t*)(ws + WS_H1B), (const pg8::bf16_t*)(ws + WS_ERAW), 1.f / GATE_WSCALE, (const LAS float*)(F.lds + TAB_RS), (const LAS float*)(F.lds + TAB_RSE)};
      pg8::gemm_phase<pg8::EpiGate, pg8::StaticOrder, true, true, true>(F.lds + RING_OFF, g, S, E, wave0); }
#endif
    if (__hip_atomic_load((gu32*)((unsigned*)(F.ctl + CW_BAR) + XB_TMO), RLX_AGENT) != 0u) { asm volatile("s_waitcnt vmcnt(0)" ::: "memory"); __syncthreads();
        float* o = karg_ptr()->out; const float qn = __builtin_nanf(""); const int t_ = wave0 * 64 + lane_now(); for (int i = t_; i < DM; i += NWAVES * 64) o[(size_t)blockIdx.x * 64 * DM + i] = qn; }
}

extern "C" void kernel_launch(void* const* d_in, const int* in_sizes, int n_in, void* d_out, int out_size, void* d_ws, size_t ws_size, hipStream_t stream) {
    static int grid = 0;
    if (grid == 0) {
        if (n_in != 17 || in_sizes[0] != M * DM || out_size != M * DM || ws_size < WS_END) { fprintf(stderr, "kernel_launch: shape / workspace mismatch (n_in %d, ws %zu, need %zu); nothing launched\n", n_in, ws_size, (size_t)WS_END); grid = -1; return; }
        int dev = 0, cus = 0, per_cu = 0;
        if (hipGetDevice(&dev) != hipSuccess || hipDeviceGetAttribute(&cus, hipDeviceAttributeMultiprocessorCount, dev) != hipSuccess) { grid = -1; return; }
        if (hipFuncSetAttribute((const void*)fwd_kernel, hipFuncAttributeMaxDynamicSharedMemorySize, LDS_BYTES) != hipSuccess) { fprintf(stderr, "kernel_launch: hipFuncSetAttribute failed\n"); grid = -1; return; }
        if (hipOccupancyMaxActiveBlocksPerMultiprocessor(&per_cu, (const void*)fwd_kernel, NWAVES * 64, LDS_BYTES) != hipSuccess || per_cu < 1) fprintf(stderr, "kernel_launch: note: occupancy query reports %d workgroups per CU\n", per_cu);
        (void)hipGetLastError();
        grid = cus;
    }
    if (grid < 0) return;
    if (hipMemsetAsync((char*)d_ws + WS_CTL, 0, CTL_ZERO_BYTES, stream) != hipSuccess) return;
    Args a{};
    for (int i = 0; i < 17; ++i) a.in[i] = (const float*)d_in[i];
    a.out = (float*)d_out; a.ws = (unsigned char*)d_ws;
    hipLaunchKernelGGL(fwd_kernel, dim3(grid), dim3(NWAVES * 64), LDS_BYTES, stream, a);
}
```

```cpp
#include <hip/hip_runtime.h>
#include <hip/hip_bf16.h>
#include <cstdio>
#include <cstdint>
namespace pg8 {
#define PG8_LAS __attribute__((address_space(3)))
typedef unsigned short bf16_t;
typedef short bf16x8 __attribute__((ext_vector_type(8)));
typedef float f32x4 __attribute__((ext_vector_type(4)));
typedef unsigned u32x4 __attribute__((ext_vector_type(4)));
constexpr int BM = 256, BK = 64, HALF = 128, HTB = HALF * BK * 2  , STAGE_BYTES = 8 * HTB, NXCD = 8, WGM = 8;

__host__ __device__ __forceinline__ int lds_byte(int r, int c) { const int st = (r >> 4) * 2 + (c >> 5), rr = r & 15, cc = c & 31, ob = rr * 64 + cc * 2; return st * 1024 + (ob ^ (((ob >> 9) & 1) << 5)); }
__host__ __device__ __forceinline__ void stage_rc(int b, int& R, int& C) { const int st = b / 1024, sb = b % 1024, swz = sb ^ (((sb >> 9) & 1) << 5); R = (st >> 1) * 16 + swz / 64; C = (st & 1) * 32 + (swz % 64) / 2; }
__host__ __device__ __forceinline__ int perm32(int rho) { const int n = rho >> 4, i = rho & 15; return 8 * (i >> 2) + 4 * n + (i & 3); }

struct Unit { int pm, pn; };
struct Gemm { const bf16_t* A; const bf16_t* Bt; int M, N, K; const bf16_t* A2; const bf16_t* B2; };

struct StaticOrder {
    int nM, nN, nwg, G, c;
    __host__ __device__ void init(int M, int N, int G_, int c_) { nM = M / BM; nN = N / BM; nwg = nM * nN; G = G_; c = c_; }
    __host__ __device__ bool next(int i, Unit& u) const {
        const long L = (long)i * G + c; if (L >= nwg) return false;
        int wgid = (int)L; { const int q = nwg / NXCD, r = nwg % NXCD, xcd = wgid % NXCD, off = wgid / NXCD; wgid = (xcd < r ? xcd * (q + 1) : r * (q + 1) + (xcd - r) * q) + off; }
        const int nig = WGM * nN, gid = wgid / nig, fm = gid * WGM, gsz = (nM - fm) < WGM ? (nM - fm) : WGM;
        u.pm = fm + ((wgid % nig) % gsz); u.pn = (wgid % nig) / gsz; return true;
    }
    __device__ __forceinline__ void a_ready(const Unit&) const {}
    __device__ __forceinline__ void done(const Unit&) const {}
};
typedef float f32x2c_t __attribute__((ext_vector_type(2))); typedef __bf16 bf16x2c_t __attribute__((ext_vector_type(2)));
__device__ __forceinline__ unsigned cvt_pk_bf16(float lo, float hi) { f32x2c_t v = {lo, hi}; bf16x2c_t b = __builtin_convertvector(v, bf16x2c_t); return __builtin_bit_cast(unsigned, b); }
typedef float f32x2 __attribute__((ext_vector_type(2)));
__device__ __forceinline__ u32x4 pack8v(const f32x4 v0, const f32x4 v1) { u32x4 w; w.x = cvt_pk_bf16(v0[0], v0[1]); w.y = cvt_pk_bf16(v0[2], v0[3]); w.z = cvt_pk_bf16(v1[0], v1[1]); w.w = cvt_pk_bf16(v1[2], v1[3]); return w; }
__device__ __forceinline__ float dot8(const f32x4 a, const f32x4 b) { return ((a[0] * a[0] + a[1] * a[1]) + (a[2] * a[2] + a[3] * a[3])) + ((b[0] * b[0] + b[1] * b[1]) + (b[2] * b[2] + b[3] * b[3])); }
__device__ __forceinline__ float red_fq(float s) { s += __shfl_xor(s, 16); s += __shfl_xor(s, 32); return s; }

struct EpiProj {
    static constexpr bool PERM = true, AFTER_DRAIN = false;
    bf16_t* proj; float* pqk; const PG8_LAS float* rs;
    __device__ __forceinline__ void operator()(const f32x4 (&acc)[2][2][4][2], const Unit& u, int wr, int wc, int fr, int fq) const {
        const int C = u.pn * BM, which = C >> 11, hp = (C & 2047) >> 8, dcol = wc * 32 + 8 * fq;
#pragma unroll
        for (int ai = 0; ai < 2; ++ai)
#pragma unroll
            for (int m = 0; m < 4; ++m) { const int lr = ai * HALF + wr * 64 + m * 16 + fr, row = u.pm * BM + lr, b = row >> 13, t = row & 8191; const float r = rs[lr];
#pragma unroll
                for (int bj = 0; bj < 2; ++bj) { const int head = 2 * hp + bj;
                    const f32x4 v0 = acc[ai][bj][m][0] * r, v1 = acc[ai][bj][m][1] * r;
                    *(u32x4*)(proj + ((size_t)((which * 2 + b) * 16 + head) * 8192 + t) * 128 + dcol) = pack8v(v0, v1);
                    if (which < 2) { const float ss = red_fq(dot8(v0, v1)); if (fq == 0) pqk[((size_t)(which * 16384 + row) * 16 + head) * 4 + wc] = ss; } } }
    }
};
struct EpiOut {
    static constexpr bool PERM = true, AFTER_DRAIN = false;
    bf16_t* hb; float* part;
    __device__ __forceinline__ void operator()(const f32x4 (&acc)[2][2][4][2], const Unit& u, int wr, int wc, int fr, int fq) const {
        const int col0 = u.pn * BM + wc * 32 + 8 * fq, row0 = u.pm * BM + wr * 64 + fr;
#pragma unroll
        for (int g = 0; g < 8; ++g) { const int ai = g >> 2, m = g & 3, row = row0 + ai * HALF + m * 16; float ss = 0.f;
#pragma unroll
            for (int bj = 0; bj < 2; ++bj) { const size_t off = (size_t)row * 4096 + col0 + bj * HALF;
                const f32x4 v0 = acc[ai][bj][m][0], v1 = acc[ai][bj][m][1];
                *(u32x4*)(hb + off) = pack8v(v0, v1); ss += dot8(v0, v1); }
            ss = red_fq(ss); if (fq == 0) part[(size_t)row * 64 + u.pn * 4 + wc] = ss; }
    }
};
struct EpiE {
    static constexpr bool PERM = true, AFTER_DRAIN = false;
    bf16_t* eb; float* part; const float* gpost;
    __device__ __forceinline__ void operator()(const f32x4 (&acc)[2][2][4][2], const Unit& u, int wr, int wc, int fr, int fq) const {
        int fr_ = fr, fq_ = fq; asm volatile("" : "+v"(fr_), "+v"(fq_));
        const int col0 = u.pn * BM + wc * 32 + 8 * fq_;
        f32x4 gp[2][2];
#pragma unroll
        for (int bj = 0; bj < 2; ++bj) { gp[bj][0] = *(const f32x4*)(gpost + col0 + bj * HALF); gp[bj][1] = *(const f32x4*)(gpost + col0 + bj * HALF + 4); }
#pragma unroll
        for (int ai = 0; ai < 2; ++ai)
#pragma unroll
            for (int m = 0; m < 4; ++m) { const int row = u.pm * BM + ai * HALF + wr * 64 + m * 16 + fr_; float ss = 0.f;
#pragma unroll
                for (int bj = 0; bj < 2; ++bj) { const size_t off = (size_t)row * 4096 + col0 + bj * HALF;
                    const f32x4 v0 = acc[ai][bj][m][0], v1 = acc[ai][bj][m][1];
                    *(u32x4*)(eb + off) = pack8v(v0 * gp[bj][0], v1 * gp[bj][1]); ss += dot8(v0, v1); }
                ss = red_fq(ss); if (fq_ == 0) part[(size_t)row * 64 + u.pn * 4 + wc] = ss; }
    }
};
struct EpiUp {
    static constexpr bool PERM = true, AFTER_DRAIN = false;
    bf16_t* hid; const PG8_LAS float* rs;
    __device__ __forceinline__ void operator()(const f32x4 (&acc)[2][2][4][2], const Unit& u, int wr, int wc, int fr, int fq) const {
        const int col0 = u.pn * BM + wc * 32 + 8 * fq;
#pragma unroll
        for (int ai = 0; ai < 2; ++ai)
#pragma unroll
            for (int m = 0; m < 4; ++m) { const int lr = ai * HALF + wr * 64 + m * 16 + fr, row = u.pm * BM + lr; const float r = rs[lr];
#pragma unroll
                for (int bj = 0; bj < 2; ++bj) { f32x4 v0 = acc[ai][bj][m][0] * r, v1 = acc[ai][bj][m][1] * r;
#pragma unroll
                    for (int i = 0; i < 4; ++i) { const float a = fmaxf(v0[i], 0.f), b = fmaxf(v1[i], 0.f); v0[i] = a * a; v1[i] = b * b; }
                    *(u32x4*)(hid + (size_t)row * 16384 + col0 + bj * HALF) = pack8v(v0, v1); } }
    }
};
struct EpiDown {
    static constexpr bool PERM = true, AFTER_DRAIN = false;
    const bf16_t* h1b; bf16_t* hb; unsigned char* h8; float* part; int row_off;
    __device__ __forceinline__ void operator()(const f32x4 (&acc)[2][2][4][2], const Unit& u, int wr, int wc, int fr, int fq) const {
        const int col0 = u.pn * BM + wc * 32 + 8 * fq, row0 = row_off + u.pm * BM + wr * 64 + fr;
        u32x4 nx[2];
#pragma unroll
        for (int bj = 0; bj < 2; ++bj) nx[bj] = *(const u32x4*)(h1b + (size_t)row0 * 4096 + col0 + bj * HALF);
#pragma unroll
        for (int g = 0; g < 8; ++g) { const int ai = g >> 2, m = g & 3, row = row0 + ai * HALF + m * 16; float ss = 0.f;
            u32x4 cx[2];
#pragma unroll
            for (int bj = 0; bj < 2; ++bj) cx[bj] = nx[bj];
            if (g < 7) { const int rown = row0 + ((g + 1) >> 2) * HALF + ((g + 1) & 3) * 16;
#pragma unroll
                for (int bj = 0; bj < 2; ++bj) nx[bj] = *(const u32x4*)(h1b + (size_t)rown * 4096 + col0 + bj * HALF); }
#pragma unroll
            for (int bj = 0; bj < 2; ++bj) { const size_t off = (size_t)row * 4096 + col0 + bj * HALF; const u32x4 w = cx[bj];
                f32x4 v0 = acc[ai][bj][m][0], v1 = acc[ai][bj][m][1];
                v0[0] += __uint_as_float(w.x << 16); v0[1] += __uint_as_float(w.x & 0xffff0000u); v0[2] += __uint_as_float(w.y << 16); v0[3] += __uint_as_float(w.y & 0xffff0000u);
                v1[0] += __uint_as_float(w.z << 16); v1[1] += __uint_as_float(w.z & 0xffff0000u); v1[2] += __uint_as_float(w.w << 16); v1[3] += __uint_as_float(w.w & 0xffff0000u);
                *(u32x4*)(hb + off) = pack8v(v0, v1); ss += dot8(v0, v1);
                { typedef unsigned u32x2_ __attribute__((ext_vector_type(2))); u32x2_ q;
                  int p0 = __builtin_amdgcn_cvt_pk_fp8_f32(v0[0], v0[1], 0, false); p0 = __builtin_amdgcn_cvt_pk_fp8_f32(v0[2], v0[3], p0, true);
                  int p1 = __builtin_amdgcn_cvt_pk_fp8_f32(v1[0], v1[1], 0, false); p1 = __builtin_amdgcn_cvt_pk_fp8_f32(v1[2], v1[3], p1, true);
                  q.x = (unsigned)p0; q.y = (unsigned)p1; *(u32x2_*)(h8 + off) = q; } }
            ss = red_fq(ss); if (fq == 0) part[(size_t)row * 64 + u.pn * 4 + wc] = ss;
            asm volatile("" ::: "memory"); }
    }
};
struct EpiGate {
    static constexpr bool PERM = true, AFTER_DRAIN = false;
    float* out; const bf16_t* h2b; const bf16_t* eb; float wscale_inv; const PG8_LAS float* rs2; const PG8_LAS float* rse;
    __device__ __forceinline__ void operator()(const f32x4 (&acc)[2][2][4][2], const Unit& u, int wr, int wc, int fr, int fq) const {
        int fr_ = fr, fq_ = fq; asm volatile("" : "+v"(fr_), "+v"(fq_));
        const int col0 = u.pn * BM + wc * 32 + 8 * fq_, lr0 = wr * 64 + fr_, row0 = u.pm * BM + lr0;
        u32x4 nx[2], ne[2];
#pragma unroll
        for (int bj = 0; bj < 2; ++bj) { const size_t off = (size_t)row0 * 4096 + col0 + bj * HALF; nx[bj] = *(const u32x4*)(h2b + off); ne[bj] = *(const u32x4*)(eb + off); }
#pragma unroll
        for (int g = 0; g < 8; ++g) { const int ai = g >> 2, m = g & 3, lr = lr0 + ai * HALF + m * 16, row = row0 + ai * HALF + m * 16;
            const float r2 = rs2[lr] * wscale_inv * -1.4426950408889634f, re = rse[lr];
            u32x4 cx[2], ce[2];
#pragma unroll
            for (int bj = 0; bj < 2; ++bj) { cx[bj] = nx[bj]; ce[bj] = ne[bj]; }
            if (g < 7) { const int rown = row0 + ((g + 1) >> 2) * HALF + ((g + 1) & 3) * 16;
#pragma unroll
                for (int bj = 0; bj < 2; ++bj) { const size_t off = (size_t)rown * 4096 + col0 + bj * HALF; nx[bj] = *(const u32x4*)(h2b + off); ne[bj] = *(const u32x4*)(eb + off); } }
#pragma unroll
            for (int bj = 0; bj < 2; ++bj) { const size_t off = (size_t)row * 4096 + col0 + bj * HALF;
                const u32x4 ew = ce[bj], hw = cx[bj];
                f32x4 e0, e1, v0, v1;
                e0[0] = __uint_as_float(ew.x << 16); e0[1] = __uint_as_float(ew.x & 0xffff0000u); e0[2] = __uint_as_float(ew.y << 16); e0[3] = __uint_as_float(ew.y & 0xffff0000u);
                e1[0] = __uint_as_float(ew.z << 16); e1[1] = __uint_as_float(ew.z & 0xffff0000u); e1[2] = __uint_as_float(ew.w << 16); e1[3] = __uint_as_float(ew.w & 0xffff0000u);
                v0[0] = __uint_as_float(hw.x << 16); v0[1] = __uint_as_float(hw.x & 0xffff0000u); v0[2] = __uint_as_float(hw.y << 16); v0[3] = __uint_as_float(hw.y & 0xffff0000u);
                v1[0] = __uint_as_float(hw.z << 16); v1[1] = __uint_as_float(hw.z & 0xffff0000u); v1[2] = __uint_as_float(hw.w << 16); v1[3] = __uint_as_float(hw.w & 0xffff0000u);
#pragma unroll
                for (int i = 0; i < 4; ++i) { const float g0 = __builtin_amdgcn_rcpf(1.f + __builtin_amdgcn_exp2f(acc[ai][bj][m][0][i] * r2)), g1 = __builtin_amdgcn_rcpf(1.f + __builtin_amdgcn_exp2f(acc[ai][bj][m][1][i] * r2));
                    v0[i] += g0 * (e0[i] * re); v1[i] += g1 * (e1[i] * re); }
                *(f32x4*)(out + off) = v0; *(f32x4*)(out + off + 4) = v1; }
            asm volatile("" ::: "memory"); }
    }
};
template <class Epi, class Sched, bool ALIGN_EPI = false, bool SP2 = false, bool FP8 = false, int EXT = 0>
__device__ __forceinline__ void gemm_phase(PG8_LAS unsigned char* lds, const Gemm g, const Sched& S, const Epi& E, const int wave_s  ) {
    int lane_; asm volatile("v_mbcnt_lo_u32_b32 %0, -1, 0\n\tv_mbcnt_hi_u32_b32 %0, -1, %0" : "=v"(lane_)); const int tid_ = wave_s * 64 + lane_;
    const int tid = tid_, wid = wave_s, lane = lane_, wr = wid >> 2, wc = wid & 3, fr = lane & 15, fq = lane >> 4;
    const int K = g.K, nt = K / BK;
    unsigned voffA[2], voffB[2];
#pragma unroll
    for (int i = 0; i < 2; ++i) { int R, C; stage_rc(tid * 16 + i * 8192, R, C); const int Rb = Epi::PERM ? ((R & ~31) + perm32(R & 31)) : R;
        voffA[i] = (unsigned)(R * K + C) * 2u; voffB[i] = (unsigned)(Rb * K + C) * 2u; }
    const size_t kstep = (size_t)(BK * 2);
    const size_t hstep = (size_t)HALF * K * 2;
    const size_t tstep = 2 * hstep;
    const unsigned ldsw = (unsigned)wid * 1024u;
    const int aoff = lds_byte(wr * 64 + fr, fq * 8), boff = lds_byte(wc * 32 + fr, fq * 8);
    const int aoff8 = lds_byte(wr * 64 + fr, fq * 16), boff8 = lds_byte(wc * 32 + fr, fq * 16);
#define PG8_SA(b, h) (((b) * 2 + (h)) * HTB)
#define PG8_SB(b, h) ((4 + (b) * 2 + (h)) * HTB)
#define PG8_STAGE(bufoff, gbase, voff) do { const char* gb_ = (const char*)(gbase); asm volatile("" : "+s"(gb_)); _Pragma("unroll") for (int _i = 0; _i < 2; ++_i) { asm volatile("" : "+v"((voff)[_i])); \
        __builtin_amdgcn_global_load_lds((const unsigned*)(gb_ + (voff)[_i]), (PG8_LAS unsigned*)(lds + (bufoff) + ldsw + _i * 8192), 16, 0, 0); } } while (0)
#define PG8_LDA(dst, b, h) do { _Pragma("unroll") for (int m = 0; m < 4; ++m) _Pragma("unroll") for (int k = 0; k < 2; ++k) dst[m][k] = *(const PG8_LAS bf16x8*)(lds + PG8_SA(b, h) + (FP8 ? aoff8 + m * 2048 + k * 16 : aoff + m * 2048 + k * 1024)); } while (0)
#define PG8_LDB(dst, b, h) do { _Pragma("unroll") for (int n = 0; n < 2; ++n) _Pragma("unroll") for (int k = 0; k < 2; ++k) dst[n][k] = *(const PG8_LAS bf16x8*)(lds + PG8_SB(b, h) + (FP8 ? boff8 + n * 2048 + k * 16 : boff + n * 2048 + k * 1024)); } while (0)
#define PG8_MMA(ai, bj, At, Bt) do { __builtin_amdgcn_s_setprio(1); if constexpr (FP8) { typedef int v8i_ __attribute__((ext_vector_type(8))); \
        _Pragma("unroll") for (int m = 0; m < 4; ++m) _Pragma("unroll") for (int n = 0; n < 2; ++n) \
            { const v8i_ b8_ = __builtin_bit_cast(v8i_, __builtin_shufflevector(Bt[n][0], Bt[n][1], 0, 1, 2, 3, 4, 5, 6, 7, 8, 9, 10, 11, 12, 13, 14, 15)), a8_ = __builtin_bit_cast(v8i_, __builtin_shufflevector(At[m][0], At[m][1], 0, 1, 2, 3, 4, 5, 6, 7, 8, 9, 10, 11, 12, 13, 14, 15)); \
              asm volatile("v_mfma_f32_16x16x128_f8f6f4 %0, %1, %2, %0" : "+v"(acc[ai][bj][m][n]) : "v"(b8_), "v"(a8_)); }     \
            } else { \
        _Pragma("unroll") for (int m = 0; m < 4; ++m) _Pragma("unroll") for (int n = 0; n < 2; ++n) _Pragma("unroll") for (int k = 0; k < 2; ++k) \
        acc[ai][bj][m][n] = __builtin_amdgcn_mfma_f32_16x16x32_bf16(Bt[n][k], At[m][k], acc[ai][bj][m][n], 0, 0, 0); } __builtin_amdgcn_s_setprio(0); } while (0)
#define PG8_WAIT_V(n) asm volatile("s_waitcnt vmcnt(" #n ")" ::: "memory")
#define PG8_WAIT_L(n) asm volatile("s_waitcnt lgkmcnt(" #n ")" ::: "memory")
#define PG8_BAR __builtin_amdgcn_s_barrier()
#define PG8_SCHED __builtin_amdgcn_sched_barrier(0)
    Unit cur, nxt; int ui = 0;
    if (!S.next(0, cur)) return;
    f32x4 acc[2][2][4][2];
#pragma unroll
    for (int a = 0; a < 2; ++a)
#pragma unroll
        for (int b = 0; b < 2; ++b)
#pragma unroll
            for (int m = 0; m < 4; ++m)
#pragma unroll
                for (int n = 0; n < 2; ++n) acc[a][b][m][n] = (f32x4){0.f, 0.f, 0.f, 0.f};
    bf16x8 At[4][2], B0[2][2], B1[2][2];
    const char* cA = (const char*)g.A + (size_t)cur.pm * tstep; const char* cB = (const char*)g.Bt + (size_t)cur.pn * tstep;
    S.a_ready(cur);
    if constexpr (SP2) {
        PG8_STAGE(PG8_SB(0, 0), cB, voffB); PG8_STAGE(PG8_SB(0, 1), cB + hstep, voffB); PG8_STAGE(PG8_SA(0, 0), cA, voffA); PG8_STAGE(PG8_SA(0, 1), cA + hstep, voffA);
        if (wr == 1) PG8_BAR;
        PG8_WAIT_V(2); PG8_BAR;
        PG8_STAGE(PG8_SB(1, 0), cB + kstep, voffB); PG8_STAGE(PG8_SA(1, 0), cA + kstep, voffA); PG8_STAGE(PG8_SB(1, 1), cB + hstep + kstep, voffB);
        PG8_WAIT_V(6); PG8_BAR;
    } else {
        PG8_STAGE(PG8_SB(0, 0), cB, voffB); PG8_STAGE(PG8_SA(0, 0), cA, voffA); PG8_STAGE(PG8_SB(0, 1), cB + hstep, voffB); PG8_STAGE(PG8_SA(0, 1), cA + hstep, voffA);
        if (wr == 1) PG8_BAR;
        PG8_WAIT_V(4); PG8_BAR;
        PG8_STAGE(PG8_SB(1, 0), cB + kstep, voffB); PG8_STAGE(PG8_SA(1, 0), cA + kstep, voffA); PG8_STAGE(PG8_SB(1, 1), cB + hstep + kstep, voffB);
        PG8_WAIT_V(6); PG8_BAR;
    }
    for (;;) {
        const bool has_next = S.next(ui + 1, nxt);
        const char* nA = has_next ? (const char*)g.A + (size_t)nxt.pm * tstep : cA; const char* nB = has_next ? (const char*)g.Bt + (size_t)nxt.pn * tstep : cB;
        static_assert(EXT % 2 == 0, "EXT");
        const char* xA = EXT ? (const char*)g.A2 + (size_t)cur.pm * tstep + (size_t)cur.pn * (BM * 2) : cA; const char* xB = EXT ? (const char*)g.B2 : cB;
        const int NT = nt + EXT;
        for (int t = 0; t < NT; t += 2) {
            const bool last = (t == NT - 2);
            const char* a1 = (!EXT || t < nt) ? cA + (size_t)(t + 1) * kstep : xA + (size_t)(t + 1 - nt) * kstep;
            const char* a2; const char* b2;
            if (last) { a2 = nA; b2 = nB; } else if (!EXT || t + 2 < nt) { a2 = cA + (size_t)(t + 2) * kstep; b2 = cB + (size_t)(t + 2) * kstep; } else { a2 = xA + (size_t)(t + 2 - nt) * kstep; b2 = xB + (size_t)(t + 2 - nt) * kstep; }
            const char* a3 = a2 + kstep; const char* b3 = b2 + kstep;
            if (last && has_next) S.a_ready(nxt);
            if constexpr (SP2) {
            PG8_LDB(B0, 0, 0); PG8_LDB(B1, 0, 1); PG8_SCHED; PG8_LDA(At, 0, 0); PG8_STAGE(PG8_SA(1, 1), a1 + hstep, voffA);
            PG8_WAIT_V(8); PG8_WAIT_L(0); PG8_BAR; PG8_MMA(0, 0, At, B0); PG8_MMA(0, 1, At, B1); PG8_BAR; PG8_SCHED;
            PG8_LDA(At, 0, 1); PG8_STAGE(PG8_SB(0, 0), b2, voffB); PG8_STAGE(PG8_SB(0, 1), b2 + hstep, voffB); PG8_STAGE(PG8_SA(0, 0), a2, voffA);
            PG8_WAIT_V(8); PG8_WAIT_L(0); PG8_BAR; PG8_MMA(1, 0, At, B0); PG8_MMA(1, 1, At, B1); PG8_BAR; PG8_SCHED;
            PG8_LDB(B0, 1, 0); PG8_LDB(B1, 1, 1); PG8_SCHED; PG8_LDA(At, 1, 0); PG8_STAGE(PG8_SA(0, 1), a2 + hstep, voffA);
            PG8_WAIT_V(8); PG8_WAIT_L(0); PG8_BAR; PG8_MMA(0, 0, At, B0); PG8_MMA(0, 1, At, B1); PG8_BAR; PG8_SCHED;
            PG8_LDA(At, 1, 1); PG8_STAGE(PG8_SB(1, 0), b3, voffB); PG8_STAGE(PG8_SB(1, 1), b3 + hstep, voffB); PG8_STAGE(PG8_SA(1, 0), a3, voffA);
            PG8_WAIT_V(8); PG8_WAIT_L(0); PG8_BAR; PG8_MMA(1, 0, At, B0); PG8_MMA(1, 1, At, B1); PG8_BAR; PG8_SCHED;
            } else {
            PG8_LDB(B0, 0, 0); PG8_SCHED; PG8_LDA(At, 0, 0); PG8_STAGE(PG8_SA(1, 1), a1 + hstep, voffA);
            PG8_WAIT_L(8); PG8_BAR; PG8_WAIT_L(0); PG8_MMA(0, 0, At, B0); PG8_BAR; PG8_SCHED;
            PG8_LDB(B1, 0, 1); PG8_STAGE(PG8_SB(0, 0), b2, voffB);
            PG8_BAR; PG8_WAIT_L(0); PG8_MMA(0, 1, At, B1); PG8_BAR;
            PG8_LDA(At, 0, 1); PG8_STAGE(PG8_SA(0, 0), a2, voffA);
            PG8_BAR; PG8_WAIT_L(0); PG8_MMA(1, 0, At, B0); PG8_BAR; PG8_SCHED;
            PG8_STAGE(PG8_SB(0, 1), b2 + hstep, voffB);
            PG8_WAIT_V(6); PG8_BAR; PG8_MMA(1, 1, At, B1); PG8_BAR;
            PG8_LDB(B0, 1, 0); PG8_SCHED; PG8_LDA(At, 1, 0); PG8_STAGE(PG8_SA(0, 1), a2 + hstep, voffA);
            PG8_WAIT_L(8); PG8_BAR; PG8_WAIT_L(0); PG8_MMA(0, 0, At, B0); PG8_BAR; PG8_SCHED;
            PG8_LDB(B1, 1, 1); PG8_STAGE(PG8_SB(1, 0), b3, voffB);
            PG8_BAR; PG8_WAIT_L(0); PG8_MMA(0, 1, At, B1); PG8_BAR;
            PG8_LDA(At, 1, 1); PG8_STAGE(PG8_SA(1, 0), a3, voffA);
            PG8_BAR; PG8_WAIT_L(0); PG8_MMA(1, 0, At, B0); PG8_BAR; PG8_SCHED;
            PG8_STAGE(PG8_SB(1, 1), b3 + hstep, voffB);
            PG8_WAIT_V(6); PG8_BAR; PG8_MMA(1, 1, At, B1); PG8_BAR;
            }
        }
        if constexpr (FP8) asm volatile("s_nop 7\n\ts_nop 7\n\ts_nop 7" ::: "memory");
        if constexpr (ALIGN_EPI) { if (wr == 0) PG8_BAR; }
        if constexpr (!Epi::AFTER_DRAIN) { { int l2_; asm volatile("v_mbcnt_lo_u32_b32 %0, -1, 0\n\tv_mbcnt_hi_u32_b32 %0, -1, %0" : "=v"(l2_)); E(acc, cur, wr, wc, l2_ & 15, l2_ >> 4); }     S.done(cur); }
        if (!has_next) break;
#pragma unroll
        for (int a = 0; a < 2; ++a)
#pragma unroll
            for (int b = 0; b < 2; ++b)
#pragma unroll
                for (int m = 0; m < 4; ++m)
#pragma unroll
                    for (int n = 0; n < 2; ++n) acc[a][b][m][n] = (f32x4){0.f, 0.f, 0.f, 0.f};
        cur = nxt; cA = nA; cB = nB; ++ui;
        if constexpr (ALIGN_EPI) { if (wr == 1) PG8_BAR; }
    }
    PG8_WAIT_V(0);
    if constexpr (!ALIGN_EPI) { if (wr == 0) PG8_BAR; }
    PG8_BAR;
    if constexpr (Epi::AFTER_DRAIN) { E.fused(acc, cur, wr, wc, fr, fq, lds, wid, lane); S.done(cur); }
#undef PG8_SA
#undef PG8_SB
#undef PG8_STAGE
#undef PG8_LDA
#undef PG8_LDB
#undef PG8_MMA
#undef PG8_WAIT_V
#undef PG8_WAIT_L
#undef PG8_BAR
#undef PG8_SCHED
}
}
namespace fa {
constexpr int D = 128;
constexpr float SCALE = 0.08838834764831845f;
constexpr float LOG2E = 1.4426950408889634f;
constexpr float THR2 = 8.f * LOG2E;
constexpr bool WSKIP = false;
constexpr int OPITCH = 4096;
constexpr int NW = 8, QBLK = 32, KVBLK = 64, QB = NW * QBLK;
constexpr int SHM_V = KVBLK * D * 2, SHM_K = KVBLK * D * 2;
constexpr int LDS_BYTES = 2 * SHM_V + 2 * SHM_K + NW * 64 * 4;
constexpr int TAB_MAX = 8192 + QB;
constexpr int FL_OFF = LDS_BYTES, RK_OFF = FL_OFF + TAB_MAX * 4, GG_OFF = RK_OFF + TAB_MAX * 4, SCR_OFF = GG_OFF + 512, FA_LDS_END = SCR_OFF + 64;
constexpr int WBIG = 1 << 30;

using bf16 = __hip_bfloat16;
typedef short bf16x8 __attribute__((ext_vector_type(8)));
typedef short s16x4 __attribute__((ext_vector_type(4)));
typedef float f32x16 __attribute__((ext_vector_type(16)));
typedef float f32x4 __attribute__((ext_vector_type(4)));
typedef unsigned u32x4 __attribute__((ext_vector_type(4)));
template <class A, class Bt> struct same_t { static constexpr bool v = false; };
template <class A> struct same_t<A, A> { static constexpr bool v = true; };

#define KSWZ(row, colB) ((row) * 256 + ((colB) ^ (((row) & 7) << 4)))
#define SBAR() __builtin_amdgcn_sched_barrier(0)
__device__ __forceinline__ int v_st(int k, int c) { const int kk = (k & ~0xC) | ((k & 4) << 1) | ((k & 8) >> 1); return ((kk >> 3) * 4 + (c >> 5)) * 512 + ((kk & 7) * 32 + (c & 31)) * 2; }
__device__ __forceinline__ int v_rd_base(int lane) { return ((lane & 3) << 3) | (((lane >> 2) & 3) << 6) | (((lane >> 4) & 1) << 5) | (((lane >> 5) & 1) << 8); }
constexpr int v_rd_off(int d0, int ks, int half) { return d0 * 512 + ks * 4096 + half * 2048; }
__device__ __forceinline__ int crow(int r, int hi) { return (r & 3) + 8 * (r >> 2) + 4 * hi; }
__device__ __forceinline__ unsigned cvtpk(float lo, float hi) {
    unsigned r; asm volatile("v_cvt_pk_bf16_f32 %0, %1, %2" : "=v"(r) : "v"(lo), "v"(hi)); return r;
}
__device__ __forceinline__ bf16x8 pack8(f32x4 a, f32x4 b) {
    u32x4 w = {cvtpk(a[0], a[1]), cvtpk(a[2], a[3]), cvtpk(b[0], b[1]), cvtpk(b[2], b[3])};
    return *reinterpret_cast<bf16x8*>(&w);
}
template <class T> __device__ __forceinline__ bf16x8 load8(const T* p) {
    if constexpr (same_t<T, float>::v) { return pack8(*(const f32x4*)p, *(const f32x4*)(p + 4)); }
    else { return *reinterpret_cast<const bf16x8*>(p); }
}
__device__ __forceinline__ void mask_tile(f32x16& p0, f32x16& p1, int dq, unsigned W) {
    const float NEG = -__builtin_inff();
#pragma unroll
    for (int r = 0; r < 16; ++r) {
        const int c = (r & 3) + 8 * (r >> 2);
        if ((unsigned)(dq - c) >= W) p0[r] = NEG;
        if ((unsigned)(dq - c - 32) >= W) p1[r] = NEG;
    }
}
__device__ __forceinline__ void partialSM(f32x16& p0, f32x16& p1, const float* FlL, const float* RKL, float& m_reg, float& mn, float& alpha) {
#pragma unroll
    for (int g = 0; g < 4; ++g) { const f32x4 f0 = *(const f32x4*)(FlL + 8 * g), k0 = *(const f32x4*)(RKL + 8 * g), f1 = *(const f32x4*)(FlL + 32 + 8 * g), k1 = *(const f32x4*)(RKL + 32 + 8 * g);
#pragma unroll
        for (int i = 0; i < 4; ++i) { p0[4 * g + i] = fmaf(p0[4 * g + i], k0[i], f0[i]); p1[4 * g + i] = fmaf(p1[4 * g + i], k1[i], f1[i]); } }
    float pmax = p0[0]; for (int r = 1; r < 16; ++r) pmax = fmaxf(pmax, p0[r]); for (int r = 0; r < 16; ++r) pmax = fmaxf(pmax, p1[r]);
    { auto rr = __builtin_amdgcn_permlane32_swap(__float_as_uint(pmax), __float_as_uint(pmax), false, false);
      pmax = fmaxf(__uint_as_float(rr[0]), __uint_as_float(rr[1])); }
    if (__builtin_expect(__all((pmax - m_reg) <= THR2), 1)) { mn = m_reg; alpha = 1.f; }
    else { mn = fmaxf(m_reg, pmax); alpha = __builtin_amdgcn_exp2f(m_reg - mn); m_reg = mn; }
    for (int r = 0; r < 16; ++r) p0[r] = p0[r] - mn; for (int r = 0; r < 16; ++r) p1[r] = p1[r] - mn;
    for (int r = 0; r < 16; ++r) p0[r] = __builtin_amdgcn_exp2f(p0[r]);
}
__device__ __forceinline__ void finishSM(f32x16& p0, f32x16& p1, float alpha, float& l_reg, bf16x8& pa0, bf16x8& pa1, bf16x8& pa2, bf16x8& pa3) {
    for (int r = 0; r < 16; ++r) p1[r] = __builtin_amdgcn_exp2f(p1[r]);
    float ps = 0; for (int r = 0; r < 16; ++r) ps += p0[r]; for (int r = 0; r < 16; ++r) ps += p1[r];
    { auto rr = __builtin_amdgcn_permlane32_swap(__float_as_uint(ps), __float_as_uint(ps), false, false);
      ps = __uint_as_float(rr[0]) + __uint_as_float(rr[1]); }
    l_reg = l_reg * alpha + ps;
#define PK4(P, B_, OUT) do { unsigned a0 = cvtpk(P[B_+0], P[B_+1]), a1 = cvtpk(P[B_+2], P[B_+3]);                          \
        unsigned b0 = cvtpk(P[B_+4], P[B_+5]), b1 = cvtpk(P[B_+6], P[B_+7]);                                             \
        auto r0 = __builtin_amdgcn_permlane32_swap(a0, b0, false, false); auto r1 = __builtin_amdgcn_permlane32_swap(a1, b1, false, false); \
        u32x4 w = {r0[0], r1[0], r0[1], r1[1]}; OUT = *reinterpret_cast<bf16x8*>(&w); } while (0)
    PK4(p0, 0, pa0); PK4(p0, 8, pa1); PK4(p1, 0, pa2); PK4(p1, 8, pa3);
#undef PK4
}
template <int KB, bool SK>
__device__ __forceinline__ void qkt(f32x16& p0, f32x16& p1, const char* K_lds, int r32, int hi, const bf16x8* qr, bool act) {
    if (SK && !act) { const float NEG = -__builtin_inff();
#pragma unroll
        for (int r = 0; r < 16; ++r) { p0[r] = NEG; p1[r] = NEG; } return; }
    p0 = f32x16{}; p1 = f32x16{};
    const char* kb[4];
#pragma unroll
    for (int dd = 0; dd < 4; ++dd) kb[dd] = K_lds + KB * SHM_K + KSWZ(r32, (dd * 16 + hi * 8) * 2);
#pragma unroll
    for (int d0 = 0; d0 < 8; ++d0) { const char* a = kb[d0 & 3] + (d0 >> 2) * 128;
        bf16x8 b0 = *reinterpret_cast<const bf16x8*>(a);
        bf16x8 b1 = *reinterpret_cast<const bf16x8*>(a + 32 * 256);
        p0 = __builtin_amdgcn_mfma_f32_32x32x16_bf16(b0, qr[d0], p0, 0, 0, 0);
        p1 = __builtin_amdgcn_mfma_f32_32x32x16_bf16(b1, qr[d0], p1, 0, 0, 0); }
}
template <int VB, bool SK>
__device__ __forceinline__ void pv_tile(f32x16* o, int vb0, bf16x8 pa0, bf16x8 pa1, bf16x8 pa2, bf16x8 pa3, bool act) {
    if (SK && !act) return;
#define TRRD(dst, off) asm volatile("ds_read_b64_tr_b16 %0, %1 offset:%2" : "=&v"(dst) : "v"(vb0), "i"(off) : "memory")
#define PV_D0(d0) do { s16x4 l0, l1, l2, l3, h0, h1, h2, h3; constexpr int b_ = VB * SHM_V + v_rd_off(d0, 0, 0);     \
        TRRD(l0, b_); TRRD(h0, b_ + 2048); TRRD(l1, b_ + 4096); TRRD(h1, b_ + 6144); TRRD(l2, b_ + 8192); TRRD(h2, b_ + 10240); TRRD(l3, b_ + 12288); TRRD(h3, b_ + 14336); \
        asm volatile("s_waitcnt lgkmcnt(0)" ::: "memory"); SBAR();                 \
        o[d0] = __builtin_amdgcn_mfma_f32_32x32x16_bf16(pa0, (bf16x8){l0[0], l0[1], l0[2], l0[3], h0[0], h0[1], h0[2], h0[3]}, o[d0], 0, 0, 0);   \
        o[d0] = __builtin_amdgcn_mfma_f32_32x32x16_bf16(pa1, (bf16x8){l1[0], l1[1], l1[2], l1[3], h1[0], h1[1], h1[2], h1[3]}, o[d0], 0, 0, 0);   \
        o[d0] = __builtin_amdgcn_mfma_f32_32x32x16_bf16(pa2, (bf16x8){l2[0], l2[1], l2[2], l2[3], h2[0], h2[1], h2[2], h2[3]}, o[d0], 0, 0, 0);   \
        o[d0] = __builtin_amdgcn_mfma_f32_32x32x16_bf16(pa3, (bf16x8){l3[0], l3[1], l3[2], l3[3], h3[0], h3[1], h3[2], h3[3]}, o[d0], 0, 0, 0); } while (0)
    PV_D0(0); PV_D0(1); PV_D0(2); PV_D0(3);
#undef PV_D0
#undef TRRD
}

template <class TIn, class TOut> struct BlockRef { const TIn* Q; const TIn* K; const TIn* V; TOut* O; int P0; int jlo; const float* LS; const float* PK; const float* PQ; float thr2; };

template <class TIn, class TOut>
__device__ __forceinline__ void fox_block(const BlockRef<TIn, TOut>& cur, char* lds, const int wave_s) {
    int lane_; asm volatile("v_mbcnt_lo_u32_b32 %0, -1, 0\n\tv_mbcnt_hi_u32_b32 %0, -1, %0" : "=v"(lane_));
    const int tid = wave_s * 64 + lane_, wid = wave_s, lane = lane_, r32 = lane & 31, hi = lane >> 5;
    const int j_lo = cur.jlo, NT = (cur.P0 + QB) / KVBLK - j_lo;
    const int qlo = cur.P0 + wid * QBLK, qm = qlo + r32 - 4 * hi;
    char* V_lds = lds; char* K_lds = lds + 2 * SHM_V;
    float* ws = (float*)(lds + 2 * SHM_V + 2 * SHM_K) + wid * 64; float* li_l = ws, * al_l = ws + 32;
    const int sr = tid >> 4, sc = (tid & 15) * 8, vst0 = v_st(sr, sc), vst1 = v_st(32 + sr, sc), kws = KSWZ(sr, sc * 2);
    const int vb0 = (int)(uintptr_t)V_lds + v_rd_base(lane);
    float* Flt = (float*)(lds + FL_OFF); float* RKt = (float*)(lds + RK_OFF); const float* GGt = (const float*)(lds + GG_OFF); float* wsum = (float*)(lds + SCR_OFF);
    bf16x8 st_v0, st_v1, st_k0, st_k1;
#define FB_LOAD(j) do { const size_t o_ = (size_t)((j) * KVBLK + sr) * D + sc; st_v0 = load8<TIn>(cur.V + o_); st_v1 = load8<TIn>(cur.V + o_ + 32 * D); st_k0 = load8<TIn>(cur.K + o_); st_k1 = load8<TIn>(cur.K + o_ + 32 * D); } while (0)
#define FB_WRITE(bf) do { *(bf16x8*)(K_lds + (bf) * SHM_K + kws) = st_k0; *(bf16x8*)(K_lds + (bf) * SHM_K + kws + 32 * 256) = st_k1; *(bf16x8*)(V_lds + (bf) * SHM_V + vst0) = st_v0; *(bf16x8*)(V_lds + (bf) * SHM_V + vst1) = st_v1; } while (0)
    FB_LOAD(j_lo);
    bf16x8 qr[8];
#pragma unroll
    for (int d0 = 0; d0 < 8; ++d0) qr[d0] = load8<TIn>(cur.Q + (size_t)(wid * QBLK + r32) * D + d0 * 16 + hi * 8);
    { const int s0 = j_lo * KVBLK, len = cur.P0 + QB - s0;
      float carry = 0.f;
      const f32x4 pq = *(const f32x4*)(cur.PQ + (size_t)(cur.P0 + wid * QBLK + r32) * 64);
      for (int base = 0; base < len; base += NW * 64) { const int i = base + tid;
          float x = (i < len) ? cur.LS[s0 + i] : 0.f;
          f32x4 pk = {1.f, 1.f, 1.f, 1.f}; if (i < len) pk = *(const f32x4*)(cur.PK + (size_t)(s0 + i) * 64);
#pragma unroll
          for (int o = 1; o < 64; o <<= 1) { const float y = __shfl_up(x, o); if (lane >= o) x += y; }
          if (lane == 63) wsum[wid] = x;
          __syncthreads();
          float off = carry, tot = 0.f;
#pragma unroll
          for (int w = 0; w < NW; ++w) { const float ws_ = wsum[w]; tot += ws_; if (w < wid) off += ws_; }
          if (i < len) { Flt[i] = -(x + off) * LOG2E;
              RKt[i] = (SCALE * LOG2E) / sqrtf(((pk[0] + pk[1]) + (pk[2] + pk[3])) * (1.f / 128.f) + 1e-6f); }
          carry += tot;
          __syncthreads(); }
      const float rq = 1.f / sqrtf(((pq[0] + pq[1]) + (pq[2] + pq[3])) * (1.f / 128.f) + 1e-6f);
#pragma unroll
      for (int d0 = 0; d0 < 8; ++d0) { const f32x4 g0 = *(const f32x4*)(GGt + d0 * 16 + hi * 8), g1 = *(const f32x4*)(GGt + d0 * 16 + hi * 8 + 4);
          f32x4 a, b;
#pragma unroll
          for (int j = 0; j < 4; ++j) { a[j] = __uint_as_float(((unsigned)(unsigned short)qr[d0][j]) << 16) * (rq * g0[j]); b[j] = __uint_as_float(((unsigned)(unsigned short)qr[d0][4 + j]) << 16) * (rq * g1[j]); }
          qr[d0] = pack8(a, b); }
    }
    const float* Flb = Flt + 4 * hi; const float* RKb = RKt + 4 * hi;
    asm volatile("s_waitcnt vmcnt(0)" ::: "memory"); FB_WRITE(0);
    __syncthreads();
    float m_reg = -1e30f, l_reg = 0; f32x16 o[4] = {};
    for (int t = 0; t < NT; ++t) {
        const int buf = t & 1, kb = (j_lo + t) * KVBLK;
        if (t + 1 < NT) FB_LOAD(j_lo + t + 1);
        if (kb <= qlo + QBLK - 1 && !(Flt[qlo - j_lo * KVBLK] - Flt[t * KVBLK + KVBLK - 1] > cur.thr2)) {
            f32x16 p0, p1; float mn, al; bf16x8 pa0, pa1, pa2, pa3;
            qkt<0, false>(p0, p1, K_lds + buf * SHM_K, r32, hi, qr, true);
            if (kb + KVBLK - 1 > qlo) mask_tile(p0, p1, qm - kb, (unsigned)WBIG);
            partialSM(p0, p1, Flb + t * KVBLK, RKb + t * KVBLK, m_reg, mn, al);
            if (__any(al < 1.f)) { if (hi == 0) al_l[r32] = al; asm volatile("s_waitcnt lgkmcnt(0)" ::: "memory");
                for (int d_ = 0; d_ < 4; ++d_) for (int r = 0; r < 16; ++r) o[d_][r] *= al_l[crow(r, hi)]; }
            finishSM(p0, p1, al, l_reg, pa0, pa1, pa2, pa3); SBAR();
            pv_tile<0, false>(o, vb0 + buf * SHM_V, pa0, pa1, pa2, pa3, true);
        }
        if (t + 1 < NT) { asm volatile("s_waitcnt vmcnt(0)" ::: "memory"); FB_WRITE(buf ^ 1); }
        __syncthreads();
    }
    if (hi == 0) li_l[r32] = l_reg; asm volatile("s_waitcnt lgkmcnt(0)" ::: "memory");
    float rli[16];
#pragma unroll
    for (int r = 0; r < 16; ++r) rli[r] = __builtin_amdgcn_rcpf(li_l[crow(r, hi)]);
    TOut* Ow = cur.O + (size_t)(wid * QBLK) * OPITCH;
#pragma unroll
    for (int r = 0; r < 16; ++r) { const int orow = crow(r, hi);
#pragma unroll
        for (int d0 = 0; d0 < 4; ++d0) { const float v = o[d0][r] * rli[r]; const float vn = __shfl_xor(v, 1);
            if ((r32 & 1) == 0) *(unsigned*)(Ow + (size_t)orow * OPITCH + d0 * 32 + r32) = cvtpk(v, vn); } }
    __syncthreads();
#undef FB_LOAD
#undef FB_WRITE
}
}
namespace hg {
#define HG_LAS __attribute__((address_space(3)))
typedef short bf16x8 __attribute__((ext_vector_type(8)));
typedef short s16x4 __attribute__((ext_vector_type(4)));
typedef float f32x4 __attribute__((ext_vector_type(4)));
typedef unsigned u32x4 __attribute__((ext_vector_type(4)));
constexpr int RB = 272;
constexpr int PL = 0, KT = 64 * RB, KH = 2 * 64 * RB, VL = 3 * 64 * RB, A1 = 4 * 64 * RB, A1RB = 144, SK = A1 + 64 * A1RB, SC = SK + 128 * RB, B63 = SC + 8 * 128 * 4, DK = B63 + 512, HG_END = DK + 512;
constexpr int OL = 0, ORB = 132 * 4;
static_assert(64 * ORB <= 2 * 64 * RB && HG_END + 1024 <= 131072, "hgrn LDS map");
typedef float f32x2_t __attribute__((ext_vector_type(2))); typedef __bf16 bf16x2_t __attribute__((ext_vector_type(2)));
__device__ __forceinline__ unsigned cvtpk(float lo, float hi) { f32x2_t v = {lo, hi}; bf16x2_t b = __builtin_convertvector(v, bf16x2_t); return __builtin_bit_cast(unsigned, b); }
__device__ __forceinline__ float bf_lo(unsigned w) { return __uint_as_float(w << 16); }
__device__ __forceinline__ float bf_hi(unsigned w) { return __uint_as_float(w & 0xffff0000u); }
__device__ __forceinline__ s16x4 vtr(const HG_LAS char* p) { typedef short v4i16_t __attribute__((ext_vector_type(4))); return __builtin_bit_cast(s16x4, __builtin_amdgcn_ds_read_tr16_b64_v4i16((HG_LAS v4i16_t*)p)); }
__device__ __forceinline__ bf16x8 tr2(const HG_LAS char* base, int row0, int col0, int lane) {
    const int i = lane & 15, kq = lane >> 4; const HG_LAS char* p = base + (row0 + 8 * kq + (i >> 2)) * RB + (col0 + 4 * (i & 3)) * 2;
    const s16x4 lo = vtr(p), hi = vtr(p + 4 * RB); return (bf16x8){lo[0], lo[1], lo[2], lo[3], hi[0], hi[1], hi[2], hi[3]};
}
__device__ __forceinline__ bf16x8 rd8(const HG_LAS char* base, int pitch, int row0, int col0, int lane) { return *(const HG_LAS bf16x8*)(base + (row0 + (lane & 15)) * pitch + (col0 + 8 * (lane >> 4)) * 2); }
#define HG_MFMA(a, b, c) __builtin_amdgcn_mfma_f32_16x16x32_bf16(a, b, c, 0, 0, 0)

struct SegArgs { const unsigned short* qb; const unsigned short* fb; const unsigned short* ib; const unsigned short* gb; unsigned short* out; const HG_LAS float* lb; const HG_LAS float* ghn; int c_begin, c_end; };
constexpr int WARM = 8;
constexpr int DSUM = HG_END, FLG = DSUM + 512, HG_END2 = FLG + 64;
__device__ __forceinline__ void hgrn_segment(HG_LAS char* lds, const SegArgs a, const int wave_s) {
    int lane_; asm volatile("v_mbcnt_lo_u32_b32 %0, -1, 0\n\tv_mbcnt_hi_u32_b32 %0, -1, %0" : "=v"(lane_));
    const int tid = wave_s * 64 + lane_, wid = wave_s;
    const int kc = tid & 15, tg = tid >> 4;
    constexpr float LOG2E = 1.4426950408889634f, LN2 = 0.6931471805599453f;
    float lbv[8];
#pragma unroll
    for (int e = 0; e < 8; ++e) lbv[e] = a.lb[8 * kc + e];
    const size_t eoff = (size_t)(2 * tg) * 128 + 8 * kc;
    const int tb = wid >> 1;
    int w0 = a.c_begin - WARM; if (w0 < 0) w0 = 0;
    for (;;) {
    f32x4 sT[8];
#pragma unroll
    for (int kb = 0; kb < 8; ++kb) sT[kb] = (f32x4){0.f, 0.f, 0.f, 0.f};
    for (int i = tid; i < 128 * RB / 16; i += 512) *(HG_LAS u32x4*)(lds + SK + i * 16) = (u32x4){0u, 0u, 0u, 0u};
    if (tid < 128) ((HG_LAS float*)(lds + DSUM))[tid] = 0.f;
    u32x4 zr[2], qr[2], vr[2];
#pragma unroll
    for (int r = 0; r < 2; ++r) { const size_t o_ = eoff + (size_t)w0 * 64 * 128 + r * 128; zr[r] = *(const u32x4*)(a.fb + o_); qr[r] = *(const u32x4*)(a.qb + o_); vr[r] = *(const u32x4*)(a.ib + o_); }
    __syncthreads();
    bool redo = false;
    for (int c = w0; c < a.c_end; ++c) {
        const bool warm = c < a.c_begin;
        float g0[8], tot[8], inc[8];
#pragma unroll
        for (int e = 0; e < 8; ++e) { const float omlb = 1.f - lbv[e];
            const unsigned w0_ = zr[0][e >> 1], w1_ = zr[1][e >> 1]; const float z0 = (e & 1) ? bf_hi(w0_) : bf_lo(w0_), z1 = (e & 1) ? bf_hi(w1_) : bf_lo(w1_);
            const float s0 = __builtin_amdgcn_rcpf(1.f + __builtin_amdgcn_exp2f(-z0 * LOG2E)), s1 = __builtin_amdgcn_rcpf(1.f + __builtin_amdgcn_exp2f(-z1 * LOG2E));
            g0[e] = __builtin_amdgcn_logf(lbv[e] + omlb * s0) * LN2; tot[e] = g0[e] + __builtin_amdgcn_logf(lbv[e] + omlb * s1) * LN2; inc[e] = tot[e]; }
#pragma unroll
        for (int e = 0; e < 8; ++e) { float y = __shfl_up(inc[e], 16); if (lane_ >= 16) inc[e] += y; y = __shfl_up(inc[e], 32); if (lane_ >= 32) inc[e] += y; }
        if (lane_ >= 48) {
#pragma unroll
            for (int e = 0; e < 8; ++e) ((HG_LAS float*)(lds + SC))[wid * 128 + 8 * kc + e] = inc[e]; }
        __syncthreads();
        float b63[8];
#pragma unroll
        for (int e = 0; e < 8; ++e) { float off = 0.f, all = 0.f;
#pragma unroll
            for (int w = 0; w < 8; ++w) { const float s = ((const HG_LAS float*)(lds + SC))[w * 128 + 8 * kc + e]; all += s; if (w < wid) off += s; }
            inc[e] = off + inc[e] - tot[e]; b63[e] = all * LOG2E; }
        if (tg == 0) {
#pragma unroll
            for (int e = 0; e < 8; ++e) { ((HG_LAS float*)(lds + DK))[8 * kc + e] = __builtin_amdgcn_exp2f(b63[e]); if (warm) ((HG_LAS float*)(lds + DSUM))[8 * kc + e] += b63[e]; } }
#pragma unroll
        for (int r = 0; r < 2; ++r) { float kh[8];
            const int ro = (2 * tg + r) * RB + 16 * kc;
            if (!warm) { float pv[8], kt[8];
#pragma unroll
                for (int e = 0; e < 8; ++e) {
                    const float km = 1.f - __builtin_amdgcn_exp2f((r ? tot[e] - g0[e] : g0[e]) * LOG2E);
                    const unsigned w = qr[r][e >> 1]; const float q = (e & 1) ? bf_hi(w) : bf_lo(w);
                    const float sq = q * __builtin_amdgcn_rcpf(1.f + __builtin_amdgcn_exp2f(-q * LOG2E)); const float bl = (inc[e] + (r ? tot[e] : g0[e])) * LOG2E;
                    pv[e] = sq * __builtin_amdgcn_exp2f(bl); kt[e] = km * __builtin_amdgcn_exp2f(-bl); kh[e] = km * __builtin_amdgcn_exp2f(b63[e] - bl); }
                *(HG_LAS u32x4*)(lds + PL + ro) = (u32x4){cvtpk(pv[0], pv[1]), cvtpk(pv[2], pv[3]), cvtpk(pv[4], pv[5]), cvtpk(pv[6], pv[7])};
                *(HG_LAS u32x4*)(lds + KT + ro) = (u32x4){cvtpk(kt[0], kt[1]), cvtpk(kt[2], kt[3]), cvtpk(kt[4], kt[5]), cvtpk(kt[6], kt[7])};
            } else {
#pragma unroll
                for (int e = 0; e < 8; ++e) { const float km = 1.f - __builtin_amdgcn_exp2f((r ? tot[e] - g0[e] : g0[e]) * LOG2E);
                    const float bl = (inc[e] + (r ? tot[e] : g0[e])) * LOG2E; kh[e] = km * __builtin_amdgcn_exp2f(b63[e] - bl); }
            }
            *(HG_LAS u32x4*)(lds + KH + ro) = (u32x4){cvtpk(kh[0], kh[1]), cvtpk(kh[2], kh[3]), cvtpk(kh[4], kh[5]), cvtpk(kh[6], kh[7])};
            *(HG_LAS u32x4*)(lds + VL + ro) = vr[r]; }
        if (c + 1 < a.c_end) { const size_t no = eoff + (size_t)(c + 1) * 64 * 128;
#pragma unroll
            for (int r = 0; r < 2; ++r) { zr[r] = *(const u32x4*)(a.fb + no + r * 128); qr[r] = *(const u32x4*)(a.qb + no + r * 128); vr[r] = *(const u32x4*)(a.ib + no + r * 128); } }
        __syncthreads();
        u32x4 gcur[2];
        if (!warm) {
#pragma unroll
            for (int r = 0; r < 2; ++r) gcur[r] = *(const u32x4*)(a.gb + eoff + (size_t)c * 64 * 128 + r * 128); }
        int lane = lane_; asm volatile("" : "+v"(lane));
        const int q4 = lane >> 4, n16 = lane & 15;
        if (!warm) {
        { const int sb0 = 2 * (wid & 1); f32x4 c0 = {0.f, 0.f, 0.f, 0.f}, c1 = {0.f, 0.f, 0.f, 0.f};
          if (sb0 <= tb) {
#pragma unroll
            for (int ks = 0; ks < 4; ++ks) { const bf16x8 af = rd8(lds + PL, RB, 16 * tb, 32 * ks, lane);
                c0 = HG_MFMA(af, rd8(lds + KT, RB, 16 * sb0, 32 * ks, lane), c0); c1 = HG_MFMA(af, rd8(lds + KT, RB, 16 * sb0 + 16, 32 * ks, lane), c1); } }
#pragma unroll
          for (int r = 0; r < 4; ++r) { const int t = 16 * tb + 4 * q4 + r, s0 = 16 * sb0 + n16, s1 = s0 + 16;
              const float x0 = (s0 <= t) ? c0[r] : 0.f, x1 = (s1 <= t) ? c1[r] : 0.f;
              *(HG_LAS unsigned short*)(lds + A1 + t * A1RB + s0 * 2) = (unsigned short)(cvtpk(x0, 0.f) & 0xffffu);
              *(HG_LAS unsigned short*)(lds + A1 + t * A1RB + s1 * 2) = (unsigned short)(cvtpk(x1, 0.f) & 0xffffu); } }
        __syncthreads();
        f32x4 oc[4];
#pragma unroll
        for (int j = 0; j < 4; ++j) oc[j] = (f32x4){0.f, 0.f, 0.f, 0.f};
        { const int vb0 = 4 * (wid & 1);
#pragma unroll
          for (int ks = 0; ks < 4; ++ks) { const bf16x8 af = rd8(lds + PL, RB, 16 * tb, 32 * ks, lane);
#pragma unroll
              for (int j = 0; j < 4; ++j) oc[j] = HG_MFMA(af, tr2(lds + SK, 32 * ks, 16 * (vb0 + j), lane), oc[j]); }
#pragma unroll
          for (int ks = 0; ks < 2; ++ks) { const bf16x8 af = rd8(lds + A1, A1RB, 16 * tb, 32 * ks, lane);
#pragma unroll
              for (int j = 0; j < 4; ++j) oc[j] = HG_MFMA(af, tr2(lds + VL, 32 * ks, 16 * (vb0 + j), lane), oc[j]); } }
        __syncthreads();
        { const int vb0 = 4 * (wid & 1);
#pragma unroll
          for (int j = 0; j < 4; ++j)
#pragma unroll
              for (int r = 0; r < 4; ++r) *(HG_LAS float*)(lds + OL + (16 * tb + 4 * q4 + r) * ORB + (16 * (vb0 + j) + n16) * 4) = oc[j][r]; }
        }
#pragma unroll
        for (int kb = 0; kb < 8; ++kb) { const float d = ((const HG_LAS float*)(lds + DK))[16 * kb + n16]; sT[kb] = sT[kb] * d; }
#pragma unroll
        for (int ks = 0; ks < 2; ++ks) { const bf16x8 af = tr2(lds + VL, 32 * ks, 16 * wid, lane);
#pragma unroll
            for (int kb = 0; kb < 8; ++kb) sT[kb] = HG_MFMA(af, tr2(lds + KH, 32 * ks, 16 * kb, lane), sT[kb]); }
#pragma unroll
        for (int kb = 0; kb < 8; ++kb) { typedef unsigned u32x2 __attribute__((ext_vector_type(2)));
            *(HG_LAS u32x2*)(lds + SK + (16 * kb + n16) * RB + (16 * wid + 4 * q4) * 2) = (u32x2){cvtpk(sT[kb][0], sT[kb][1]), cvtpk(sT[kb][2], sT[kb][3])}; }
        if (!warm) {
        __syncthreads();
#pragma unroll
        for (int r = 0; r < 2; ++r) { const int t = 2 * tg + r;
            const f32x4 o0 = *(const HG_LAS f32x4*)(lds + OL + t * ORB + 32 * kc), o1 = *(const HG_LAS f32x4*)(lds + OL + t * ORB + 32 * kc + 16);
            float ss = ((o0[0] * o0[0] + o0[1] * o0[1]) + (o0[2] * o0[2] + o0[3] * o0[3])) + ((o1[0] * o1[0] + o1[1] * o1[1]) + (o1[2] * o1[2] + o1[3] * o1[3]));
            ss += __shfl_xor(ss, 1); ss += __shfl_xor(ss, 2); ss += __shfl_xor(ss, 4); ss += __shfl_xor(ss, 8);
            const float rstd = 1.f / sqrtf(ss * (1.f / 128.f) + 1e-6f);
            float y[8], ghv[8]; { const f32x4 ga = *(const HG_LAS f32x4*)(a.ghn + 8 * kc), gb_ = *(const HG_LAS f32x4*)(a.ghn + 8 * kc + 4); ghv[0] = ga[0]; ghv[1] = ga[1]; ghv[2] = ga[2]; ghv[3] = ga[3]; ghv[4] = gb_[0]; ghv[5] = gb_[1]; ghv[6] = gb_[2]; ghv[7] = gb_[3]; }
#pragma unroll
            for (int e = 0; e < 8; ++e) { const unsigned w = gcur[r][e >> 1]; const float gt = (e & 1) ? bf_hi(w) : bf_lo(w);
                const float sgt = gt * __builtin_amdgcn_rcpf(1.f + __builtin_amdgcn_exp2f(-gt * LOG2E)); const float o = (e < 4) ? o0[e & 3] : o1[e & 3];
                y[e] = (o * rstd * ghv[e]) * sgt; }
            *(u32x4*)(a.out + ((size_t)c * 64 + t) * 4096 + 8 * kc) = (u32x4){cvtpk(y[0], y[1]), cvtpk(y[2], y[3]), cvtpk(y[4], y[5]), cvtpk(y[6], y[7])}; }
        } else if (c + 1 == a.c_begin && w0 > 0) {
            __syncthreads();
            bool ok = true;
#pragma unroll
            for (int e = 0; e < 8; ++e) ok = ok && (((const HG_LAS float*)(lds + DSUM))[8 * kc + e] < -104.f * LOG2E);
            const bool wok = __all(ok);
            if (lane == 0) ((HG_LAS unsigned*)(lds + FLG))[wid] = wok ? 1u : 0u;
            __syncthreads();
            unsigned allok = 1u;
#pragma unroll
            for (int w = 0; w < 8; ++w) allok &= ((const HG_LAS unsigned*)(lds + FLG))[w];
#if !defined(PROBE_NOCHECK)
            if (!allok) { redo = true; break; }
#else
            (void)allok;
#endif
        }
    }
    if (!redo) break;
    __syncthreads();
    w0 -= WARM; if (w0 < 0) w0 = 0;
    }
    __syncthreads();
}
#undef HG_MFMA
}
#define GAS __attribute__((address_space(1)))
#define LAS __attribute__((address_space(3)))
typedef unsigned short bf16;
typedef unsigned v4u __attribute__((ext_vector_type(4)));
typedef float f32x4 __attribute__((ext_vector_type(4)));
typedef short bf16x8 __attribute__((ext_vector_type(8)));
typedef GAS unsigned gu32;
typedef GAS unsigned long long gu64;
#define RLX_AGENT __ATOMIC_RELAXED, __HIP_MEMORY_SCOPE_AGENT
#define LDS_WAIT() asm volatile("s_waitcnt lgkmcnt(0)" ::: "memory")
#define VM_WAIT() asm volatile("s_waitcnt vmcnt(0)" ::: "memory")
__device__ __forceinline__ unsigned long long rt() { return __builtin_amdgcn_s_memrealtime(); }
__device__ __forceinline__ unsigned f2bf(float f) { unsigned u = __builtin_bit_cast(unsigned, f); return (u + 0x7fffu + ((u >> 16) & 1u)) >> 16; }
__device__ __forceinline__ unsigned pk2(float lo, float hi) { typedef float f2_ __attribute__((ext_vector_type(2))); typedef __bf16 b2_ __attribute__((ext_vector_type(2))); const f2_ v = {lo, hi}; return __builtin_bit_cast(unsigned, __builtin_convertvector(v, b2_)); }

#define XB_TMO      128
#define XB_XCNT(j)  (256  + 64 * (j))
#define XB_XSUB(j)  (1280 + 64 * (j))
#define XB_XGEN(j)  (2304 + 64 * (j))
#define XB_TOP      3328
#define XB_TOPGEN   3392
#define XCD_BAR_WORDS 3456
#define XB_SPIN_CAP (1u << 18)

__device__ __forceinline__ unsigned xb_ld(unsigned* p)              { return __hip_atomic_load(p, __ATOMIC_RELAXED, __HIP_MEMORY_SCOPE_AGENT); }
__device__ __forceinline__ unsigned xb_add(unsigned* p, unsigned v) { return __hip_atomic_fetch_add(p, v, __ATOMIC_RELAXED, __HIP_MEMORY_SCOPE_AGENT); }
__device__ __forceinline__ unsigned xb_xcc_id() { return (unsigned)__builtin_amdgcn_s_getreg((3 << 11) | 20) & 0xFu; }
#define XB_SPIN(cond, bar) do { unsigned _sp = 0; while (cond) { __builtin_amdgcn_s_sleep(1); \
    if ((++_sp & 255u) == 0u) { if (xb_ld(&(bar)[XB_TMO])) break; if (_sp > XB_SPIN_CAP) { atomicAdd(&(bar)[XB_TMO], 1u); break; } } } } while (0)

__device__ __forceinline__ int lane_now() { int l; asm volatile("v_mbcnt_lo_u32_b32 %0, -1, 0\n\tv_mbcnt_hi_u32_b32 %0, -1, %0" : "=v"(l)); return l; }
struct XcdBarrier {
    unsigned* bar; unsigned x; int w0;
    volatile LAS unsigned* st;
};

__device__ __forceinline__ XcdBarrier xcd_barrier_post(unsigned* bar, volatile LAS unsigned* st) {
    XcdBarrier b; b.bar = bar; b.x = xb_xcc_id(); b.st = st; b.w0 = __builtin_amdgcn_readfirstlane((int)threadIdx.x >> 6);
    if (threadIdx.x == 0) (void)xb_add(&bar[XB_XCNT(b.x)], 1u);
    return b;
}
__device__ __forceinline__ void xcd_barrier_complete(unsigned* bar, unsigned x, unsigned& nloc, unsigned& nx) {
    const unsigned G = gridDim.x * gridDim.y * gridDim.z;
    unsigned sum, cnt, mine, sp = 0u;
    for (;;) {
        sum = 0u; cnt = 0u; mine = 0u;
#pragma unroll
        for (unsigned j = 0; j < 16; ++j) { const unsigned c = xb_ld(&bar[XB_XCNT(j)]); sum += c; cnt += (c > 0u) ? 1u : 0u; mine = (j == x) ? c : mine; }
        if (sum == G) break;
        __builtin_amdgcn_s_sleep(1);
        if ((++sp & 255u) == 0u) { if (xb_ld(&bar[XB_TMO])) break; if (sp > XB_SPIN_CAP) { atomicAdd(&bar[XB_TMO], 1u); break; } }
    }
    nloc = mine > 0u ? mine : 1u; nx = cnt > 0u ? cnt : 1u;
}

__device__ __forceinline__ void xcd_barrier(const XcdBarrier& b) {
    asm volatile("s_waitcnt vmcnt(0)" ::: "memory");
    __syncthreads();
    if (b.w0 == 0 && lane_now() == 0) {
        unsigned* bar = b.bar;
        __builtin_amdgcn_s_waitcnt(0);
        unsigned nloc = b.st[0], nx = b.st[1];
        if (nloc == 0u) { xcd_barrier_complete(bar, b.x, nloc, nx); b.st[0] = nloc; b.st[1] = nx; }
        const unsigned old = xb_add(&bar[XB_XSUB(b.x)], 1u);
        const unsigned gen = old / nloc;
        if (old + 1u == (gen + 1u) * nloc) {
            __builtin_amdgcn_fence(__ATOMIC_RELEASE, "agent");
            asm volatile("s_waitcnt vmcnt(0)" ::: "memory");
            const unsigned og = xb_add(&bar[XB_TOP], 1u);
            const unsigned tg = og / nx;
            if (og + 1u == (tg + 1u) * nx) xb_add(&bar[XB_TOPGEN], 1u);
            else XB_SPIN(xb_ld(&bar[XB_TOPGEN]) == tg, bar);
            __builtin_amdgcn_fence(__ATOMIC_ACQUIRE, "agent");
            xb_add(&bar[XB_XGEN(b.x)], 1u);
            asm volatile("s_waitcnt vmcnt(0)" ::: "memory");
        } else {
            XB_SPIN(xb_ld(&bar[XB_XGEN(b.x)]) == gen, bar);
            __builtin_amdgcn_fence(__ATOMIC_ACQUIRE, "agent");
            asm volatile("s_waitcnt vmcnt(0)" ::: "memory");
        }
    }
    __syncthreads();
}
__device__ __forceinline__ void group_sync(const XcdBarrier& b, unsigned* cnt, unsigned n) {
    asm volatile("s_waitcnt vmcnt(0)" ::: "memory");
    __syncthreads();
    if (b.w0 == 0 && lane_now() == 0) {
        __builtin_amdgcn_s_waitcnt(0);
        __builtin_amdgcn_fence(__ATOMIC_RELEASE, "agent");
        asm volatile("s_waitcnt vmcnt(0)" ::: "memory");
        (void)xb_add(cnt, 1u);
        XB_SPIN(xb_ld(cnt) < n, b.bar);
        __builtin_amdgcn_fence(__ATOMIC_ACQUIRE, "agent");
        asm volatile("s_waitcnt vmcnt(0)" ::: "memory");
    }
    __syncthreads();
}
typedef unsigned short u16;
constexpr int NWAVES = 8;
constexpr int BATCH = 2, SEQ = 8192, DM = 4096, NH = 16, HD = 128, DFF = 16384, PLE = 256;
constexpr int M = BATCH * SEQ;
constexpr int NIN = 14352, NPROJ = 14336, FA_COL = 6144;
constexpr float RMS_EPS = 1e-6f;
constexpr size_t MiB = 1u << 20;
constexpr size_t WS_CTL = 0, CTL_ZERO_BYTES = 65536;
constexpr size_t WS_WFA = 1 * MiB;
constexpr size_t WS_LS = 2 * MiB;
constexpr size_t WS_BS = 3 * MiB;
constexpr size_t WS_PQK = 4 * MiB;
constexpr size_t WS_P1 = 12 * MiB, WS_P2 = 16 * MiB, WS_PE = 20 * MiB;
constexpr size_t WS_WGATE = 24 * MiB, WS_WDOWN = 40 * MiB, WS_WUP = 168 * MiB, WS_WOUT = 296 * MiB, WS_WPLE = 328 * MiB;
constexpr size_t WS_PB = 330 * MiB;
constexpr size_t WS_ACTA = 338 * MiB;
constexpr size_t WS_WIN = 466 * MiB;
constexpr size_t WS_PROJ = 578 * MiB;
constexpr size_t WS_H1B = 808 * MiB;
constexpr size_t WS_HID = 296 * MiB;
constexpr size_t WS_ERAW = 936 * MiB;
constexpr size_t WS_H2F8 = 1064 * MiB;
constexpr size_t WS_RS0 = 12 * MiB;
constexpr size_t WS_IDB = 1128 * MiB;
constexpr size_t WS_END = 1130 * MiB;
constexpr size_t PROJ_T = (size_t)2 * 16 * 8192 * 128;
constexpr int CW_TMO = 0, CW_BAR = 4096, CW_GRP = 8192;
static_assert(CW_BAR + XCD_BAR_WORDS <= CW_GRP && (CW_GRP + 2 * 64 * 64) * 4 <= (int)CTL_ZERO_BYTES, "control words");
constexpr int LDS_BYTES = 163840;
constexpr int RING_OFF = 0;
constexpr int TAB_OFF = 160768, TAB_RS = TAB_OFF, TAB_RSE = TAB_OFF + 1024;
constexpr int MISC_OFF = 162816;
static_assert(fa::FA_LDS_END <= TAB_OFF && hg::HG_END2 + 1024 <= TAB_OFF, "LDS map");

struct Frame {
    LAS unsigned char* lds; volatile LAS unsigned* MISC; gu32* ctl;
    int tid, lane, wave, vcu, G;
};
__device__ __forceinline__ float wave_sum(float v) {
#pragma unroll
    for (int o = 1; o < 64; o <<= 1) v += __shfl_xor(v, o);
    return v;
}
struct TItem { const float* W; const float* g; unsigned char* WT; int ldw, K, k0, src0, dst0; float scale; int fp8; };
__device__ __forceinline__ void p0_item_load(const TItem& t, float (&wv)[32], int lane) {
#pragma unroll
    for (int i = 0; i < 32; ++i) wv[i] = t.W[(size_t)(t.k0 + 2 * i + (lane >> 5)) * t.ldw + t.src0 + (lane & 31)];
}
__device__ __forceinline__ unsigned pk4_fp8(float a, float b, float c, float d) { int p = __builtin_amdgcn_cvt_pk_fp8_f32(a, b, 0, false); p = __builtin_amdgcn_cvt_pk_fp8_f32(c, d, p, true); return (unsigned)p; }
__device__ __forceinline__ void p0_item_finish(const TItem& t, const float (&wv)[32], LAS float* scr, int lane) {
#pragma unroll
    for (int i = 0; i < 32; ++i) { const int kk = 2 * i + (lane >> 5); float w = wv[i] * t.scale; if (t.g) w *= t.g[t.k0 + kk]; scr[kk * 33 + (lane & 31)] = w; }
    LDS_WAIT(); asm volatile("" ::: "memory");
    const int c = lane & 7;
    if (t.fp8) {
#pragma unroll
        for (int j = 0; j < 4; ++j) { const int n = (lane >> 3) + 8 * j; const LAS float* s = scr + (8 * c) * 33 + n;
            typedef unsigned u32x2_ __attribute__((ext_vector_type(2)));
            u32x2_ o; o.x = pk4_fp8(s[0 * 33], s[1 * 33], s[2 * 33], s[3 * 33]); o.y = pk4_fp8(s[4 * 33], s[5 * 33], s[6 * 33], s[7 * 33]);
            *(GAS u32x2_*)(t.WT + (size_t)(t.dst0 + n) * t.K + t.k0 + 8 * c) = o; }
    } else {
#pragma unroll
        for (int j = 0; j < 4; ++j) { const int n = (lane >> 3) + 8 * j; const LAS float* s = scr + (8 * c) * 33 + n;
            v4u o; o.x = pk2(s[0 * 33], s[1 * 33]); o.y = pk2(s[2 * 33], s[3 * 33]); o.z = pk2(s[4 * 33], s[5 * 33]); o.w = pk2(s[6 * 33], s[7 * 33]);
            *(GAS v4u*)((u16*)t.WT + (size_t)(t.dst0 + n) * t.K + t.k0 + 8 * c) = o; }
    }
    LDS_WAIT(); asm volatile("" ::: "memory");
}
constexpr float GATE_WSCALE = 64.f;
struct Args { const float* in[17]; float* out; unsigned char* ws; };
typedef const __attribute__((address_space(4))) Args KArgs;
__device__ __forceinline__ KArgs* karg_ptr() { KArgs* kp = (KArgs*)__builtin_amdgcn_kernarg_segment_ptr(); asm volatile("" : "+s"(kp)); return kp; }

__device__ __forceinline__ void p0_prologue(Frame& F) {
    KArgs& A = *karg_ptr(); unsigned char* ws = A.ws;
    LAS float* scr = (LAS float*)(F.lds + RING_OFF + F.wave * 16384);
    const int gw = F.vcu * NWAVES + F.wave, NGW = F.G * NWAVES;
    constexpr int I_IN = (DM / 64) * (NPROJ / 32), I_OUT = (DM / 64) * (DM / 32), I_UP = (DM / 64) * (DFF / 32), I_DN = (DFF / 64) * (DM / 32), I_GT = I_OUT, I_PL = (PLE / 64) * (DM / 32);
    constexpr int NITEMS = I_IN + I_OUT + I_UP + I_DN + I_GT + I_PL;
    auto decode = [&](int r) { TItem t; t.scale = 1.f; t.fp8 = 0; t.g = nullptr;
        if (r < I_IN) { const int nblk = NPROJ / 32, kb = r / nblk, n0 = 32 * (r % nblk); t.W = A.in[3]; t.ldw = NIN; t.K = DM; t.g = A.in[2]; t.WT = ws + WS_WIN; t.k0 = 64 * kb; t.src0 = n0 + (n0 >= FA_COL ? 16 : 0); t.dst0 = n0; return t; } r -= I_IN;
        if (r < I_OUT) { const int nblk = DM / 32; t.W = A.in[9]; t.ldw = DM; t.K = DM; t.WT = ws + WS_WOUT; t.k0 = 64 * (r / nblk); t.src0 = t.dst0 = 32 * (r % nblk); return t; } r -= I_OUT;
        if (r < I_UP) { const int nblk = DFF / 32; t.W = A.in[11]; t.ldw = DFF; t.K = DM; t.g = A.in[10]; t.WT = ws + WS_WUP; t.k0 = 64 * (r / nblk); t.src0 = t.dst0 = 32 * (r % nblk); return t; } r -= I_UP;
        if (r < I_DN) { const int nblk = DM / 32; t.W = A.in[12]; t.ldw = DM; t.K = DFF; t.WT = ws + WS_WDOWN; t.k0 = 64 * (r / nblk); t.src0 = t.dst0 = 32 * (r % nblk); return t; } r -= I_DN;
        if (r < I_GT) { const int nblk = DM / 32; t.W = A.in[14]; t.ldw = DM; t.K = DM; t.g = A.in[13]; t.scale = GATE_WSCALE; t.fp8 = 1; t.WT = ws + WS_WGATE; t.k0 = 64 * (r / nblk); t.src0 = t.dst0 = 32 * (r % nblk); return t; } r -= I_GT;
        { const int nblk = DM / 32; t.W = A.in[15]; t.ldw = DM; t.K = PLE; t.WT = ws + WS_WPLE; t.k0 = 64 * (r / nblk); t.src0 = t.dst0 = 32 * (r % nblk); return t; } };
    if (gw < NITEMS) {
        float wa[32], wb[32]; int it = gw; TItem ta = decode(it), tb = ta; p0_item_load(ta, wa, F.lane);
        for (;;) {
            const bool hb = it + NGW < NITEMS; if (hb) { tb = decode(it + NGW); p0_item_load(tb, wb, F.lane); }
            p0_item_finish(ta, wa, scr, F.lane); if (!hb) break;
            const bool ha = it + 2 * NGW < NITEMS; if (ha) { ta = decode(it + 2 * NGW); p0_item_load(ta, wa, F.lane); }
            p0_item_finish(tb, wb, scr, F.lane); if (!ha) break;
            it += 2 * NGW; }
    }
    { const int gt = F.vcu * 512 + F.tid, NT = F.G * 512;
      for (int i = gt; i < 16 * DM; i += NT) { const int n = i >> 12, k = i & 4095; ((u16*)(ws + WS_WFA))[i] = (u16)f2bf(A.in[3][(size_t)k * NIN + FA_COL + n] * A.in[2][k]); }
      for (int i = gt; i < 256 * 256; i += NT) ((u16*)(ws + WS_IDB))[(size_t)(i >> 8) * DM + (i & 255)] = ((i >> 8) == (i & 255)) ? (u16)0x3F80u : (u16)0u;
      const f32x4* p4 = (const f32x4*)A.in[1]; unsigned long long* pb = (unsigned long long*)(ws + WS_PB);
      for (int i = gt; i < M * PLE / 4; i += NT) { const f32x4 v = p4[i]; pb[i] = (unsigned long long)pk2(v.x, v.y) | ((unsigned long long)pk2(v.z, v.w) << 32); } }
    { float* RS0 = (float*)(ws + WS_RS0);
      auto xload = [&](f32x4 (&v)[16], int m) { const f32x4* xr = (const f32x4*)(A.in[0] + (size_t)m * DM);
#pragma unroll
          for (int j = 0; j < 8; ++j) { v[2 * j] = xr[128 * j + 2 * F.lane]; v[2 * j + 1] = xr[128 * j + 2 * F.lane + 1]; } };
      auto xrow = [&](const f32x4 (&v)[16], int m) { float s = 0.f;
          v4u* xo = (v4u*)((u16*)A.out + (size_t)m * DM);
#pragma unroll
          for (int j = 0; j < 8; ++j) { v4u xw; xw.x = pk2(v[2 * j].x, v[2 * j].y); xw.y = pk2(v[2 * j].z, v[2 * j].w); xw.z = pk2(v[2 * j + 1].x, v[2 * j + 1].y); xw.w = pk2(v[2 * j + 1].z, v[2 * j + 1].w); xo[64 * j + F.lane] = xw; }
#pragma unroll
          for (int j = 0; j < 16; ++j) s += (v[j].x * v[j].x + v[j].y * v[j].y) + (v[j].z * v[j].z + v[j].w * v[j].w);
          const float rstd = 1.f / sqrtf(wave_sum(s) * (1.f / DM) + RMS_EPS);
          if (F.lane == 0) RS0[m] = rstd; };
      if (gw < M) {
          f32x4 va[16], vb[16]; int m = gw; xload(va, m);
          for (;;) {
              const bool hb = m + NGW < M; if (hb) xload(vb, m + NGW);
              xrow(va, m); if (!hb) break;
              const bool ha = m + 2 * NGW < M; if (ha) xload(va, m + 2 * NGW);
              xrow(vb, m + NGW); if (!ha) break;
              m += 2 * NGW; } } }
}
__device__ __forceinline__ void fa_tile(Frame& F, int tile) {
    KArgs& A = *karg_ptr(); unsigned char* ws = A.ws; const u16* U = (const u16*)A.out; const u16* WF = (const u16*)(ws + WS_WFA);
    const int R0 = tile * 64, b = R0 >> 13, t0 = R0 & 8191, rb = F.wave & 3, kh = F.wave >> 2, n16 = F.lane & 15, q4 = F.lane >> 4;
    f32x4 acc = {0.f, 0.f, 0.f, 0.f};
    const u16* ap = U + (size_t)(R0 + 16 * rb + n16) * DM + kh * 2048 + 8 * q4; const u16* bp = WF + (size_t)n16 * DM + kh * 2048 + 8 * q4;
#pragma unroll 16
    for (int s = 0; s < 64; ++s) acc = __builtin_amdgcn_mfma_f32_16x16x32_bf16(*(const bf16x8*)(ap + 32 * s), *(const bf16x8*)(bp + 32 * s), acc, 0, 0, 0);
    LAS float* red = (LAS float*)(F.lds + RING_OFF);
    LAS float* bsum = (LAS float*)(F.lds + RING_OFF + 4096);
    if (kh == 1) *(LAS f32x4*)(red + (rb * 64 + F.lane) * 4) = acc;
    __syncthreads();
    if (kh == 0) { const f32x4 o = *(const LAS f32x4*)(red + (rb * 64 + F.lane) * 4); const float bias = A.in[4][n16]; float ts = 0.f;
        const f32x4 rs = *(const f32x4*)((const float*)(ws + WS_RS0) + R0 + 16 * rb + 4 * q4);
        float* LS = (float*)(ws + WS_LS) + (size_t)(b * 16 + n16) * 8192 + t0 + 16 * rb + 4 * q4;
        f32x4 l;
#pragma unroll
        for (int r = 0; r < 4; ++r) { const float v = (acc[r] + o[r]) * rs[r] + bias; l[r] = fminf(v, 0.f) - __builtin_amdgcn_logf(1.f + __builtin_amdgcn_exp2f(-fabsf(v) * 1.4426950408889634f)) * 0.6931471805599453f; ts += l[r]; }
        *(f32x4*)LS = l;
        ts += __shfl_xor(ts, 16); ts += __shfl_xor(ts, 32);
        if (q4 == 0) bsum[rb * 16 + n16] = ts; }
    __syncthreads();
    if (F.tid < 16) { const float s = (bsum[F.tid] + bsum[16 + F.tid]) + (bsum[32 + F.tid] + bsum[48 + F.tid]); ((float*)(ws + WS_BS))[(b * 16 + F.tid) * 128 + (t0 >> 6)] = s; }
    __syncthreads();
}
__device__ __forceinline__ void row_table(Frame& F, const float* part, int row0, LAS float* tab) {
    if (F.tid < 256) { const f32x4* p = (const f32x4*)(part + (size_t)(row0 + F.tid) * 64); float s = 0.f;
#pragma unroll
        for (int j = 0; j < 16; ++j) { const f32x4 v = p[j]; s += (v.x + v.y) + (v.z + v.w); }
        tab[F.tid] = 1.f / sqrtf(s * (1.f / DM) + RMS_EPS); }
    __syncthreads();
}

typedef __hip_bfloat16 hbf; typedef fa::BlockRef<hbf, hbf> FoxRef;
__device__ __forceinline__ FoxRef fox_ref(int L, const u16* PJ, u16* MIX, const float* BS, const float* LS, const float* PQK, float bqk2) {
    const int bh = L >> 5, qb = L & 31, b = bh >> 4, h = bh & 15; FoxRef r;
    r.Q = (const hbf*)(PJ + 0 * PROJ_T + ((size_t)bh * 8192 + qb * 256) * 128); r.K = (const hbf*)(PJ + 1 * PROJ_T + (size_t)bh * 8192 * 128); r.V = (const hbf*)(PJ + 2 * PROJ_T + (size_t)bh * 8192 * 128);
    r.O = (hbf*)(MIX + ((size_t)b * 8192 + qb * 256) * 4096 + 128 * h); r.P0 = qb * 256;
    int jlo = qb * 4; float sacc = 0.f; while (jlo > 0 && bqk2 + sacc >= -110.f) { --jlo; sacc += BS[bh * 128 + jlo]; }
    r.jlo = jlo; r.thr2 = (110.f + bqk2) * 1.4426950408889634f; r.LS = LS + (size_t)bh * 8192; r.PK = PQK + ((size_t)(16384 + b * 8192) * 16 + h) * 4; r.PQ = PQK + ((size_t)(b * 8192) * 16 + h) * 4; return r;
}

__global__ void __launch_bounds__(NWAVES * 64, 2) fwd_kernel(Args args) {
    extern __shared__ __attribute__((aligned(16))) unsigned char lds[];
    Frame F;
    F.lds = (LAS unsigned char*)lds;
    F.MISC = (volatile LAS unsigned*)(F.lds + MISC_OFF);
#define REFRESH_TID() do { const int l_ = lane_now(); F.tid = wave0 * 64 + l_; F.lane = l_; F.wave = wave0; } while (0)
    const int wave0 = __builtin_amdgcn_readfirstlane((int)threadIdx.x >> 6);
    REFRESH_TID();
    F.G = gridDim.x; { const int bx = blockIdx.x; F.vcu = (F.G % 8 == 0) ? (bx % 8) * (F.G / 8) + bx / 8 : bx; }
    F.ctl = (gu32*)(karg_ptr()->ws + WS_CTL);
    for (int u = F.tid; u < (LDS_BYTES - MISC_OFF) / 4; u += NWAVES * 64) ((LAS unsigned*)(F.lds + MISC_OFF))[u] = 0u;
    __syncthreads();
    XcdBarrier bar = xcd_barrier_post((unsigned*)(F.ctl + CW_BAR), F.MISC + 8);
    const int G = F.G, cb = (int)blockIdx.x;

#ifndef PHM
#define PHM 0xff
#endif
#if PHM & 1
    REFRESH_TID(); p0_prologue(F);
#endif
    xcd_barrier(bar);

#if PHM & 2
    REFRESH_TID();
    for (int tile = F.vcu; tile < M / 64; tile += G) fa_tile(F, tile);
    { unsigned char* ws = karg_ptr()->ws;
      pg8::Gemm g{(const pg8::bf16_t*)karg_ptr()->out, (const pg8::bf16_t*)(ws + WS_WIN), M, NPROJ, DM, nullptr, nullptr}; pg8::StaticOrder S; S.init(M, NPROJ, G, cb);
      { pg8::Unit u0; if (S.next(0, u0) && F.tid < 256) ((LAS float*)(F.lds + TAB_RS))[F.tid] = ((const float*)(ws + WS_RS0))[u0.pm * 256 + F.tid]; __syncthreads(); }
      pg8::EpiProj E{(pg8::bf16_t*)(ws + WS_PROJ), (float*)(ws + WS_PQK), (const LAS float*)(F.lds + TAB_RS)};
      pg8::gemm_phase<pg8::EpiProj, pg8::StaticOrder, true, true>(F.lds + RING_OFF, g, S, E, wave0); }
#endif
    xcd_barrier(bar);

#if PHM & 4
    REFRESH_TID();
    {
        KArgs& args = *karg_ptr(); unsigned char* ws = args.ws;
        const u16* PJ = (const u16*)(ws + WS_PROJ); u16* MIX = (u16*)(ws + WS_ACTA);
        constexpr int HSEG = 16, NSEG = (SEQ / 64) / HSEG, NHITEM = 32 * NSEG;
#if defined(PROBE_HG)
        for (int it2 = F.vcu; it2 < 2 * NHITEM; it2 += G) { const int it = it2 % NHITEM;
#else
        for (int it = F.vcu; it < NHITEM; it += G) {
#endif
            LAS float* lbt = (LAS float*)(F.lds + hg::HG_END2);
            const int bh = it / NSEG, seg = it % NSEG, b = bh >> 4, h = bh & 15;
            if (F.tid < 128) { const float l0 = args.in[7][h * 128 + F.tid], l1 = args.in[7][2048 + h * 128 + F.tid]; const float mx = fmaxf(l0, l1), e0 = __expf(l0 - mx), e1 = __expf(l1 - mx); lbt[F.tid] = e0 / (e0 + e1); lbt[128 + F.tid] = args.in[8][F.tid]; }
            __syncthreads();
            hg::SegArgs a{PJ + 3 * PROJ_T + (size_t)bh * 8192 * 128, PJ + 4 * PROJ_T + (size_t)bh * 8192 * 128, PJ + 5 * PROJ_T + (size_t)bh * 8192 * 128, PJ + 6 * PROJ_T + (size_t)bh * 8192 * 128,
                          MIX + (size_t)b * 8192 * 4096 + 2048 + 128 * h, (const HG_LAS float*)lbt, (const HG_LAS float*)(lbt + 128), seg * HSEG, seg * HSEG + HSEG};
            hg::hgrn_segment((HG_LAS char*)F.lds, a, wave0);
        }
        {
            typedef hbf hb; typedef FoxRef Ref;
            LAS float* GGt = (LAS float*)(F.lds + fa::GG_OFF);
            if (F.tid < 128) GGt[F.tid] = args.in[5][F.tid] * args.in[6][F.tid];
            float gq = 0.f, gk = 0.f;
            for (int i = 0; i < 128; ++i) { gq = fmaxf(gq, fabsf(args.in[5][i])); gk = fmaxf(gk, fabsf(args.in[6][i])); }
            const float bqk2 = 2.f * 11.313708499f * gq * gk * 1.03f;
            __syncthreads();
            const int NITEM = 32 * 32;
            const float* BS = (const float*)(ws + WS_BS); const float* LS = (const float*)(ws + WS_LS); const float* PQK = (const float*)(ws + WS_PQK);
#if defined(PROBE_ATT)
            for (int L2 = F.vcu; L2 < 2 * NITEM; L2 += G) { const int L = L2 % NITEM; const Ref cur = fox_ref(L, PJ, MIX, BS, LS, PQK, bqk2); fa::fox_block<hb, hb>(cur, (char*)lds, wave0); }
#else
            for (int L = F.vcu; L < NITEM; L += G) { const Ref cur = fox_ref(L, PJ, MIX, BS, LS, PQK, bqk2); fa::fox_block<hb, hb>(cur, (char*)lds, wave0); }
#endif
        }
    }
#endif
    xcd_barrier(bar);

#if PHM & 8
    REFRESH_TID();
    { KArgs& args = *karg_ptr(); unsigned char* ws = args.ws;
      pg8::Gemm g{(const pg8::bf16_t*)(ws + WS_ACTA), (const pg8::bf16_t*)(ws + WS_WOUT), M, DM, DM, (const pg8::bf16_t*)args.out, (const pg8::bf16_t*)(ws + WS_IDB)}; pg8::StaticOrder S; S.init(M, DM, G, cb);
      pg8::EpiOut E{(pg8::bf16_t*)(ws + WS_H1B), (float*)(ws + WS_P1)};
      pg8::gemm_phase<pg8::EpiOut, pg8::StaticOrder, true, true, false, 4>(F.lds + RING_OFF, g, S, E, wave0); }
    { unsigned char* ws = karg_ptr()->ws;
      pg8::Gemm g{(const pg8::bf16_t*)(ws + WS_PB), (const pg8::bf16_t*)(ws + WS_WPLE), M, DM, PLE, nullptr, nullptr}; pg8::StaticOrder S; S.init(M, DM, G, cb);
      pg8::EpiE E{(pg8::bf16_t*)(ws + WS_ERAW), (float*)(ws + WS_PE), karg_ptr()->in[16]};
      pg8::gemm_phase<pg8::EpiE, pg8::StaticOrder, true, true>(F.lds + RING_OFF, g, S, E, wave0); }
#endif
    xcd_barrier(bar);

#if PHM & 16
    REFRESH_TID();
    { unsigned char* ws = karg_ptr()->ws;
      pg8::Gemm g{(const pg8::bf16_t*)(ws + WS_H1B), (const pg8::bf16_t*)(ws + WS_WUP), M, DFF, DM, nullptr, nullptr}; pg8::StaticOrder S; S.init(M, DFF, G, cb);
      pg8::Unit u0; if (S.next(0, u0)) row_table(F, (const float*)(ws + WS_P1), u0.pm * 256, (LAS float*)(F.lds + TAB_RS)); else __syncthreads();
      pg8::EpiUp E{(pg8::bf16_t*)(ws + WS_HID), (const LAS float*)(F.lds + TAB_RS)};
      pg8::gemm_phase<pg8::EpiUp, pg8::StaticOrder, true, true>(F.lds + RING_OFF, g, S, E, wave0); }
    int pmg; { pg8::StaticOrder S; S.init(M, DM, G, cb); pg8::Unit u0; pmg = S.next(0, u0) ? u0.pm : 0; }
    if (G == 256) group_sync(bar, (unsigned*)(F.ctl + CW_GRP + 64 * pmg), 4u); else xcd_barrier(bar);
    REFRESH_TID();
    { KArgs& args = *karg_ptr(); unsigned char* ws = args.ws;
      pg8::Gemm g{(const pg8::bf16_t*)(ws + WS_HID), (const pg8::bf16_t*)(ws + WS_WDOWN), M, DM, DFF, nullptr, nullptr}; pg8::StaticOrder S; S.init(M, DM, G, cb);
      pg8::EpiDown E{(const pg8::bf16_t*)(ws + WS_H1B), (pg8::bf16_t*)(ws + WS_H1B), (unsigned char*)(ws + WS_H2F8), (float*)(ws + WS_P2), 0};
      pg8::gemm_phase<pg8::EpiDown, pg8::StaticOrder, true, true>(F.lds + RING_OFF, g, S, E, wave0); }
    if (G == 256) group_sync(bar, (unsigned*)(F.ctl + CW_GRP + 64 * (64 + pmg)), 4u); else xcd_barrier(bar);
#endif
#if PHM & 32
    REFRESH_TID();
    { KArgs& args = *karg_ptr(); unsigned char* ws = args.ws;
      pg8::Gemm g{(const pg8::bf16_t*)(ws + WS_H2F8), (const pg8::bf16_t*)(ws + WS_WGATE), M, DM, DM / 2, nullptr, nullptr}; pg8::StaticOrder S; S.init(M, DM, G, cb);
      pg8::Unit u0; if (S.next(0, u0)) { row_table(F, (const float*)(ws + WS_P2), u0.pm * 256, (LAS float*)(F.lds + TAB_RS)); row_table(F, (const float*)(ws + WS_PE), u0.pm * 256, (LAS float*)(F.lds + TAB_RSE)); }
      pg8::EpiGate E{args.out, (const pg8::bf16_t*)(ws + WS_H1B), (const pg8::bf16_t*)(ws + WS_ERAW), 1.f / GATE_WSCALE, (const LAS float*)(F.lds + TAB_RS), (const LAS float*)(F.lds + TAB_RSE)};
      pg8::gemm_phase<pg8::EpiGate, pg8::StaticOrder, true, true, true>(F.lds + RING_OFF, g, S, E, wave0); }
#endif
    if (__hip_atomic_load((gu32*)((unsigned*)(F.ctl + CW_BAR) + XB_TMO), RLX_AGENT) != 0u) { asm volatile("s_waitcnt vmcnt(0)" ::: "memory"); __syncthreads();
        float* o = karg_ptr()->out; const float qn = __builtin_nanf(""); const int t_ = wave0 * 64 + lane_now(); for (int i = t_; i < DM; i += NWAVES * 64) o[(size_t)blockIdx.x * 64 * DM + i] = qn; }
}

extern "C" void kernel_launch(void* const* d_in, const int* in_sizes, int n_in, void* d_out, int out_size, void* d_ws, size_t ws_size, hipStream_t stream) {
    static int grid = 0;
    if (grid == 0) {
        if (n_in != 17 || in_sizes[0] != M * DM || out_size != M * DM || ws_size < WS_END) { fprintf(stderr, "kernel_launch: shape / workspace mismatch (n_in %d, ws %zu, need %zu); nothing launched\n", n_in, ws_size, (size_t)WS_END); grid = -1; return; }
        int dev = 0, cus = 0, per_cu = 0;
        if (hipGetDevice(&dev) != hipSuccess || hipDeviceGetAttribute(&cus, hipDeviceAttributeMultiprocessorCount, dev) != hipSuccess) { grid = -1; return; }
        if (hipFuncSetAttribute((const void*)fwd_kernel, hipFuncAttributeMaxDynamicSharedMemorySize, LDS_BYTES) != hipSuccess) { fprintf(stderr, "kernel_launch: hipFuncSetAttribute failed\n"); grid = -1; return; }
        if (hipOccupancyMaxActiveBlocksPerMultiprocessor(&per_cu, (const void*)fwd_kernel, NWAVES * 64, LDS_BYTES) != hipSuccess || per_cu < 1) fprintf(stderr, "kernel_launch: note: occupancy query reports %d workgroups per CU\n", per_cu);
        (void)hipGetLastError();
        grid = cus;
    }
    if (grid < 0) return;
    if (hipMemsetAsync((char*)d_ws + WS_CTL, 0, CTL_ZERO_BYTES, stream) != hipSuccess) return;
    Args a{};
    for (int i = 0; i < 17; ++i) a.in[i] = (const float*)d_in[i];
    a.out = (float*)d_out; a.ws = (unsigned char*)d_ws;
    hipLaunchKernelGGL(fwd_kernel, dim3(grid), dim3(NWAVES * 64), LDS_BYTES, stream, a);
}
```

```cpp
#include <hip/hip_runtime.h>
#include <hip/hip_bf16.h>
#include <cstdio>
#include <cstdint>
namespace pg8 {
#define PG8_LAS __attribute__((address_space(3)))
typedef unsigned short bf16_t;
typedef short bf16x8 __attribute__((ext_vector_type(8)));
typedef float f32x4 __attribute__((ext_vector_type(4)));
typedef unsigned u32x4 __attribute__((ext_vector_type(4)));
constexpr int BM = 256, BK = 64, HALF = 128, HTB = HALF * BK * 2  , STAGE_BYTES = 8 * HTB, NXCD = 8, WGM = 8;

__host__ __device__ __forceinline__ int lds_byte(int r, int c) { const int st = (r >> 4) * 2 + (c >> 5), rr = r & 15, cc = c & 31, ob = rr * 64 + cc * 2; return st * 1024 + (ob ^ (((ob >> 9) & 1) << 5)); }
__host__ __device__ __forceinline__ void stage_rc(int b, int& R, int& C) { const int st = b / 1024, sb = b % 1024, swz = sb ^ (((sb >> 9) & 1) << 5); R = (st >> 1) * 16 + swz / 64; C = (st & 1) * 32 + (swz % 64) / 2; }
__host__ __device__ __forceinline__ int perm32(int rho) { const int n = rho >> 4, i = rho & 15; return 8 * (i >> 2) + 4 * n + (i & 3); }

struct Unit { int pm, pn; };
struct Gemm { const bf16_t* A; const bf16_t* Bt; int M, N, K; const bf16_t* A2; const bf16_t* B2; };

struct StaticOrder {
    int nM, nN, nwg, G, c;
    __host__ __device__ void init(int M, int N, int G_, int c_) { nM = M / BM; nN = N / BM; nwg = nM * nN; G = G_; c = c_; }
    __host__ __device__ bool next(int i, Unit& u) const {
        const long L = (long)i * G + c; if (L >= nwg) return false;
        int wgid = (int)L; { const int q = nwg / NXCD, r = nwg % NXCD, xcd = wgid % NXCD, off = wgid / NXCD; wgid = (xcd < r ? xcd * (q + 1) : r * (q + 1) + (xcd - r) * q) + off; }
        const int nig = WGM * nN, gid = wgid / nig, fm = gid * WGM, gsz = (nM - fm) < WGM ? (nM - fm) : WGM;
        u.pm = fm + ((wgid % nig) % gsz); u.pn = (wgid % nig) / gsz; return true;
    }
    __device__ __forceinline__ void a_ready(const Unit&) const {}
    __device__ __forceinline__ void done(const Unit&) const {}
};
typedef float f32x2c_t __attribute__((ext_vector_type(2))); typedef __bf16 bf16x2c_t __attribute__((ext_vector_type(2)));
__device__ __forceinline__ unsigned cvt_pk_bf16(float lo, float hi) { f32x2c_t v = {lo, hi}; bf16x2c_t b = __builtin_convertvector(v, bf16x2c_t); return __builtin_bit_cast(unsigned, b); }
typedef float f32x2 __attribute__((ext_vector_type(2)));
__device__ __forceinline__ u32x4 pack8v(const f32x4 v0, const f32x4 v1) { u32x4 w; w.x = cvt_pk_bf16(v0[0], v0[1]); w.y = cvt_pk_bf16(v0[2], v0[3]); w.z = cvt_pk_bf16(v1[0], v1[1]); w.w = cvt_pk_bf16(v1[2], v1[3]); return w; }
__device__ __forceinline__ float dot8(const f32x4 a, const f32x4 b) { return ((a[0] * a[0] + a[1] * a[1]) + (a[2] * a[2] + a[3] * a[3])) + ((b[0] * b[0] + b[1] * b[1]) + (b[2] * b[2] + b[3] * b[3])); }
__device__ __forceinline__ float red_fq(float s) { s += __shfl_xor(s, 16); s += __shfl_xor(s, 32); return s; }

struct EpiProj {
    static constexpr bool PERM = true, AFTER_DRAIN = false;
    bf16_t* proj; float* pqk; const PG8_LAS float* rs;
    __device__ __forceinline__ void operator()(const f32x4 (&acc)[2][2][4][2], const Unit& u, int wr, int wc, int fr, int fq) const {
        const int C = u.pn * BM, which = C >> 11, hp = (C & 2047) >> 8, dcol = wc * 32 + 8 * fq;
#pragma unroll
        for (int ai = 0; ai < 2; ++ai)
#pragma unroll
            for (int m = 0; m < 4; ++m) { const int lr = ai * HALF + wr * 64 + m * 16 + fr, row = u.pm * BM + lr, b = row >> 13, t = row & 8191; const float r = rs[lr];
#pragma unroll
                for (int bj = 0; bj < 2; ++bj) { const int head = 2 * hp + bj;
                    const f32x4 v0 = acc[ai][bj][m][0] * r, v1 = acc[ai][bj][m][1] * r;
                    *(u32x4*)(proj + ((size_t)((which * 2 + b) * 16 + head) * 8192 + t) * 128 + dcol) = pack8v(v0, v1);
                    if (which < 2) { const float ss = red_fq(dot8(v0, v1)); if (fq == 0) pqk[((size_t)(which * 16384 + row) * 16 + head) * 4 + wc] = ss; } } }
    }
};
struct EpiOut {
    static constexpr bool PERM = true, AFTER_DRAIN = false;
    bf16_t* hb; float* part;
    __device__ __forceinline__ void operator()(const f32x4 (&acc)[2][2][4][2], const Unit& u, int wr, int wc, int fr, int fq) const {
        const int col0 = u.pn * BM + wc * 32 + 8 * fq, row0 = u.pm * BM + wr * 64 + fr;
#pragma unroll
        for (int g = 0; g < 8; ++g) { const int ai = g >> 2, m = g & 3, row = row0 + ai * HALF + m * 16; float ss = 0.f;
#pragma unroll
            for (int bj = 0; bj < 2; ++bj) { const size_t off = (size_t)row * 4096 + col0 + bj * HALF;
                const f32x4 v0 = acc[ai][bj][m][0], v1 = acc[ai][bj][m][1];
                *(u32x4*)(hb + off) = pack8v(v0, v1); ss += dot8(v0, v1); }
            ss = red_fq(ss); if (fq == 0) part[(size_t)row * 64 + u.pn * 4 + wc] = ss; }
    }
};
struct EpiE {
    static constexpr bool PERM = true, AFTER_DRAIN = false;
    bf16_t* eb; float* part; const float* gpost;
    __device__ __forceinline__ void operator()(const f32x4 (&acc)[2][2][4][2], const Unit& u, int wr, int wc, int fr, int fq) const {
        int fr_ = fr, fq_ = fq; asm volatile("" : "+v"(fr_), "+v"(fq_));
        const int col0 = u.pn * BM + wc * 32 + 8 * fq_;
        f32x4 gp[2][2];
#pragma unroll
        for (int bj = 0; bj < 2; ++bj) { gp[bj][0] = *(const f32x4*)(gpost + col0 + bj * HALF); gp[bj][1] = *(const f32x4*)(gpost + col0 + bj * HALF + 4); }
#pragma unroll
        for (int ai = 0; ai < 2; ++ai)
#pragma unroll
            for (int m = 0; m < 4; ++m) { const int row = u.pm * BM + ai * HALF + wr * 64 + m * 16 + fr_; float ss = 0.f;
#pragma unroll
                for (int bj = 0; bj < 2; ++bj) { const size_t off = (size_t)row * 4096 + col0 + bj * HALF;
                    const f32x4 v0 = acc[ai][bj][m][0], v1 = acc[ai][bj][m][1];
                    *(u32x4*)(eb + off) = pack8v(v0 * gp[bj][0], v1 * gp[bj][1]); ss += dot8(v0, v1); }
                ss = red_fq(ss); if (fq_ == 0) part[(size_t)row * 64 + u.pn * 4 + wc] = ss; }
    }
};
struct EpiUp {
    static constexpr bool PERM = true, AFTER_DRAIN = false;
    bf16_t* hid; const PG8_LAS float* rs;
    __device__ __forceinline__ void operator()(const f32x4 (&acc)[2][2][4][2], const Unit& u, int wr, int wc, int fr, int fq) const {
        const int col0 = u.pn * BM + wc * 32 + 8 * fq;
#pragma unroll
        for (int ai = 0; ai < 2; ++ai)
#pragma unroll
            for (int m = 0; m < 4; ++m) { const int lr = ai * HALF + wr * 64 + m * 16 + fr, row = u.pm * BM + lr; const float r = rs[lr];
#pragma unroll
                for (int bj = 0; bj < 2; ++bj) { f32x4 v0 = acc[ai][bj][m][0] * r, v1 = acc[ai][bj][m][1] * r;
#pragma unroll
                    for (int i = 0; i < 4; ++i) { const float a = fmaxf(v0[i], 0.f), b = fmaxf(v1[i], 0.f); v0[i] = a * a; v1[i] = b * b; }
                    *(u32x4*)(hid + (size_t)row * 16384 + col0 + bj * HALF) = pack8v(v0, v1); } }
    }
};
struct EpiDown {
    static constexpr bool PERM = true, AFTER_DRAIN = false;
    const bf16_t* h1b; bf16_t* hb; unsigned char* h8; float* part; int row_off;
    __device__ __forceinline__ void operator()(const f32x4 (&acc)[2][2][4][2], const Unit& u, int wr, int wc, int fr, int fq) const {
        const int col0 = u.pn * BM + wc * 32 + 8 * fq, row0 = row_off + u.pm * BM + wr * 64 + fr;
        u32x4 nx[2];
#pragma unroll
        for (int bj = 0; bj < 2; ++bj) nx[bj] = *(const u32x4*)(h1b + (size_t)row0 * 4096 + col0 + bj * HALF);
#pragma unroll
        for (int g = 0; g < 8; ++g) { const int ai = g >> 2, m = g & 3, row = row0 + ai * HALF + m * 16; float ss = 0.f;
            u32x4 cx[2];
#pragma unroll
            for (int bj = 0; bj < 2; ++bj) cx[bj] = nx[bj];
            if (g < 7) { const int rown = row0 + ((g + 1) >> 2) * HALF + ((g + 1) & 3) * 16;
#pragma unroll
                for (int bj = 0; bj < 2; ++bj) nx[bj] = *(const u32x4*)(h1b + (size_t)rown * 4096 + col0 + bj * HALF); }
#pragma unroll
            for (int bj = 0; bj < 2; ++bj) { const size_t off = (size_t)row * 4096 + col0 + bj * HALF; const u32x4 w = cx[bj];
                f32x4 v0 = acc[ai][bj][m][0], v1 = acc[ai][bj][m][1];
                v0[0] += __uint_as_float(w.x << 16); v0[1] += __uint_as_float(w.x & 0xffff0000u); v0[2] += __uint_as_float(w.y << 16); v0[3] += __uint_as_float(w.y & 0xffff0000u);
                v1[0] += __uint_as_float(w.z << 16); v1[1] += __uint_as_float(w.z & 0xffff0000u); v1[2] += __uint_as_float(w.w << 16); v1[3] += __uint_as_float(w.w & 0xffff0000u);
                *(u32x4*)(hb + off) = pack8v(v0, v1); ss += dot8(v0, v1);
                { typedef unsigned u32x2_ __attribute__((ext_vector_type(2))); u32x2_ q;
                  int p0 = __builtin_amdgcn_cvt_pk_fp8_f32(v0[0], v0[1], 0, false); p0 = __builtin_amdgcn_cvt_pk_fp8_f32(v0[2], v0[3], p0, true);
                  int p1 = __builtin_amdgcn_cvt_pk_fp8_f32(v1[0], v1[1], 0, false); p1 = __builtin_amdgcn_cvt_pk_fp8_f32(v1[2], v1[3], p1, true);
                  q.x = (unsigned)p0; q.y = (unsigned)p1; *(u32x2_*)(h8 + off) = q; } }
            ss = red_fq(ss); if (fq == 0) part[(size_t)row * 64 + u.pn * 4 + wc] = ss;
            asm volatile("" ::: "memory"); }
    }
};
struct EpiGate {
    static constexpr bool PERM = true, AFTER_DRAIN = false;
    float* out; const bf16_t* h2b; const bf16_t* eb; float wscale_inv; const PG8_LAS float* rs2; const PG8_LAS float* rse;
    __device__ __forceinline__ void operator()(const f32x4 (&acc)[2][2][4][2], const Unit& u, int wr, int wc, int fr, int fq) const {
        int fr_ = fr, fq_ = fq; asm volatile("" : "+v"(fr_), "+v"(fq_));
        const int col0 = u.pn * BM + wc * 32 + 8 * fq_, lr0 = wr * 64 + fr_, row0 = u.pm * BM + lr0;
        u32x4 nx[2], ne[2];
#pragma unroll
        for (int bj = 0; bj < 2; ++bj) { const size_t off = (size_t)row0 * 4096 + col0 + bj * HALF; nx[bj] = *(const u32x4*)(h2b + off); ne[bj] = *(const u32x4*)(eb + off); }
#pragma unroll
        for (int g = 0; g < 8; ++g) { const int ai = g >> 2, m = g & 3, lr = lr0 + ai * HALF + m * 16, row = row0 + ai * HALF + m * 16;
            const float r2 = rs2[lr] * wscale_inv * -1.4426950408889634f, re = rse[lr];
            u32x4 cx[2], ce[2];
#pragma unroll
            for (int bj = 0; bj < 2; ++bj) { cx[bj] = nx[bj]; ce[bj] = ne[bj]; }
            if (g < 7) { const int rown = row0 + ((g + 1) >> 2) * HALF + ((g + 1) & 3) * 16;
#pragma unroll
                for (int bj = 0; bj < 2; ++bj) { const size_t off = (size_t)rown * 4096 + col0 + bj * HALF; nx[bj] = *(const u32x4*)(h2b + off); ne[bj] = *(const u32x4*)(eb + off); } }
#pragma unroll
            for (int bj = 0; bj < 2; ++bj) { const size_t off = (size_t)row * 4096 + col0 + bj * HALF;
                const u32x4 ew = ce[bj], hw = cx[bj];
                f32x4 e0, e1, v0, v1;
                e0[0] = __uint_as_float(ew.x << 16); e0[1] = __uint_as_float(ew.x & 0xffff0000u); e0[2] = __uint_as_float(ew.y << 16); e0[3] = __uint_as_float(ew.y & 0xffff0000u);
                e1[0] = __uint_as_float(ew.z << 16); e1[1] = __uint_as_float(ew.z & 0xffff0000u); e1[2] = __uint_as_float(ew.w << 16); e1[3] = __uint_as_float(ew.w & 0xffff0000u);
                v0[0] = __uint_as_float(hw.x << 16); v0[1] = __uint_as_float(hw.x & 0xffff0000u); v0[2] = __uint_as_float(hw.y << 16); v0[3] = __uint_as_float(hw.y & 0xffff0000u);
                v1[0] = __uint_as_float(hw.z << 16); v1[1] = __uint_as_float(hw.z & 0xffff0000u); v1[2] = __uint_as_float(hw.w << 16); v1[3] = __uint_as_float(hw.w & 0xffff0000u);
#pragma unroll
                for (int i = 0; i < 4; ++i) { const float g0 = __builtin_amdgcn_rcpf(1.f + __builtin_amdgcn_exp2f(acc[ai][bj][m][0][i] * r2)), g1 = __builtin_amdgcn_rcpf(1.f + __builtin_amdgcn_exp2f(acc[ai][bj][m][1][i] * r2));
                    v0[i] += g0 * (e0[i] * re); v1[i] += g1 * (e1[i] * re); }
                *(f32x4*)(out + off) = v0; *(f32x4*)(out + off + 4) = v1; }
            asm volatile("" ::: "memory"); }
    }
};
template <class Epi, class Sched, bool ALIGN_EPI = false, bool SP2 = false, bool FP8 = false, int EXT = 0>
__device__ __forceinline__ void gemm_phase(PG8_LAS unsigned char* lds, const Gemm g, const Sched& S, const Epi& E, const int wave_s  ) {
    int lane_; asm volatile("v_mbcnt_lo_u32_b32 %0, -1, 0\n\tv_mbcnt_hi_u32_b32 %0, -1, %0" : "=v"(lane_)); const int tid_ = wave_s * 64 + lane_;
    const int tid = tid_, wid = wave_s, lane = lane_, wr = wid >> 2, wc = wid & 3, fr = lane & 15, fq = lane >> 4;
    const int K = g.K, nt = K / BK;
    unsigned voffA[2], voffB[2];
#pragma unroll
    for (int i = 0; i < 2; ++i) { int R, C; stage_rc(tid * 16 + i * 8192, R, C); const int Rb = Epi::PERM ? ((R & ~31) + perm32(R & 31)) : R;
        voffA[i] = (unsigned)(R * K + C) * 2u; voffB[i] = (unsigned)(Rb * K + C) * 2u; }
    const size_t kstep = (size_t)(BK * 2);
    const size_t hstep = (size_t)HALF * K * 2;
    const size_t tstep = 2 * hstep;
    const unsigned ldsw = (unsigned)wid * 1024u;
    const int aoff = lds_byte(wr * 64 + fr, fq * 8), boff = lds_byte(wc * 32 + fr, fq * 8);
    const int aoff8 = lds_byte(wr * 64 + fr, fq * 16), boff8 = lds_byte(wc * 32 + fr, fq * 16);
#define PG8_SA(b, h) (((b) * 2 + (h)) * HTB)
#define PG8_SB(b, h) ((4 + (b) * 2 + (h)) * HTB)
#define PG8_STAGE(bufoff, gbase, voff) do { const char* gb_ = (const char*)(gbase); asm volatile("" : "+s"(gb_)); _Pragma("unroll") for (int _i = 0; _i < 2; ++_i) { asm volatile("" : "+v"((voff)[_i])); \
        __builtin_amdgcn_global_load_lds((const unsigned*)(gb_ + (voff)[_i]), (PG8_LAS unsigned*)(lds + (bufoff) + ldsw + _i * 8192), 16, 0, 0); } } while (0)
#define PG8_LDA(dst, b, h) do { _Pragma("unroll") for (int m = 0; m < 4; ++m) _Pragma("unroll") for (int k = 0; k < 2; ++k) dst[m][k] = *(const PG8_LAS bf16x8*)(lds + PG8_SA(b, h) + (FP8 ? aoff8 + m * 2048 + k * 16 : aoff + m * 2048 + k * 1024)); } while (0)
#define PG8_LDB(dst, b, h) do { _Pragma("unroll") for (int n = 0; n < 2; ++n) _Pragma("unroll") for (int k = 0; k < 2; ++k) dst[n][k] = *(const PG8_LAS bf16x8*)(lds + PG8_SB(b, h) + (FP8 ? boff8 + n * 2048 + k * 16 : boff + n * 2048 + k * 1024)); } while (0)
#define PG8_MMA(ai, bj, At, Bt) do { __builtin_amdgcn_s_setprio(1); if constexpr (FP8) { typedef int v8i_ __attribute__((ext_vector_type(8))); \
        _Pragma("unroll") for (int m = 0; m < 4; ++m) _Pragma("unroll") for (int n = 0; n < 2; ++n) \
            { const v8i_ b8_ = __builtin_bit_cast(v8i_, __builtin_shufflevector(Bt[n][0], Bt[n][1], 0, 1, 2, 3, 4, 5, 6, 7, 8, 9, 10, 11, 12, 13, 14, 15)), a8_ = __builtin_bit_cast(v8i_, __builtin_shufflevector(At[m][0], At[m][1], 0, 1, 2, 3, 4, 5, 6, 7, 8, 9, 10, 11, 12, 13, 14, 15)); \
              asm volatile("v_mfma_f32_16x16x128_f8f6f4 %0, %1, %2, %0" : "+v"(acc[ai][bj][m][n]) : "v"(b8_), "v"(a8_)); }     \
            } else { \
        _Pragma("unroll") for (int m = 0; m < 4; ++m) _Pragma("unroll") for (int n = 0; n < 2; ++n) _Pragma("unroll") for (int k = 0; k < 2; ++k) \
        acc[ai][bj][m][n] = __builtin_amdgcn_mfma_f32_16x16x32_bf16(Bt[n][k], At[m][k], acc[ai][bj][m][n], 0, 0, 0); } __builtin_amdgcn_s_setprio(0); } while (0)
#define PG8_WAIT_V(n) asm volatile("s_waitcnt vmcnt(" #n ")" ::: "memory")
#define PG8_WAIT_L(n) asm volatile("s_waitcnt lgkmcnt(" #n ")" ::: "memory")
#define PG8_BAR __builtin_amdgcn_s_barrier()
#define PG8_SCHED __builtin_amdgcn_sched_barrier(0)
    Unit cur, nxt; int ui = 0;
    if (!S.next(0, cur)) return;
    f32x4 acc[2][2][4][2];
#pragma unroll
    for (int a = 0; a < 2; ++a)
#pragma unroll
        for (int b = 0; b < 2; ++b)
#pragma unroll
            for (int m = 0; m < 4; ++m)
#pragma unroll
                for (int n = 0; n < 2; ++n) acc[a][b][m][n] = (f32x4){0.f, 0.f, 0.f, 0.f};
    bf16x8 At[4][2], B0[2][2], B1[2][2];
    const char* cA = (const char*)g.A + (size_t)cur.pm * tstep; const char* cB = (const char*)g.Bt + (size_t)cur.pn * tstep;
    S.a_ready(cur);
    if constexpr (SP2) {
        PG8_STAGE(PG8_SB(0, 0), cB, voffB); PG8_STAGE(PG8_SB(0, 1), cB + hstep, voffB); PG8_STAGE(PG8_SA(0, 0), cA, voffA); PG8_STAGE(PG8_SA(0, 1), cA + hstep, voffA);
        if (wr == 1) PG8_BAR;
        PG8_WAIT_V(2); PG8_BAR;
        PG8_STAGE(PG8_SB(1, 0), cB + kstep, voffB); PG8_STAGE(PG8_SA(1, 0), cA + kstep, voffA); PG8_STAGE(PG8_SB(1, 1), cB + hstep + kstep, voffB);
        PG8_WAIT_V(6); PG8_BAR;
    } else {
        PG8_STAGE(PG8_SB(0, 0), cB, voffB); PG8_STAGE(PG8_SA(0, 0), cA, voffA); PG8_STAGE(PG8_SB(0, 1), cB + hstep, voffB); PG8_STAGE(PG8_SA(0, 1), cA + hstep, voffA);
        if (wr == 1) PG8_BAR;
        PG8_WAIT_V(4); PG8_BAR;
        PG8_STAGE(PG8_SB(1, 0), cB + kstep, voffB); PG8_STAGE(PG8_SA(1, 0), cA + kstep, voffA); PG8_STAGE(PG8_SB(1, 1), cB + hstep + kstep, voffB);
        PG8_WAIT_V(6); PG8_BAR;
    }
    for (;;) {
        const bool has_next = S.next(ui + 1, nxt);
        const char* nA = has_next ? (const char*)g.A + (size_t)nxt.pm * tstep : cA; const char* nB = has_next ? (const char*)g.Bt + (size_t)nxt.pn * tstep : cB;
        static_assert(EXT % 2 == 0, "EXT");
        const char* xA = EXT ? (const char*)g.A2 + (size_t)cur.pm * tstep + (size_t)cur.pn * (BM * 2) : cA; const char* xB = EXT ? (const char*)g.B2 : cB;
        const int NT = nt + EXT;
        for (int t = 0; t < NT; t += 2) {
            const bool last = (t == NT - 2);
            const char* a1 = (!EXT || t < nt) ? cA + (size_t)(t + 1) * kstep : xA + (size_t)(t + 1 - nt) * kstep;
            const char* a2; const char* b2;
            if (last) { a2 = nA; b2 = nB; } else if (!EXT || t + 2 < nt) { a2 = cA + (size_t)(t + 2) * kstep; b2 = cB + (size_t)(t + 2) * kstep; } else { a2 = xA + (size_t)(t + 2 - nt) * kstep; b2 = xB + (size_t)(t + 2 - nt) * kstep; }
            const char* a3 = a2 + kstep; const char* b3 = b2 + kstep;
            if (last && has_next) S.a_ready(nxt);
            if constexpr (SP2) {
            PG8_LDB(B0, 0, 0); PG8_LDB(B1, 0, 1); PG8_SCHED; PG8_LDA(At, 0, 0); PG8_STAGE(PG8_SA(1, 1), a1 + hstep, voffA);
            PG8_WAIT_V(8); PG8_WAIT_L(0); PG8_BAR; PG8_MMA(0, 0, At, B0); PG8_MMA(0, 1, At, B1); PG8_BAR; PG8_SCHED;
            PG8_LDA(At, 0, 1); PG8_STAGE(PG8_SB(0, 0), b2, voffB); PG8_STAGE(PG8_SB(0, 1), b2 + hstep, voffB); PG8_STAGE(PG8_SA(0, 0), a2, voffA);
            PG8_WAIT_V(8); PG8_WAIT_L(0); PG8_BAR; PG8_MMA(1, 0, At, B0); PG8_MMA(1, 1, At, B1); PG8_BAR; PG8_SCHED;
            PG8_LDB(B0, 1, 0); PG8_LDB(B1, 1, 1); PG8_SCHED; PG8_LDA(At, 1, 0); PG8_STAGE(PG8_SA(0, 1), a2 + hstep, voffA);
            PG8_WAIT_V(8); PG8_WAIT_L(0); PG8_BAR; PG8_MMA(0, 0, At, B0); PG8_MMA(0, 1, At, B1); PG8_BAR; PG8_SCHED;
            PG8_LDA(At, 1, 1); PG8_STAGE(PG8_SB(1, 0), b3, voffB); PG8_STAGE(PG8_SB(1, 1), b3 + hstep, voffB); PG8_STAGE(PG8_SA(1, 0), a3, voffA);
            PG8_WAIT_V(8); PG8_WAIT_L(0); PG8_BAR; PG8_MMA(1, 0, At, B0); PG8_MMA(1, 1, At, B1); PG8_BAR; PG8_SCHED;
            } else {
            PG8_LDB(B0, 0, 0); PG8_SCHED; PG8_LDA(At, 0, 0); PG8_STAGE(PG8_SA(1, 1), a1 + hstep, voffA);
            PG8_WAIT_L(8); PG8_BAR; PG8_WAIT_L(0); PG8_MMA(0, 0, At, B0); PG8_BAR; PG8_SCHED;
            PG8_LDB(B1, 0, 1); PG8_STAGE(PG8_SB(0, 0), b2, voffB);
            PG8_BAR; PG8_WAIT_L(0); PG8_MMA(0, 1, At, B1); PG8_BAR;
            PG8_LDA(At, 0, 1); PG8_STAGE(PG8_SA(0, 0), a2, voffA);
            PG8_BAR; PG8_WAIT_L(0); PG8_MMA(1, 0, At, B0); PG8_BAR; PG8_SCHED;
            PG8_STAGE(PG8_SB(0, 1), b2 + hstep, voffB);
            PG8_WAIT_V(6); PG8_BAR; PG8_MMA(1, 1, At, B1); PG8_BAR;
            PG8_LDB(B0, 1, 0); PG8_SCHED; PG8_LDA(At, 1, 0); PG8_STAGE(PG8_SA(0, 1), a2 + hstep, voffA);
            PG8_WAIT_L(8); PG8_BAR; PG8_WAIT_L(0); PG8_MMA(0, 0, At, B0); PG8_BAR; PG8_SCHED;
            PG8_LDB(B1, 1, 1); PG8_STAGE(PG8_SB(1, 0), b3, voffB);
            PG8_BAR; PG8_WAIT_L(0); PG8_MMA(0, 1, At, B1); PG8_BAR;
            PG8_LDA(At, 1, 1); PG8_STAGE(PG8_SA(1, 0), a3, voffA);
            PG8_BAR; PG8_WAIT_L(0); PG8_MMA(1, 0, At, B0); PG8_BAR; PG8_SCHED;
            PG8_STAGE(PG8_SB(1, 1), b3 + hstep, voffB);
            PG8_WAIT_V(6); PG8_BAR; PG8_MMA(1, 1, At, B1); PG8_BAR;
            }
        }
        if constexpr (FP8) asm volatile("s_nop 7\n\ts_nop 7\n\ts_nop 7" ::: "memory");
        if constexpr (ALIGN_EPI) { if (wr == 0) PG8_BAR; }
        if constexpr (!Epi::AFTER_DRAIN) { { int l2_; asm volatile("v_mbcnt_lo_u32_b32 %0, -1, 0\n\tv_mbcnt_hi_u32_b32 %0, -1, %0" : "=v"(l2_)); E(acc, cur, wr, wc, l2_ & 15, l2_ >> 4); }     S.done(cur); }
        if (!has_next) break;
#pragma unroll
        for (int a = 0; a < 2; ++a)
#pragma unroll
            for (int b = 0; b < 2; ++b)
#pragma unroll
                for (int m = 0; m < 4; ++m)
#pragma unroll
                    for (int n = 0; n < 2; ++n) acc[a][b][m][n] = (f32x4){0.f, 0.f, 0.f, 0.f};
        cur = nxt; cA = nA; cB = nB; ++ui;
        if constexpr (ALIGN_EPI) { if (wr == 1) PG8_BAR; }
    }
    PG8_WAIT_V(0);
    if constexpr (!ALIGN_EPI) { if (wr == 0) PG8_BAR; }
    PG8_BAR;
    if constexpr (Epi::AFTER_DRAIN) { E.fused(acc, cur, wr, wc, fr, fq, lds, wid, lane); S.done(cur); }
#undef PG8_SA
#undef PG8_SB
#undef PG8_STAGE
#undef PG8_LDA
#undef PG8_LDB
#undef PG8_MMA
#undef PG8_WAIT_V
#undef PG8_WAIT_L
#undef PG8_BAR
#undef PG8_SCHED
}
}
namespace fa {
constexpr int D = 128;
constexpr float SCALE = 0.08838834764831845f;
constexpr float LOG2E = 1.4426950408889634f;
constexpr float THR2 = 8.f * LOG2E;
constexpr bool WSKIP = false;
constexpr int OPITCH = 4096;
constexpr int NW = 8, QBLK = 32, KVBLK = 64, QB = NW * QBLK;
constexpr int SHM_V = KVBLK * D * 2, SHM_K = KVBLK * D * 2;
constexpr int LDS_BYTES = 2 * SHM_V + 2 * SHM_K + NW * 64 * 4;
constexpr int TAB_MAX = 8192 + QB;
constexpr int FL_OFF = LDS_BYTES, RK_OFF = FL_OFF + TAB_MAX * 4, GG_OFF = RK_OFF + TAB_MAX * 4, SCR_OFF = GG_OFF + 512, FA_LDS_END = SCR_OFF + 64;
constexpr int WBIG = 1 << 30;

using bf16 = __hip_bfloat16;
typedef short bf16x8 __attribute__((ext_vector_type(8)));
typedef short s16x4 __attribute__((ext_vector_type(4)));
typedef float f32x16 __attribute__((ext_vector_type(16)));
typedef float f32x4 __attribute__((ext_vector_type(4)));
typedef unsigned u32x4 __attribute__((ext_vector_type(4)));
template <class A, class Bt> struct same_t { static constexpr bool v = false; };
template <class A> struct same_t<A, A> { static constexpr bool v = true; };

#define KSWZ(row, colB) ((row) * 256 + ((colB) ^ (((row) & 7) << 4)))
#define SBAR() __builtin_amdgcn_sched_barrier(0)
__device__ __forceinline__ int v_st(int k, int c) { const int kk = (k & ~0xC) | ((k & 4) << 1) | ((k & 8) >> 1); return ((kk >> 3) * 4 + (c >> 5)) * 512 + ((kk & 7) * 32 + (c & 31)) * 2; }
__device__ __forceinline__ int v_rd_base(int lane) { return ((lane & 3) << 3) | (((lane >> 2) & 3) << 6) | (((lane >> 4) & 1) << 5) | (((lane >> 5) & 1) << 8); }
constexpr int v_rd_off(int d0, int ks, int half) { return d0 * 512 + ks * 4096 + half * 2048; }
__device__ __forceinline__ int crow(int r, int hi) { return (r & 3) + 8 * (r >> 2) + 4 * hi; }
__device__ __forceinline__ unsigned cvtpk(float lo, float hi) {
    unsigned r; asm volatile("v_cvt_pk_bf16_f32 %0, %1, %2" : "=v"(r) : "v"(lo), "v"(hi)); return r;
}
__device__ __forceinline__ bf16x8 pack8(f32x4 a, f32x4 b) {
    u32x4 w = {cvtpk(a[0], a[1]), cvtpk(a[2], a[3]), cvtpk(b[0], b[1]), cvtpk(b[2], b[3])};
    return *reinterpret_cast<bf16x8*>(&w);
}
template <class T> __device__ __forceinline__ bf16x8 load8(const T* p) {
    if constexpr (same_t<T, float>::v) { return pack8(*(const f32x4*)p, *(const f32x4*)(p + 4)); }
    else { return *reinterpret_cast<const bf16x8*>(p); }
}
__device__ __forceinline__ void mask_tile(f32x16& p0, f32x16& p1, int dq, unsigned W) {
    const float NEG = -__builtin_inff();
#pragma unroll
    for (int r = 0; r < 16; ++r) {
        const int c = (r & 3) + 8 * (r >> 2);
        if ((unsigned)(dq - c) >= W) p0[r] = NEG;
        if ((unsigned)(dq - c - 32) >= W) p1[r] = NEG;
    }
}
__device__ __forceinline__ void partialSM(f32x16& p0, f32x16& p1, const float* FlL, const float* RKL, float& m_reg, float& mn, float& alpha) {
#pragma unroll
    for (int g = 0; g < 4; ++g) { const f32x4 f0 = *(const f32x4*)(FlL + 8 * g), k0 = *(const f32x4*)(RKL + 8 * g), f1 = *(const f32x4*)(FlL + 32 + 8 * g), k1 = *(const f32x4*)(RKL + 32 + 8 * g);
#pragma unroll
        for (int i = 0; i < 4; ++i) { p0[4 * g + i] = fmaf(p0[4 * g + i], k0[i], f0[i]); p1[4 * g + i] = fmaf(p1[4 * g + i], k1[i], f1[i]); } }
    float pmax = p0[0]; for (int r = 1; r < 16; ++r) pmax = fmaxf(pmax, p0[r]); for (int r = 0; r < 16; ++r) pmax = fmaxf(pmax, p1[r]);
    { auto rr = __builtin_amdgcn_permlane32_swap(__float_as_uint(pmax), __float_as_uint(pmax), false, false);
      pmax = fmaxf(__uint_as_float(rr[0]), __uint_as_float(rr[1])); }
    if (__builtin_expect(__all((pmax - m_reg) <= THR2), 1)) { mn = m_reg; alpha = 1.f; }
    else { mn = fmaxf(m_reg, pmax); alpha = __builtin_amdgcn_exp2f(m_reg - mn); m_reg = mn; }
    for (int r = 0; r < 16; ++r) p0[r] = p0[r] - mn; for (int r = 0; r < 16; ++r) p1[r] = p1[r] - mn;
    for (int r = 0; r < 16; ++r) p0[r] = __builtin_amdgcn_exp2f(p0[r]);
}
__device__ __forceinline__ void finishSM(f32x16& p0, f32x16& p1, float alpha, float& l_reg, bf16x8& pa0, bf16x8& pa1, bf16x8& pa2, bf16x8& pa3) {
    for (int r = 0; r < 16; ++r) p1[r] = __builtin_amdgcn_exp2f(p1[r]);
    float ps = 0; for (int r = 0; r < 16; ++r) ps += p0[r]; for (int r = 0; r < 16; ++r) ps += p1[r];
    { auto rr = __builtin_amdgcn_permlane32_swap(__float_as_uint(ps), __float_as_uint(ps), false, false);
      ps = __uint_as_float(rr[0]) + __uint_as_float(rr[1]); }
    l_reg = l_reg * alpha + ps;
#define PK4(P, B_, OUT) do { unsigned a0 = cvtpk(P[B_+0], P[B_+1]), a1 = cvtpk(P[B_+2], P[B_+3]);                          \
        unsigned b0 = cvtpk(P[B_+4], P[B_+5]), b1 = cvtpk(P[B_+6], P[B_+7]);                                             \
        auto r0 = __builtin_amdgcn_permlane32_swap(a0, b0, false, false); auto r1 = __builtin_amdgcn_permlane32_swap(a1, b1, false, false); \
        u32x4 w = {r0[0], r1[0], r0[1], r1[1]}; OUT = *reinterpret_cast<bf16x8*>(&w); } while (0)
    PK4(p0, 0, pa0); PK4(p0, 8, pa1); PK4(p1, 0, pa2); PK4(p1, 8, pa3);
#undef PK4
}
template <int KB, bool SK>
__device__ __forceinline__ void qkt(f32x16& p0, f32x16& p1, const char* K_lds, int r32, int hi, const bf16x8* qr, bool act) {
    if (SK && !act) { const float NEG = -__builtin_inff();
#pragma unroll
        for (int r = 0; r < 16; ++r) { p0[r] = NEG; p1[r] = NEG; } return; }
    p0 = f32x16{}; p1 = f32x16{};
    const char* kb[4];
#pragma unroll
    for (int dd = 0; dd < 4; ++dd) kb[dd] = K_lds + KB * SHM_K + KSWZ(r32, (dd * 16 + hi * 8) * 2);
#pragma unroll
    for (int d0 = 0; d0 < 8; ++d0) { const char* a = kb[d0 & 3] + (d0 >> 2) * 128;
        bf16x8 b0 = *reinterpret_cast<const bf16x8*>(a);
        bf16x8 b1 = *reinterpret_cast<const bf16x8*>(a + 32 * 256);
        p0 = __builtin_amdgcn_mfma_f32_32x32x16_bf16(b0, qr[d0], p0, 0, 0, 0);
        p1 = __builtin_amdgcn_mfma_f32_32x32x16_bf16(b1, qr[d0], p1, 0, 0, 0); }
}
template <int VB, bool SK>
__device__ __forceinline__ void pv_tile(f32x16* o, int vb0, bf16x8 pa0, bf16x8 pa1, bf16x8 pa2, bf16x8 pa3, bool act) {
    if (SK && !act) return;
#define TRRD(dst, off) asm volatile("ds_read_b64_tr_b16 %0, %1 offset:%2" : "=&v"(dst) : "v"(vb0), "i"(off) : "memory")
#define PV_D0(d0) do { s16x4 l0, l1, l2, l3, h0, h1, h2, h3; constexpr int b_ = VB * SHM_V + v_rd_off(d0, 0, 0);     \
        TRRD(l0, b_); TRRD(h0, b_ + 2048); TRRD(l1, b_ + 4096); TRRD(h1, b_ + 6144); TRRD(l2, b_ + 8192); TRRD(h2, b_ + 10240); TRRD(l3, b_ + 12288); TRRD(h3, b_ + 14336); \
        asm volatile("s_waitcnt lgkmcnt(0)" ::: "memory"); SBAR();                 \
        o[d0] = __builtin_amdgcn_mfma_f32_32x32x16_bf16(pa0, (bf16x8){l0[0], l0[1], l0[2], l0[3], h0[0], h0[1], h0[2], h0[3]}, o[d0], 0, 0, 0);   \
        o[d0] = __builtin_amdgcn_mfma_f32_32x32x16_bf16(pa1, (bf16x8){l1[0], l1[1], l1[2], l1[3], h1[0], h1[1], h1[2], h1[3]}, o[d0], 0, 0, 0);   \
        o[d0] = __builtin_amdgcn_mfma_f32_32x32x16_bf16(pa2, (bf16x8){l2[0], l2[1], l2[2], l2[3], h2[0], h2[1], h2[2], h2[3]}, o[d0], 0, 0, 0);   \
        o[d0] = __builtin_amdgcn_mfma_f32_32x32x16_bf16(pa3, (bf16x8){l3[0], l3[1], l3[2], l3[3], h3[0], h3[1], h3[2], h3[3]}, o[d0], 0, 0, 0); } while (0)
    PV_D0(0); PV_D0(1); PV_D0(2); PV_D0(3);
#undef PV_D0
#undef TRRD
}

template <class TIn, class TOut> struct BlockRef { const TIn* Q; const TIn* K; const TIn* V; TOut* O; int P0; int jlo; const float* LS; const float* PK; const float* PQ; float thr2; };

template <class TIn, class TOut>
__device__ __forceinline__ void fox_block(const BlockRef<TIn, TOut>& cur, char* lds, const int wave_s) {
    int lane_; asm volatile("v_mbcnt_lo_u32_b32 %0, -1, 0\n\tv_mbcnt_hi_u32_b32 %0, -1, %0" : "=v"(lane_));
    const int tid = wave_s * 64 + lane_, wid = wave_s, lane = lane_, r32 = lane & 31, hi = lane >> 5;
    const int j_lo = cur.jlo, NT = (cur.P0 + QB) / KVBLK - j_lo;
    const int qlo = cur.P0 + wid * QBLK, qm = qlo + r32 - 4 * hi;
    char* V_lds = lds; char* K_lds = lds + 2 * SHM_V;
    float* ws = (float*)(lds + 2 * SHM_V + 2 * SHM_K) + wid * 64; float* li_l = ws, * al_l = ws + 32;
    const int sr = tid >> 4, sc = (tid & 15) * 8, vst0 = v_st(sr, sc), vst1 = v_st(32 + sr, sc), kws = KSWZ(sr, sc * 2);
    const int vb0 = (int)(uintptr_t)V_lds + v_rd_base(lane);
    float* Flt = (float*)(lds + FL_OFF); float* RKt = (float*)(lds + RK_OFF); const float* GGt = (const float*)(lds + GG_OFF); float* wsum = (float*)(lds + SCR_OFF);
    bf16x8 st_v0, st_v1, st_k0, st_k1;
#define FB_LOAD(j) do { const size_t o_ = (size_t)((j) * KVBLK + sr) * D + sc; st_v0 = load8<TIn>(cur.V + o_); st_v1 = load8<TIn>(cur.V + o_ + 32 * D); st_k0 = load8<TIn>(cur.K + o_); st_k1 = load8<TIn>(cur.K + o_ + 32 * D); } while (0)
#define FB_WRITE(bf) do { *(bf16x8*)(K_lds + (bf) * SHM_K + kws) = st_k0; *(bf16x8*)(K_lds + (bf) * SHM_K + kws + 32 * 256) = st_k1; *(bf16x8*)(V_lds + (bf) * SHM_V + vst0) = st_v0; *(bf16x8*)(V_lds + (bf) * SHM_V + vst1) = st_v1; } while (0)
    FB_LOAD(j_lo);
    bf16x8 qr[8];
#pragma unroll
    for (int d0 = 0; d0 < 8; ++d0) qr[d0] = load8<TIn>(cur.Q + (size_t)(wid * QBLK + r32) * D + d0 * 16 + hi * 8);
    { const int s0 = j_lo * KVBLK, len = cur.P0 + QB - s0;
      float carry = 0.f;
      const f32x4 pq = *(const f32x4*)(cur.PQ + (size_t)(cur.P0 + wid * QBLK + r32) * 64);
      for (int base = 0; base < len; base += NW * 64) { const int i = base + tid;
          float x = (i < len) ? cur.LS[s0 + i] : 0.f;
          f32x4 pk = {1.f, 1.f, 1.f, 1.f}; if (i < len) pk = *(const f32x4*)(cur.PK + (size_t)(s0 + i) * 64);
#pragma unroll
          for (int o = 1; o < 64; o <<= 1) { const float y = __shfl_up(x, o); if (lane >= o) x += y; }
          if (lane == 63) wsum[wid] = x;
          __syncthreads();
          float off = carry, tot = 0.f;
#pragma unroll
          for (int w = 0; w < NW; ++w) { const float ws_ = wsum[w]; tot += ws_; if (w < wid) off += ws_; }
          if (i < len) { Flt[i] = -(x + off) * LOG2E;
              RKt[i] = (SCALE * LOG2E) / sqrtf(((pk[0] + pk[1]) + (pk[2] + pk[3])) * (1.f / 128.f) + 1e-6f); }
          carry += tot;
          __syncthreads(); }
      const float rq = 1.f / sqrtf(((pq[0] + pq[1]) + (pq[2] + pq[3])) * (1.f / 128.f) + 1e-6f);
#pragma unroll
      for (int d0 = 0; d0 < 8; ++d0) { const f32x4 g0 = *(const f32x4*)(GGt + d0 * 16 + hi * 8), g1 = *(const f32x4*)(GGt + d0 * 16 + hi * 8 + 4);
          f32x4 a, b;
#pragma unroll
          for (int j = 0; j < 4; ++j) { a[j] = __uint_as_float(((unsigned)(unsigned short)qr[d0][j]) << 16) * (rq * g0[j]); b[j] = __uint_as_float(((unsigned)(unsigned short)qr[d0][4 + j]) << 16) * (rq * g1[j]); }
          qr[d0] = pack8(a, b); }
    }
    const float* Flb = Flt + 4 * hi; const float* RKb = RKt + 4 * hi;
    asm volatile("s_waitcnt vmcnt(0)" ::: "memory"); FB_WRITE(0);
    __syncthreads();
    float m_reg = -1e30f, l_reg = 0; f32x16 o[4] = {};
    for (int t = 0; t < NT; ++t) {
        const int buf = t & 1, kb = (j_lo + t) * KVBLK;
        if (t + 1 < NT) FB_LOAD(j_lo + t + 1);
        if (kb <= qlo + QBLK - 1 && !(Flt[qlo - j_lo * KVBLK] - Flt[t * KVBLK + KVBLK - 1] > cur.thr2)) {
            f32x16 p0, p1; float mn, al; bf16x8 pa0, pa1, pa2, pa3;
            qkt<0, false>(p0, p1, K_lds + buf * SHM_K, r32, hi, qr, true);
            if (kb + KVBLK - 1 > qlo) mask_tile(p0, p1, qm - kb, (unsigned)WBIG);
            partialSM(p0, p1, Flb + t * KVBLK, RKb + t * KVBLK, m_reg, mn, al);
            if (__any(al < 1.f)) { if (hi == 0) al_l[r32] = al; asm volatile("s_waitcnt lgkmcnt(0)" ::: "memory");
                for (int d_ = 0; d_ < 4; ++d_) for (int r = 0; r < 16; ++r) o[d_][r] *= al_l[crow(r, hi)]; }
            finishSM(p0, p1, al, l_reg, pa0, pa1, pa2, pa3); SBAR();
            pv_tile<0, false>(o, vb0 + buf * SHM_V, pa0, pa1, pa2, pa3, true);
        }
        if (t + 1 < NT) { asm volatile("s_waitcnt vmcnt(0)" ::: "memory"); FB_WRITE(buf ^ 1); }
        __syncthreads();
    }
    if (hi == 0) li_l[r32] = l_reg; asm volatile("s_waitcnt lgkmcnt(0)" ::: "memory");
    float rli[16];
#pragma unroll
    for (int r = 0; r < 16; ++r) rli[r] = __builtin_amdgcn_rcpf(li_l[crow(r, hi)]);
    TOut* Ow = cur.O + (size_t)(wid * QBLK) * OPITCH;
#pragma unroll
    for (int r = 0; r < 16; ++r) { const int orow = crow(r, hi);
#pragma unroll
        for (int d0 = 0; d0 < 4; ++d0) { const float v = o[d0][r] * rli[r]; const float vn = __shfl_xor(v, 1);
            if ((r32 & 1) == 0) *(unsigned*)(Ow + (size_t)orow * OPITCH + d0 * 32 + r32) = cvtpk(v, vn); } }
    __syncthreads();
#undef FB_LOAD
#undef FB_WRITE
}
}
namespace hg {
#define HG_LAS __attribute__((address_space(3)))
typedef short bf16x8 __attribute__((ext_vector_type(8)));
typedef short s16x4 __attribute__((ext_vector_type(4)));
typedef float f32x4 __attribute__((ext_vector_type(4)));
typedef unsigned u32x4 __attribute__((ext_vector_type(4)));
constexpr int RB = 272;
constexpr int PL = 0, KT = 64 * RB, KH = 2 * 64 * RB, VL = 3 * 64 * RB, A1 = 4 * 64 * RB, A1RB = 144, SK = A1 + 64 * A1RB, SC = SK + 128 * RB, B63 = SC + 8 * 128 * 4, DK = B63 + 512, HG_END = DK + 512;
constexpr int OL = 0, ORB = 132 * 4;
static_assert(64 * ORB <= 2 * 64 * RB && HG_END + 1024 <= 131072, "hgrn LDS map");
typedef float f32x2_t __attribute__((ext_vector_type(2))); typedef __bf16 bf16x2_t __attribute__((ext_vector_type(2)));
__device__ __forceinline__ unsigned cvtpk(float lo, float hi) { f32x2_t v = {lo, hi}; bf16x2_t b = __builtin_convertvector(v, bf16x2_t); return __builtin_bit_cast(unsigned, b); }
__device__ __forceinline__ float bf_lo(unsigned w) { return __uint_as_float(w << 16); }
__device__ __forceinline__ float bf_hi(unsigned w) { return __uint_as_float(w & 0xffff0000u); }
__device__ __forceinline__ s16x4 vtr(const HG_LAS char* p) { typedef short v4i16_t __attribute__((ext_vector_type(4))); return __builtin_bit_cast(s16x4, __builtin_amdgcn_ds_read_tr16_b64_v4i16((HG_LAS v4i16_t*)p)); }
__device__ __forceinline__ bf16x8 tr2(const HG_LAS char* base, int row0, int col0, int lane) {
    const int i = lane & 15, kq = lane >> 4; const HG_LAS char* p = base + (row0 + 8 * kq + (i >> 2)) * RB + (col0 + 4 * (i & 3)) * 2;
    const s16x4 lo = vtr(p), hi = vtr(p + 4 * RB); return (bf16x8){lo[0], lo[1], lo[2], lo[3], hi[0], hi[1], hi[2], hi[3]};
}
__device__ __forceinline__ bf16x8 rd8(const HG_LAS char* base, int pitch, int row0, int col0, int lane) { return *(const HG_LAS bf16x8*)(base + (row0 + (lane & 15)) * pitch + (col0 + 8 * (lane >> 4)) * 2); }
#define HG_MFMA(a, b, c) __builtin_amdgcn_mfma_f32_16x16x32_bf16(a, b, c, 0, 0, 0)

struct SegArgs { const unsigned short* qb; const unsigned short* fb; const unsigned short* ib; const unsigned short* gb; unsigned short* out; const HG_LAS float* lb; const HG_LAS float* ghn; int c_begin, c_end; };
constexpr int WARM = 8;
constexpr int DSUM = HG_END, FLG = DSUM + 512, HG_END2 = FLG + 64;
__device__ __forceinline__ void hgrn_segment(HG_LAS char* lds, const SegArgs a, const int wave_s) {
    int lane_; asm volatile("v_mbcnt_lo_u32_b32 %0, -1, 0\n\tv_mbcnt_hi_u32_b32 %0, -1, %0" : "=v"(lane_));
    const int tid = wave_s * 64 + lane_, wid = wave_s;
    const int kc = tid & 15, tg = tid >> 4;
    constexpr float LOG2E = 1.4426950408889634f, LN2 = 0.6931471805599453f;
    float lbv[8];
#pragma unroll
    for (int e = 0; e < 8; ++e) lbv[e] = a.lb[8 * kc + e];
    const size_t eoff = (size_t)(2 * tg) * 128 + 8 * kc;
    const int tb = wid >> 1;
    int w0 = a.c_begin - WARM; if (w0 < 0) w0 = 0;
    for (;;) {
    f32x4 sT[8];
#pragma unroll
    for (int kb = 0; kb < 8; ++kb) sT[kb] = (f32x4){0.f, 0.f, 0.f, 0.f};
    for (int i = tid; i < 128 * RB / 16; i += 512) *(HG_LAS u32x4*)(lds + SK + i * 16) = (u32x4){0u, 0u, 0u, 0u};
    if (tid < 128) ((HG_LAS float*)(lds + DSUM))[tid] = 0.f;
    u32x4 zr[2], qr[2], vr[2];
#pragma unroll
    for (int r = 0; r < 2; ++r) { const size_t o_ = eoff + (size_t)w0 * 64 * 128 + r * 128; zr[r] = *(const u32x4*)(a.fb + o_); qr[r] = *(const u32x4*)(a.qb + o_); vr[r] = *(const u32x4*)(a.ib + o_); }
    __syncthreads();
    bool redo = false;
    for (int c = w0; c < a.c_end; ++c) {
        const bool warm = c < a.c_begin;
        float g0[8], tot[8], inc[8];
#pragma unroll
        for (int e = 0; e < 8; ++e) { const float omlb = 1.f - lbv[e];
            const unsigned w0_ = zr[0][e >> 1], w1_ = zr[1][e >> 1]; const float z0 = (e & 1) ? bf_hi(w0_) : bf_lo(w0_), z1 = (e & 1) ? bf_hi(w1_) : bf_lo(w1_);
            const float s0 = __builtin_amdgcn_rcpf(1.f + __builtin_amdgcn_exp2f(-z0 * LOG2E)), s1 = __builtin_amdgcn_rcpf(1.f + __builtin_amdgcn_exp2f(-z1 * LOG2E));
            g0[e] = __builtin_amdgcn_logf(lbv[e] + omlb * s0) * LN2; tot[e] = g0[e] + __builtin_amdgcn_logf(lbv[e] + omlb * s1) * LN2; inc[e] = tot[e]; }
#pragma unroll
        for (int e = 0; e < 8; ++e) { float y = __shfl_up(inc[e], 16); if (lane_ >= 16) inc[e] += y; y = __shfl_up(inc[e], 32); if (lane_ >= 32) inc[e] += y; }
        if (lane_ >= 48) {
#pragma unroll
            for (int e = 0; e < 8; ++e) ((HG_LAS float*)(lds + SC))[wid * 128 + 8 * kc + e] = inc[e]; }
        __syncthreads();
        float b63[8];
#pragma unroll
        for (int e = 0; e < 8; ++e) { float off = 0.f, all = 0.f;
#pragma unroll
            for (int w = 0; w < 8; ++w) { const float s = ((const HG_LAS float*)(lds + SC))[w * 128 + 8 * kc + e]; all += s; if (w < wid) off += s; }
            inc[e] = off + inc[e] - tot[e]; b63[e] = all * LOG2E; }
        if (tg == 0) {
#pragma unroll
            for (int e = 0; e < 8; ++e) { ((HG_LAS float*)(lds + DK))[8 * kc + e] = __builtin_amdgcn_exp2f(b63[e]); if (warm) ((HG_LAS float*)(lds + DSUM))[8 * kc + e] += b63[e]; } }
#pragma unroll
        for (int r = 0; r < 2; ++r) { float kh[8];
            const int ro = (2 * tg + r) * RB + 16 * kc;
            if (!warm) { float pv[8], kt[8];
#pragma unroll
                for (int e = 0; e < 8; ++e) {
                    const float km = 1.f - __builtin_amdgcn_exp2f((r ? tot[e] - g0[e] : g0[e]) * LOG2E);
                    const unsigned w = qr[r][e >> 1]; const float q = (e & 1) ? bf_hi(w) : bf_lo(w);
                    const float sq = q * __builtin_amdgcn_rcpf(1.f + __builtin_amdgcn_exp2f(-q * LOG2E)); const float bl = (inc[e] + (r ? tot[e] : g0[e])) * LOG2E;
                    pv[e] = sq * __builtin_amdgcn_exp2f(bl); kt[e] = km * __builtin_amdgcn_exp2f(-bl); kh[e] = km * __builtin_amdgcn_exp2f(b63[e] - bl); }
                *(HG_LAS u32x4*)(lds + PL + ro) = (u32x4){cvtpk(pv[0], pv[1]), cvtpk(pv[2], pv[3]), cvtpk(pv[4], pv[5]), cvtpk(pv[6], pv[7])};
                *(HG_LAS u32x4*)(lds + KT + ro) = (u32x4){cvtpk(kt[0], kt[1]), cvtpk(kt[2], kt[3]), cvtpk(kt[4], kt[5]), cvtpk(kt[6], kt[7])};
            } else {
#pragma unroll
                for (int e = 0; e < 8; ++e) { const float km = 1.f - __builtin_amdgcn_exp2f((r ? tot[e] - g0[e] : g0[e]) * LOG2E);
                    const float bl = (inc[e] + (r ? tot[e] : g0[e])) * LOG2E; kh[e] = km * __builtin_amdgcn_exp2f(b63[e] - bl); }
            }
            *(HG_LAS u32x4*)(lds + KH + ro) = (u32x4){cvtpk(kh[0], kh[1]), cvtpk(kh[2], kh[3]), cvtpk(kh[4], kh[5]), cvtpk(kh[6], kh[7])};
            *(HG_LAS u32x4*)(lds + VL + ro) = vr[r]; }
        if (c + 1 < a.c_end) { const size_t no = eoff + (size_t)(c + 1) * 64 * 128;
#pragma unroll
            for (int r = 0; r < 2; ++r) { zr[r] = *(const u32x4*)(a.fb + no + r * 128); qr[r] = *(const u32x4*)(a.qb + no + r * 128); vr[r] = *(const u32x4*)(a.ib + no + r * 128); } }
        __syncthreads();
        u32x4 gcur[2];
        if (!warm) {
#pragma unroll
            for (int r = 0; r < 2; ++r) gcur[r] = *(const u32x4*)(a.gb + eoff + (size_t)c * 64 * 128 + r * 128); }
        int lane = lane_; asm volatile("" : "+v"(lane));
        const int q4 = lane >> 4, n16 = lane & 15;
        if (!warm) {
        { const int sb0 = 2 * (wid & 1); f32x4 c0 = {0.f, 0.f, 0.f, 0.f}, c1 = {0.f, 0.f, 0.f, 0.f};
          if (sb0 <= tb) {
#pragma unroll
            for (int ks = 0; ks < 4; ++ks) { const bf16x8 af = rd8(lds + PL, RB, 16 * tb, 32 * ks, lane);
                c0 = HG_MFMA(af, rd8(lds + KT, RB, 16 * sb0, 32 * ks, lane), c0); c1 = HG_MFMA(af, rd8(lds + KT, RB, 16 * sb0 + 16, 32 * ks, lane), c1); } }
#pragma unroll
          for (int r = 0; r < 4; ++r) { const int t = 16 * tb + 4 * q4 + r, s0 = 16 * sb0 + n16, s1 = s0 + 16;
              const float x0 = (s0 <= t) ? c0[r] : 0.f, x1 = (s1 <= t) ? c1[r] : 0.f;
              *(HG_LAS unsigned short*)(lds + A1 + t * A1RB + s0 * 2) = (unsigned short)(cvtpk(x0, 0.f) & 0xffffu);
              *(HG_LAS unsigned short*)(lds + A1 + t * A1RB + s1 * 2) = (unsigned short)(cvtpk(x1, 0.f) & 0xffffu); } }
        __syncthreads();
        f32x4 oc[4];
#pragma unroll
        for (int j = 0; j < 4; ++j) oc[j] = (f32x4){0.f, 0.f, 0.f, 0.f};
        { const int vb0 = 4 * (wid & 1);
#pragma unroll
          for (int ks = 0; ks < 4; ++ks) { const bf16x8 af = rd8(lds + PL, RB, 16 * tb, 32 * ks, lane);
#pragma unroll
              for (int j = 0; j < 4; ++j) oc[j] = HG_MFMA(af, tr2(lds + SK, 32 * ks, 16 * (vb0 + j), lane), oc[j]); }
#pragma unroll
          for (int ks = 0; ks < 2; ++ks) { const bf16x8 af = rd8(lds + A1, A1RB, 16 * tb, 32 * ks, lane);
#pragma unroll
              for (int j = 0; j < 4; ++j) oc[j] = HG_MFMA(af, tr2(lds + VL, 32 * ks, 16 * (vb0 + j), lane), oc[j]); } }
        __syncthreads();
        { const int vb0 = 4 * (wid & 1);
#pragma unroll
          for (int j = 0; j < 4; ++j)
#pragma unroll
              for (int r = 0; r < 4; ++r) *(HG_LAS float*)(lds + OL + (16 * tb + 4 * q4 + r) * ORB + (16 * (vb0 + j) + n16) * 4) = oc[j][r]; }
        }
#pragma unroll
        for (int kb = 0; kb < 8; ++kb) { const float d = ((const HG_LAS float*)(lds + DK))[16 * kb + n16]; sT[kb] = sT[kb] * d; }
#pragma unroll
        for (int ks = 0; ks < 2; ++ks) { const bf16x8 af = tr2(lds + VL, 32 * ks, 16 * wid, lane);
#pragma unroll
            for (int kb = 0; kb < 8; ++kb) sT[kb] = HG_MFMA(af, tr2(lds + KH, 32 * ks, 16 * kb, lane), sT[kb]); }
#pragma unroll
        for (int kb = 0; kb < 8; ++kb) { typedef unsigned u32x2 __attribute__((ext_vector_type(2)));
            *(HG_LAS u32x2*)(lds + SK + (16 * kb + n16) * RB + (16 * wid + 4 * q4) * 2) = (u32x2){cvtpk(sT[kb][0], sT[kb][1]), cvtpk(sT[kb][2], sT[kb][3])}; }
        if (!warm) {
        __syncthreads();
#pragma unroll
        for (int r = 0; r < 2; ++r) { const int t = 2 * tg + r;
            const f32x4 o0 = *(const HG_LAS f32x4*)(lds + OL + t * ORB + 32 * kc), o1 = *(const HG_LAS f32x4*)(lds + OL + t * ORB + 32 * kc + 16);
            float ss = ((o0[0] * o0[0] + o0[1] * o0[1]) + (o0[2] * o0[2] + o0[3] * o0[3])) + ((o1[0] * o1[0] + o1[1] * o1[1]) + (o1[2] * o1[2] + o1[3] * o1[3]));
            ss += __shfl_xor(ss, 1); ss += __shfl_xor(ss, 2); ss += __shfl_xor(ss, 4); ss += __shfl_xor(ss, 8);
            const float rstd = 1.f / sqrtf(ss * (1.f / 128.f) + 1e-6f);
            float y[8], ghv[8]; { const f32x4 ga = *(const HG_LAS f32x4*)(a.ghn + 8 * kc), gb_ = *(const HG_LAS f32x4*)(a.ghn + 8 * kc + 4); ghv[0] = ga[0]; ghv[1] = ga[1]; ghv[2] = ga[2]; ghv[3] = ga[3]; ghv[4] = gb_[0]; ghv[5] = gb_[1]; ghv[6] = gb_[2]; ghv[7] = gb_[3]; }
#pragma unroll
            for (int e = 0; e < 8; ++e) { const unsigned w = gcur[r][e >> 1]; const float gt = (e & 1) ? bf_hi(w) : bf_lo(w);
                const float sgt = gt * __builtin_amdgcn_rcpf(1.f + __builtin_amdgcn_exp2f(-gt * LOG2E)); const float o = (e < 4) ? o0[e & 3] : o1[e & 3];
                y[e] = (o * rstd * ghv[e]) * sgt; }
            *(u32x4*)(a.out + ((size_t)c * 64 + t) * 4096 + 8 * kc) = (u32x4){cvtpk(y[0], y[1]), cvtpk(y[2], y[3]), cvtpk(y[4], y[5]), cvtpk(y[6], y[7])}; }
        } else if (c + 1 == a.c_begin && w0 > 0) {
            __syncthreads();
            bool ok = true;
#pragma unroll
            for (int e = 0; e < 8; ++e) ok = ok && (((const HG_LAS float*)(lds + DSUM))[8 * kc + e] < -104.f * LOG2E);
            const bool wok = __all(ok);
            if (lane == 0) ((HG_LAS unsigned*)(lds + FLG))[wid] = wok ? 1u : 0u;
            __syncthreads();
            unsigned allok = 1u;
#pragma unroll
            for (int w = 0; w < 8; ++w) allok &= ((const HG_LAS unsigned*)(lds + FLG))[w];
#if !defined(PROBE_NOCHECK)
            if (!allok) { redo = true; break; }
#else
            (void)allok;
#endif
        }
    }
    if (!redo) break;
    __syncthreads();
    w0 -= WARM; if (w0 < 0) w0 = 0;
    }
    __syncthreads();
}
#undef HG_MFMA
}
#define GAS __attribute__((address_space(1)))
#define LAS __attribute__((address_space(3)))
typedef unsigned short bf16;
typedef unsigned v4u __attribute__((ext_vector_type(4)));
typedef float f32x4 __attribute__((ext_vector_type(4)));
typedef short bf16x8 __attribute__((ext_vector_type(8)));
typedef GAS unsigned gu32;
typedef GAS unsigned long long gu64;
#define RLX_AGENT __ATOMIC_RELAXED, __HIP_MEMORY_SCOPE_AGENT
#define LDS_WAIT() asm volatile("s_waitcnt lgkmcnt(0)" ::: "memory")
#define VM_WAIT() asm volatile("s_waitcnt vmcnt(0)" ::: "memory")
__device__ __forceinline__ unsigned long long rt() { return __builtin_amdgcn_s_memrealtime(); }
__device__ __forceinline__ unsigned f2bf(float f) { unsigned u = __builtin_bit_cast(unsigned, f); return (u + 0x7fffu + ((u >> 16) & 1u)) >> 16; }
__device__ __forceinline__ unsigned pk2(float lo, float hi) { typedef float f2_ __attribute__((ext_vector_type(2))); typedef __bf16 b2_ __attribute__((ext_vector_type(2))); const f2_ v = {lo, hi}; return __builtin_bit_cast(unsigned, __builtin_convertvector(v, b2_)); }

#define XB_TMO      128
#define XB_XCNT(j)  (256  + 64 * (j))
#define XB_XSUB(j)  (1280 + 64 * (j))
#define XB_XGEN(j)  (2304 + 64 * (j))
#define XB_TOP      3328
#define XB_TOPGEN   3392
#define XCD_BAR_WORDS 3456
#define XB_SPIN_CAP (1u << 18)

__device__ __forceinline__ unsigned xb_ld(unsigned* p)              { return __hip_atomic_load(p, __ATOMIC_RELAXED, __HIP_MEMORY_SCOPE_AGENT); }
__device__ __forceinline__ unsigned xb_add(unsigned* p, unsigned v) { return __hip_atomic_fetch_add(p, v, __ATOMIC_RELAXED, __HIP_MEMORY_SCOPE_AGENT); }
__device__ __forceinline__ unsigned xb_xcc_id() { return (unsigned)__builtin_amdgcn_s_getreg((3 << 11) | 20) & 0xFu; }
#define XB_SPIN(cond, bar) do { unsigned _sp = 0; while (cond) { __builtin_amdgcn_s_sleep(1); \
    if ((++_sp & 255u) == 0u) { if (xb_ld(&(bar)[XB_TMO])) break; if (_sp > XB_SPIN_CAP) { atomicAdd(&(bar)[XB_TMO], 1u); break; } } } } while (0)

__device__ __forceinline__ int lane_now() { int l; asm volatile("v_mbcnt_lo_u32_b32 %0, -1, 0\n\tv_mbcnt_hi_u32_b32 %0, -1, %0" : "=v"(l)); return l; }
struct XcdBarrier {
    unsigned* bar; unsigned x; int w0;
    volatile LAS unsigned* st;
};

__device__ __forceinline__ XcdBarrier xcd_barrier_post(unsigned* bar, volatile LAS unsigned* st) {
    XcdBarrier b; b.bar = bar; b.x = xb_xcc_id(); b.st = st; b.w0 = __builtin_amdgcn_readfirstlane((int)threadIdx.x >> 6);
    if (threadIdx.x == 0) (void)xb_add(&bar[XB_XCNT(b.x)], 1u);
    return b;
}
__device__ __forceinline__ void xcd_barrier_complete(unsigned* bar, unsigned x, unsigned& nloc, unsigned& nx) {
    const unsigned G = gridDim.x * gridDim.y * gridDim.z;
    unsigned sum, cnt, mine, sp = 0u;
    for (;;) {
        sum = 0u; cnt = 0u; mine = 0u;
#pragma unroll
        for (unsigned j = 0; j < 16; ++j) { const unsigned c = xb_ld(&bar[XB_XCNT(j)]); sum += c; cnt += (c > 0u) ? 1u : 0u; mine = (j == x) ? c : mine; }
        if (sum == G) break;
        __builtin_amdgcn_s_sleep(1);
        if ((++sp & 255u) == 0u) { if (xb_ld(&bar[XB_TMO])) break; if (sp > XB_SPIN_CAP) { atomicAdd(&bar[XB_TMO], 1u); break; } }
    }
    nloc = mine > 0u ? mine : 1u; nx = cnt > 0u ? cnt : 1u;
}

__device__ __forceinline__ void xcd_barrier(const XcdBarrier& b) {
    asm volatile("s_waitcnt vmcnt(0)" ::: "memory");
    __syncthreads();
    if (b.w0 == 0 && lane_now() == 0) {
        unsigned* bar = b.bar;
        __builtin_amdgcn_s_waitcnt(0);
        unsigned nloc = b.st[0], nx = b.st[1];
        if (nloc == 0u) { xcd_barrier_complete(bar, b.x, nloc, nx); b.st[0] = nloc; b.st[1] = nx; }
        const unsigned old = xb_add(&bar[XB_XSUB(b.x)], 1u);
        const unsigned gen = old / nloc;
        if (old + 1u == (gen + 1u) * nloc) {
            __builtin_amdgcn_fence(__ATOMIC_RELEASE, "agent");
            asm volatile("s_waitcnt vmcnt(0)" ::: "memory");
            const unsigned og = xb_add(&bar[XB_TOP], 1u);
            const unsigned tg = og / nx;
            if (og + 1u == (tg + 1u) * nx) xb_add(&bar[XB_TOPGEN], 1u);
            else XB_SPIN(xb_ld(&bar[XB_TOPGEN]) == tg, bar);
            __builtin_amdgcn_fence(__ATOMIC_ACQUIRE, "agent");
            xb_add(&bar[XB_XGEN(b.x)], 1u);
            asm volatile("s_waitcnt vmcnt(0)" ::: "memory");
        } else {
            XB_SPIN(xb_ld(&bar[XB_XGEN(b.x)]) == gen, bar);
            __builtin_amdgcn_fence(__ATOMIC_ACQUIRE, "agent");
            asm volatile("s_waitcnt vmcnt(0)" ::: "memory");
        }
    }
    __syncthreads();
}
__device__ __forceinline__ void group_sync(const XcdBarrier& b, unsigned* cnt, unsigned n) {
    asm volatile("s_waitcnt vmcnt(0)" ::: "memory");
    __syncthreads();
    if (b.w0 == 0 && lane_now() == 0) {
        __builtin_amdgcn_s_waitcnt(0);
        __builtin_amdgcn_fence(__ATOMIC_RELEASE, "agent");
        asm volatile("s_waitcnt vmcnt(0)" ::: "memory");
        (void)xb_add(cnt, 1u);
        XB_SPIN(xb_ld(cnt) < n, b.bar);
        __builtin_amdgcn_fence(__ATOMIC_ACQUIRE, "agent");
        asm volatile("s_waitcnt vmcnt(0)" ::: "memory");
    }
    __syncthreads();
}
typedef unsigned short u16;
constexpr int NWAVES = 8;
constexpr int BATCH = 2, SEQ = 8192, DM = 4096, NH = 16, HD = 128, DFF = 16384, PLE = 256;
constexpr int M = BATCH * SEQ;
constexpr int NIN = 14352, NPROJ = 14336, FA_COL = 6144;
constexpr float RMS_EPS = 1e-6f;
constexpr size_t MiB = 1u << 20;
constexpr size_t WS_CTL = 0, CTL_ZERO_BYTES = 65536;
constexpr size_t WS_WFA = 1 * MiB;
constexpr size_t WS_LS = 2 * MiB;
constexpr size_t WS_BS = 3 * MiB;
constexpr size_t WS_PQK = 4 * MiB;
constexpr size_t WS_P1 = 12 * MiB, WS_P2 = 16 * MiB, WS_PE = 20 * MiB;
constexpr size_t WS_WGATE = 24 * MiB, WS_WDOWN = 40 * MiB, WS_WUP = 168 * MiB, WS_WOUT = 296 * MiB, WS_WPLE = 328 * MiB;
constexpr size_t WS_PB = 330 * MiB;
constexpr size_t WS_ACTA = 338 * MiB;
constexpr size_t WS_WIN = 466 * MiB;
constexpr size_t WS_PROJ = 578 * MiB;
constexpr size_t WS_H1B = 808 * MiB;
constexpr size_t WS_HID = 296 * MiB;
constexpr size_t WS_ERAW = 936 * MiB;
constexpr size_t WS_H2F8 = 1064 * MiB;
constexpr size_t WS_RS0 = 12 * MiB;
constexpr size_t WS_IDB = 1128 * MiB;
constexpr size_t WS_END = 1130 * MiB;
constexpr size_t PROJ_T = (size_t)2 * 16 * 8192 * 128;
constexpr int CW_TMO = 0, CW_BAR = 4096, CW_GRP = 8192;
static_assert(CW_BAR + XCD_BAR_WORDS <= CW_GRP && (CW_GRP + 2 * 64 * 64) * 4 <= (int)CTL_ZERO_BYTES, "control words");
constexpr int LDS_BYTES = 163840;
constexpr int RING_OFF = 0;
constexpr int TAB_OFF = 160768, TAB_RS = TAB_OFF, TAB_RSE = TAB_OFF + 1024;
constexpr int MISC_OFF = 162816;
static_assert(fa::FA_LDS_END <= TAB_OFF && hg::HG_END2 + 1024 <= TAB_OFF, "LDS map");

struct Frame {
    LAS unsigned char* lds; volatile LAS unsigned* MISC; gu32* ctl;
    int tid, lane, wave, vcu, G;
};
__device__ __forceinline__ float wave_sum(float v) {
#pragma unroll
    for (int o = 1; o < 64; o <<= 1) v += __shfl_xor(v, o);
    return v;
}
struct TItem { const float* W; const float* g; unsigned char* WT; int ldw, K, k0, src0, dst0; float scale; int fp8; };
__device__ __forceinline__ void p0_item_load(const TItem& t, float (&wv)[32], int lane) {
#pragma unroll
    for (int i = 0; i < 32; ++i) wv[i] = t.W[(size_t)(t.k0 + 2 * i + (lane >> 5)) * t.ldw + t.src0 + (lane & 31)];
}
__device__ __forceinline__ unsigned pk4_fp8(float a, float b, float c, float d) { int p = __builtin_amdgcn_cvt_pk_fp8_f32(a, b, 0, false); p = __builtin_amdgcn_cvt_pk_fp8_f32(c, d, p, true); return (unsigned)p; }
__device__ __forceinline__ void p0_item_finish(const TItem& t, const float (&wv)[32], LAS float* scr, int lane) {
#pragma unroll
    for (int i = 0; i < 32; ++i) { const int kk = 2 * i + (lane >> 5); float w = wv[i] * t.scale; if (t.g) w *= t.g[t.k0 + kk]; scr[kk * 33 + (lane & 31)] = w; }
    LDS_WAIT(); asm volatile("" ::: "memory");
    const int c = lane & 7;
    if (t.fp8) {
#pragma unroll
        for (int j = 0; j < 4; ++j) { const int n = (lane >> 3) + 8 * j; const LAS float* s = scr + (8 * c) * 33 + n;
            typedef unsigned u32x2_ __attribute__((ext_vector_type(2)));
            u32x2_ o; o.x = pk4_fp8(s[0 * 33], s[1 * 33], s[2 * 33], s[3 * 33]); o.y = pk4_fp8(s[4 * 33], s[5 * 33], s[6 * 33], s[7 * 33]);
            *(GAS u32x2_*)(t.WT + (size_t)(t.dst0 + n) * t.K + t.k0 + 8 * c) = o; }
    } else {
#pragma unroll
        for (int j = 0; j < 4; ++j) { const int n = (lane >> 3) + 8 * j; const LAS float* s = scr + (8 * c) * 33 + n;
            v4u o; o.x = pk2(s[0 * 33], s[1 * 33]); o.y = pk2(s[2 * 33], s[3 * 33]); o.z = pk2(s[4 * 33], s[5 * 33]); o.w = pk2(s[6 * 33], s[7 * 33]);
            *(GAS v4u*)((u16*)t.WT + (size_t)(t.dst0 + n) * t.K + t.k0 + 8 * c) = o; }
    }
    LDS_WAIT(); asm volatile("" ::: "memory");
}
constexpr float GATE_WSCALE = 64.f;
struct Args { const float* in[17]; float* out; unsigned char* ws; };
typedef const __attribute__((address_space(4))) Args KArgs;
__device__ __forceinline__ KArgs* karg_ptr() { KArgs* kp = (KArgs*)__builtin_amdgcn_kernarg_segment_ptr(); asm volatile("" : "+s"(kp)); return kp; }

template <int PART> __device__ __forceinline__ void p0_prologue(Frame& F) {
    KArgs& A = *karg_ptr(); unsigned char* ws = A.ws;
    LAS float* scr = (LAS float*)(F.lds + RING_OFF + F.wave * 16384);
    const int gw = F.vcu * NWAVES + F.wave, NGW = F.G * NWAVES;
    constexpr int I_IN = (DM / 64) * (NPROJ / 32), I_OUT = (DM / 64) * (DM / 32), I_UP = (DM / 64) * (DFF / 32), I_DN = (DFF / 64) * (DM / 32), I_GT = I_OUT, I_PL = (PLE / 64) * (DM / 32);
    constexpr int NITEMS = I_IN + I_OUT + I_UP + I_DN + I_GT + I_PL, NA = I_IN + I_OUT + I_PL, LO = PART ? NA : 0, HI = PART ? NITEMS : NA;
    auto decode = [&](int r) { TItem t; t.scale = 1.f; t.fp8 = 0; t.g = nullptr;
        if (r < I_IN) { const int nblk = NPROJ / 32, kb = r / nblk, n0 = 32 * (r % nblk); t.W = A.in[3]; t.ldw = NIN; t.K = DM; t.g = A.in[2]; t.WT = ws + WS_WIN; t.k0 = 64 * kb; t.src0 = n0 + (n0 >= FA_COL ? 16 : 0); t.dst0 = n0; return t; } r -= I_IN;
        if (r < I_OUT) { const int nblk = DM / 32; t.W = A.in[9]; t.ldw = DM; t.K = DM; t.WT = ws + WS_WOUT; t.k0 = 64 * (r / nblk); t.src0 = t.dst0 = 32 * (r % nblk); return t; } r -= I_OUT;
        if (r < I_PL) { const int nblk = DM / 32; t.W = A.in[15]; t.ldw = DM; t.K = PLE; t.WT = ws + WS_WPLE; t.k0 = 64 * (r / nblk); t.src0 = t.dst0 = 32 * (r % nblk); return t; } r -= I_PL;
        if (r < I_UP) { const int nblk = DFF / 32; t.W = A.in[11]; t.ldw = DFF; t.K = DM; t.g = A.in[10]; t.WT = ws + WS_WUP; t.k0 = 64 * (r / nblk); t.src0 = t.dst0 = 32 * (r % nblk); return t; } r -= I_UP;
        if (r < I_DN) { const int nblk = DM / 32; t.W = A.in[12]; t.ldw = DM; t.K = DFF; t.WT = ws + WS_WDOWN; t.k0 = 64 * (r / nblk); t.src0 = t.dst0 = 32 * (r % nblk); return t; } r -= I_DN;
        { const int nblk = DM / 32; t.W = A.in[14]; t.ldw = DM; t.K = DM; t.g = A.in[13]; t.scale = GATE_WSCALE; t.fp8 = 1; t.WT = ws + WS_WGATE; t.k0 = 64 * (r / nblk); t.src0 = t.dst0 = 32 * (r % nblk); return t; } };
    if (LO + gw < HI) {
        float wa[32], wb[32]; int it = LO + gw; TItem ta = decode(it), tb = ta; p0_item_load(ta, wa, F.lane);
        for (;;) {
            const bool hb = it + NGW < HI; if (hb) { tb = decode(it + NGW); p0_item_load(tb, wb, F.lane); }
            p0_item_finish(ta, wa, scr, F.lane); if (!hb) break;
            const bool ha = it + 2 * NGW < HI; if (ha) { ta = decode(it + 2 * NGW); p0_item_load(ta, wa, F.lane); }
            p0_item_finish(tb, wb, scr, F.lane); if (!ha) break;
            it += 2 * NGW; }
    }
    if constexpr (PART == 0) {
    { const int gt = F.vcu * 512 + F.tid, NT = F.G * 512;
      for (int i = gt; i < 16 * DM; i += NT) { const int n = i >> 12, k = i & 4095; ((u16*)(ws + WS_WFA))[i] = (u16)f2bf(A.in[3][(size_t)k * NIN + FA_COL + n] * A.in[2][k]); }
      for (int i = gt; i < 256 * 256; i += NT) ((u16*)(ws + WS_IDB))[(size_t)(i >> 8) * DM + (i & 255)] = ((i >> 8) == (i & 255)) ? (u16)0x3F80u : (u16)0u;
      const f32x4* p4 = (const f32x4*)A.in[1]; unsigned long long* pb = (unsigned long long*)(ws + WS_PB);
      for (int i = gt; i < M * PLE / 4; i += NT) { const f32x4 v = p4[i]; pb[i] = (unsigned long long)pk2(v.x, v.y) | ((unsigned long long)pk2(v.z, v.w) << 32); } }
    { float* RS0 = (float*)(ws + WS_RS0);
      auto xload = [&](f32x4 (&v)[16], int m) { const f32x4* xr = (const f32x4*)(A.in[0] + (size_t)m * DM);
#pragma unroll
          for (int j = 0; j < 8; ++j) { v[2 * j] = xr[128 * j + 2 * F.lane]; v[2 * j + 1] = xr[128 * j + 2 * F.lane + 1]; } };
      auto xrow = [&](const f32x4 (&v)[16], int m) { float s = 0.f;
          v4u* xo = (v4u*)((u16*)A.out + (size_t)m * DM);
#pragma unroll
          for (int j = 0; j < 8; ++j) { v4u xw; xw.x = pk2(v[2 * j].x, v[2 * j].y); xw.y = pk2(v[2 * j].z, v[2 * j].w); xw.z = pk2(v[2 * j + 1].x, v[2 * j + 1].y); xw.w = pk2(v[2 * j + 1].z, v[2 * j + 1].w); xo[64 * j + F.lane] = xw; }
#pragma unroll
          for (int j = 0; j < 16; ++j) s += (v[j].x * v[j].x + v[j].y * v[j].y) + (v[j].z * v[j].z + v[j].w * v[j].w);
          const float rstd = 1.f / sqrtf(wave_sum(s) * (1.f / DM) + RMS_EPS);
          if (F.lane == 0) RS0[m] = rstd; };
      if (gw < M) {
          f32x4 va[16], vb[16]; int m = gw; xload(va, m);
          for (;;) {
              const bool hb = m + NGW < M; if (hb) xload(vb, m + NGW);
              xrow(va, m); if (!hb) break;
              const bool ha = m + 2 * NGW < M; if (ha) xload(va, m + 2 * NGW);
              xrow(vb, m + NGW); if (!ha) break;
              m += 2 * NGW; } } }
    }
}
__device__ __forceinline__ void fa_tile(Frame& F, int tile) {
    KArgs& A = *karg_ptr(); unsigned char* ws = A.ws; const u16* U = (const u16*)A.out; const u16* WF = (const u16*)(ws + WS_WFA);
    const int R0 = tile * 64, b = R0 >> 13, t0 = R0 & 8191, rb = F.wave & 3, kh = F.wave >> 2, n16 = F.lane & 15, q4 = F.lane >> 4;
    f32x4 acc = {0.f, 0.f, 0.f, 0.f};
    const u16* ap = U + (size_t)(R0 + 16 * rb + n16) * DM + kh * 2048 + 8 * q4; const u16* bp = WF + (size_t)n16 * DM + kh * 2048 + 8 * q4;
#pragma unroll 16
    for (int s = 0; s < 64; ++s) acc = __builtin_amdgcn_mfma_f32_16x16x32_bf16(*(const bf16x8*)(ap + 32 * s), *(const bf16x8*)(bp + 32 * s), acc, 0, 0, 0);
    LAS float* red = (LAS float*)(F.lds + RING_OFF);
    LAS float* bsum = (LAS float*)(F.lds + RING_OFF + 4096);
    if (kh == 1) *(LAS f32x4*)(red + (rb * 64 + F.lane) * 4) = acc;
    __syncthreads();
    if (kh == 0) { const f32x4 o = *(const LAS f32x4*)(red + (rb * 64 + F.lane) * 4); const float bias = A.in[4][n16]; float ts = 0.f;
        const f32x4 rs = *(const f32x4*)((const float*)(ws + WS_RS0) + R0 + 16 * rb + 4 * q4);
        float* LS = (float*)(ws + WS_LS) + (size_t)(b * 16 + n16) * 8192 + t0 + 16 * rb + 4 * q4;
        f32x4 l;
#pragma unroll
        for (int r = 0; r < 4; ++r) { const float v = (acc[r] + o[r]) * rs[r] + bias; l[r] = fminf(v, 0.f) - __builtin_amdgcn_logf(1.f + __builtin_amdgcn_exp2f(-fabsf(v) * 1.4426950408889634f)) * 0.6931471805599453f; ts += l[r]; }
        *(f32x4*)LS = l;
        ts += __shfl_xor(ts, 16); ts += __shfl_xor(ts, 32);
        if (q4 == 0) bsum[rb * 16 + n16] = ts; }
    __syncthreads();
    if (F.tid < 16) { const float s = (bsum[F.tid] + bsum[16 + F.tid]) + (bsum[32 + F.tid] + bsum[48 + F.tid]); ((float*)(ws + WS_BS))[(b * 16 + F.tid) * 128 + (t0 >> 6)] = s; }
    __syncthreads();
}
__device__ __forceinline__ void row_table(Frame& F, const float* part, int row0, LAS float* tab) {
    if (F.tid < 256) { const f32x4* p = (const f32x4*)(part + (size_t)(row0 + F.tid) * 64); float s = 0.f;
#pragma unroll
        for (int j = 0; j < 16; ++j) { const f32x4 v = p[j]; s += (v.x + v.y) + (v.z + v.w); }
        tab[F.tid] = 1.f / sqrtf(s * (1.f / DM) + RMS_EPS); }
    __syncthreads();
}

typedef __hip_bfloat16 hbf; typedef fa::BlockRef<hbf, hbf> FoxRef;
__device__ __forceinline__ FoxRef fox_ref(int L, const u16* PJ, u16* MIX, const float* BS, const float* LS, const float* PQK, float bqk2) {
    const int bh = L >> 5, qb = L & 31, b = bh >> 4, h = bh & 15; FoxRef r;
    r.Q = (const hbf*)(PJ + 0 * PROJ_T + ((size_t)bh * 8192 + qb * 256) * 128); r.K = (const hbf*)(PJ + 1 * PROJ_T + (size_t)bh * 8192 * 128); r.V = (const hbf*)(PJ + 2 * PROJ_T + (size_t)bh * 8192 * 128);
    r.O = (hbf*)(MIX + ((size_t)b * 8192 + qb * 256) * 4096 + 128 * h); r.P0 = qb * 256;
    int jlo = qb * 4; float sacc = 0.f; while (jlo > 0 && bqk2 + sacc >= -110.f) { --jlo; sacc += BS[bh * 128 + jlo]; }
    r.jlo = jlo; r.thr2 = (110.f + bqk2) * 1.4426950408889634f; r.LS = LS + (size_t)bh * 8192; r.PK = PQK + ((size_t)(16384 + b * 8192) * 16 + h) * 4; r.PQ = PQK + ((size_t)(b * 8192) * 16 + h) * 4; return r;
}

__global__ void __launch_bounds__(NWAVES * 64, 2) fwd_kernel(Args args) {
    extern __shared__ __attribute__((aligned(16))) unsigned char lds[];
    Frame F;
    F.lds = (LAS unsigned char*)lds;
    F.MISC = (volatile LAS unsigned*)(F.lds + MISC_OFF);
#define REFRESH_TID() do { const int l_ = lane_now(); F.tid = wave0 * 64 + l_; F.lane = l_; F.wave = wave0; } while (0)
    const int wave0 = __builtin_amdgcn_readfirstlane((int)threadIdx.x >> 6);
    REFRESH_TID();
    F.G = gridDim.x; { const int bx = blockIdx.x; F.vcu = (F.G % 8 == 0) ? (bx % 8) * (F.G / 8) + bx / 8 : bx; }
    F.ctl = (gu32*)(karg_ptr()->ws + WS_CTL);
    for (int u = F.tid; u < (LDS_BYTES - MISC_OFF) / 4; u += NWAVES * 64) ((LAS unsigned*)(F.lds + MISC_OFF))[u] = 0u;
    __syncthreads();
    XcdBarrier bar = xcd_barrier_post((unsigned*)(F.ctl + CW_BAR), F.MISC + 8);
    const int G = F.G, cb = (int)blockIdx.x;

#ifndef PHM
#define PHM 0xff
#endif
#if PHM & 1
    REFRESH_TID(); p0_prologue<0>(F);
#endif
    xcd_barrier(bar);

#if PHM & 2
    REFRESH_TID();
    for (int tile = F.vcu; tile < M / 64; tile += G) fa_tile(F, tile);
    { unsigned char* ws = karg_ptr()->ws;
      pg8::Gemm g{(const pg8::bf16_t*)karg_ptr()->out, (const pg8::bf16_t*)(ws + WS_WIN), M, NPROJ, DM, nullptr, nullptr}; pg8::StaticOrder S; S.init(M, NPROJ, G, cb);
      { pg8::Unit u0; if (S.next(0, u0) && F.tid < 256) ((LAS float*)(F.lds + TAB_RS))[F.tid] = ((const float*)(ws + WS_RS0))[u0.pm * 256 + F.tid]; __syncthreads(); }
      pg8::EpiProj E{(pg8::bf16_t*)(ws + WS_PROJ), (float*)(ws + WS_PQK), (const LAS float*)(F.lds + TAB_RS)};
      pg8::gemm_phase<pg8::EpiProj, pg8::StaticOrder, true, true>(F.lds + RING_OFF, g, S, E, wave0); }
#endif
    xcd_barrier(bar);

#if PHM & 4
    REFRESH_TID();
    {
        KArgs& args = *karg_ptr(); unsigned char* ws = args.ws;
        const u16* PJ = (const u16*)(ws + WS_PROJ); u16* MIX = (u16*)(ws + WS_ACTA);
        constexpr int HSEG = 16, NSEG = (SEQ / 64) / HSEG, NHITEM = 32 * NSEG;
#if defined(PROBE_HG)
        for (int it2 = F.vcu; it2 < 2 * NHITEM; it2 += G) { const int it = it2 % NHITEM;
#else
        for (int it = F.vcu; it < NHITEM; it += G) {
#endif
            LAS float* lbt = (LAS float*)(F.lds + hg::HG_END2);
            const int bh = it / NSEG, seg = it % NSEG, b = bh >> 4, h = bh & 15;
            if (F.tid < 128) { const float l0 = args.in[7][h * 128 + F.tid], l1 = args.in[7][2048 + h * 128 + F.tid]; const float mx = fmaxf(l0, l1), e0 = __expf(l0 - mx), e1 = __expf(l1 - mx); lbt[F.tid] = e0 / (e0 + e1); lbt[128 + F.tid] = args.in[8][F.tid]; }
            __syncthreads();
            hg::SegArgs a{PJ + 3 * PROJ_T + (size_t)bh * 8192 * 128, PJ + 4 * PROJ_T + (size_t)bh * 8192 * 128, PJ + 5 * PROJ_T + (size_t)bh * 8192 * 128, PJ + 6 * PROJ_T + (size_t)bh * 8192 * 128,
                          MIX + (size_t)b * 8192 * 4096 + 2048 + 128 * h, (const HG_LAS float*)lbt, (const HG_LAS float*)(lbt + 128), seg * HSEG, seg * HSEG + HSEG};
            hg::hgrn_segment((HG_LAS char*)F.lds, a, wave0);
        }
        {
            typedef hbf hb; typedef FoxRef Ref;
            LAS float* GGt = (LAS float*)(F.lds + fa::GG_OFF);
            if (F.tid < 128) GGt[F.tid] = args.in[5][F.tid] * args.in[6][F.tid];
            float gq = 0.f, gk = 0.f;
            for (int i = 0; i < 128; ++i) { gq = fmaxf(gq, fabsf(args.in[5][i])); gk = fmaxf(gk, fabsf(args.in[6][i])); }
            const float bqk2 = 2.f * 11.313708499f * gq * gk * 1.03f;
            __syncthreads();
            const int NITEM = 32 * 32;
            const float* BS = (const float*)(ws + WS_BS); const float* LS = (const float*)(ws + WS_LS); const float* PQK = (const float*)(ws + WS_PQK);
#if defined(PROBE_ATT)
            for (int L2 = F.vcu; L2 < 2 * NITEM; L2 += G) { const int L = L2 % NITEM; const Ref cur = fox_ref(L, PJ, MIX, BS, LS, PQK, bqk2); fa::fox_block<hb, hb>(cur, (char*)lds, wave0); }
#else
            for (int L = F.vcu; L < NITEM; L += G) { const Ref cur = fox_ref(L, PJ, MIX, BS, LS, PQK, bqk2); fa::fox_block<hb, hb>(cur, (char*)lds, wave0); }
#endif
        }
    }
#endif
    xcd_barrier(bar);

#if PHM & 8
    REFRESH_TID();
    { KArgs& args = *karg_ptr(); unsigned char* ws = args.ws;
      pg8::Gemm g{(const pg8::bf16_t*)(ws + WS_ACTA), (const pg8::bf16_t*)(ws + WS_WOUT), M, DM, DM, (const pg8::bf16_t*)args.out, (const pg8::bf16_t*)(ws + WS_IDB)}; pg8::StaticOrder S; S.init(M, DM, G, cb);
      pg8::EpiOut E{(pg8::bf16_t*)(ws + WS_H1B), (float*)(ws + WS_P1)};
      pg8::gemm_phase<pg8::EpiOut, pg8::StaticOrder, true, true, false, 4>(F.lds + RING_OFF, g, S, E, wave0); }
    { unsigned char* ws = karg_ptr()->ws;
      pg8::Gemm g{(const pg8::bf16_t*)(ws + WS_PB), (const pg8::bf16_t*)(ws + WS_WPLE), M, DM, PLE, nullptr, nullptr}; pg8::StaticOrder S; S.init(M, DM, G, cb);
      pg8::EpiE E{(pg8::bf16_t*)(ws + WS_ERAW), (float*)(ws + WS_PE), karg_ptr()->in[16]};
      pg8::gemm_phase<pg8::EpiE, pg8::StaticOrder, true, true>(F.lds + RING_OFF, g, S, E, wave0); }
    __syncthreads(); REFRESH_TID(); p0_prologue<1>(F);
#endif
    xcd_barrier(bar);

#if PHM & 16
    REFRESH_TID();
    { unsigned char* ws = karg_ptr()->ws;
      pg8::Gemm g{(const pg8::bf16_t*)(ws + WS_H1B), (const pg8::bf16_t*)(ws + WS_WUP), M, DFF, DM, nullptr, nullptr}; pg8::StaticOrder S; S.init(M, DFF, G, cb);
      pg8::Unit u0; if (S.next(0, u0)) row_table(F, (const float*)(ws + WS_P1), u0.pm * 256, (LAS float*)(F.lds + TAB_RS)); else __syncthreads();
      pg8::EpiUp E{(pg8::bf16_t*)(ws + WS_HID), (const LAS float*)(F.lds + TAB_RS)};
      pg8::gemm_phase<pg8::EpiUp, pg8::StaticOrder, true, true>(F.lds + RING_OFF, g, S, E, wave0); }
    int pmg; { pg8::StaticOrder S; S.init(M, DM, G, cb); pg8::Unit u0; pmg = S.next(0, u0) ? u0.pm : 0; }
    if (G == 256) group_sync(bar, (unsigned*)(F.ctl + CW_GRP + 64 * pmg), 4u); else xcd_barrier(bar);
    REFRESH_TID();
    { KArgs& args = *karg_ptr(); unsigned char* ws = args.ws;
      pg8::Gemm g{(const pg8::bf16_t*)(ws + WS_HID), (const pg8::bf16_t*)(ws + WS_WDOWN), M, DM, DFF, nullptr, nullptr}; pg8::StaticOrder S; S.init(M, DM, G, cb);
      pg8::EpiDown E{(const pg8::bf16_t*)(ws + WS_H1B), (pg8::bf16_t*)(ws + WS_H1B), (unsigned char*)(ws + WS_H2F8), (float*)(ws + WS_P2), 0};
      pg8::gemm_phase<pg8::EpiDown, pg8::StaticOrder, true, true>(F.lds + RING_OFF, g, S, E, wave0); }
    if (G == 256) group_sync(bar, (unsigned*)(F.ctl + CW_GRP + 64 * (64 + pmg)), 4u); else xcd_barrier(bar);
#endif
#if PHM & 32
    REFRESH_TID();
    { KArgs& args = *karg_ptr(); unsigned char* ws = args.ws;
      pg8::Gemm g{(const pg8::bf16_t*)(ws + WS_H2F8), (const pg8::bf16_t*)(ws + WS_WGATE), M, DM, DM / 2, nullptr, nullptr}; pg8::StaticOrder S; S.init(M, DM, G, cb);
      pg8::Unit u0; if (S.next(0, u0)) { row_table(F, (const float*)(ws + WS_P2), u0.pm * 256, (LAS float*)(F.lds + TAB_RS)); row_table(F, (const float*)(ws + WS_PE), u0.pm * 256, (LAS float*)(F.lds + TAB_RSE)); }
      pg8::EpiGate E{args.out, (const pg8::bf16_t*)(ws + WS_H1B), (const pg8::bf16_t*)(ws + WS_ERAW), 1.f / GATE_WSCALE, (const LAS float*)(F.lds + TAB_RS), (const LAS float*)(F.lds + TAB_RSE)};
      pg8::gemm_phase<pg8::EpiGate, pg8::StaticOrder, true, true, true>(F.lds + RING_OFF, g, S, E, wave0); }
#endif
    if (__hip_atomic_load((gu32*)((unsigned*)(F.ctl + CW_BAR) + XB_TMO), RLX_AGENT) != 0u) { asm volatile("s_waitcnt vmcnt(0)" ::: "memory"); __syncthreads();
        float* o = karg_ptr()->out; const float qn = __builtin_nanf(""); const int t_ = wave0 * 64 + lane_now(); for (int i = t_; i < DM; i += NWAVES * 64) o[(size_t)blockIdx.x * 64 * DM + i] = qn; }
}

extern "C" void kernel_launch(void* const* d_in, const int* in_sizes, int n_in, void* d_out, int out_size, void* d_ws, size_t ws_size, hipStream_t stream) {
    static int grid = 0;
    if (grid == 0) {
        if (n_in != 17 || in_sizes[0] != M * DM || out_size != M * DM || ws_size < WS_END) { fprintf(stderr, "kernel_launch: shape / workspace mismatch (n_in %d, ws %zu, need %zu); nothing launched\n", n_in, ws_size, (size_t)WS_END); grid = -1; return; }
        int dev = 0, cus = 0, per_cu = 0;
        if (hipGetDevice(&dev) != hipSuccess || hipDeviceGetAttribute(&cus, hipDeviceAttributeMultiprocessorCount, dev) != hipSuccess) { grid = -1; return; }
        if (hipFuncSetAttribute((const void*)fwd_kernel, hipFuncAttributeMaxDynamicSharedMemorySize, LDS_BYTES) != hipSuccess) { fprintf(stderr, "kernel_launch: hipFuncSetAttribute failed\n"); grid = -1; return; }
        if (hipOccupancyMaxActiveBlocksPerMultiprocessor(&per_cu, (const void*)fwd_kernel, NWAVES * 64, LDS_BYTES) != hipSuccess || per_cu < 1) fprintf(stderr, "kernel_launch: note: occupancy query reports %d workgroups per CU\n", per_cu);
        (void)hipGetLastError();
        grid = cus;
    }
    if (grid < 0) return;
    if (hipMemsetAsync((char*)d_ws + WS_CTL, 0, CTL_ZERO_BYTES, stream) != hipSuccess) return;
    Args a{};
    for (int i = 0; i < 17; ++i) a.in[i] = (const float*)d_in[i];
    a.out = (float*)d_out; a.ws = (unsigned char*)d_ws;
    hipLaunchKernelGGL(fwd_kernel, dim3(grid), dim3(NWAVES * 64), LDS_BYTES, stream, a);
}
```
